# Optimizing an MI355X kernel written in HIP

```python
import numpy as np
import jax
import jax.numpy as jnp
from jax import lax

D_MODEL = 2048
BATCH = 4
SEQ = 4096
DEPTH = 2

HEAD_DIM = 64
SWA_HEADS = D_MODEL // HEAD_DIM // 2
SWA_KV_HEADS = 2
SWA_WINDOW = 128
NSA_HEADS = D_MODEL // HEAD_DIM - SWA_HEADS
NSA_KV_GROUPS = 2
NSA_CMP_LEN = 32
NSA_CMP_STRIDE = 16
NSA_CMP_HIDDEN = 256
NSA_SLC_LEN = 64
NSA_TOPK = 16
NSA_WINDOW = 512
Q_BLOCK = 128
NSA_Q_CHUNK = 64
N_GROUPS = 8
EXPERTS_PER_GROUP = 8
N_EXPERTS = N_GROUPS * EXPERTS_PER_GROUP
EXPERT_TOPK = 2
EXPERT_HIDDEN = 512
EXPERT_ROWS = 128
SWA_Q_W = SWA_HEADS * HEAD_DIM
SWA_KV_W = SWA_KV_HEADS * HEAD_DIM
NSA_Q_W = NSA_HEADS * HEAD_DIM
NSA_KV_W = NSA_KV_GROUPS * HEAD_DIM
NSA_GATE_W = 3 * NSA_HEADS
IN_COLS = SWA_Q_W + 2 * SWA_KV_W + NSA_Q_W + 6 * NSA_KV_W + NSA_GATE_W
MIX_WIDTH = SWA_Q_W + NSA_Q_W
ALPHA = (2.0 * DEPTH) ** 0.25
BETA = (8.0 * DEPTH) ** -0.25
LN_EPS = 1e-5

kernel_name = 'hybrid_swa_nsa_hier_moe'


def layer_norm(x, g, b):
    xf = x.astype(jnp.float32)
    mu = jnp.mean(xf, axis=-1, keepdims=True)
    var = jnp.mean(jnp.square(xf - mu), axis=-1, keepdims=True)
    return ((xf - mu) * lax.rsqrt(var + LN_EPS) * g + b).astype(x.dtype)


def alibi_slopes():
    n = SWA_HEADS + NSA_HEADS
    s = jnp.exp2(-8.0 * jnp.arange(1, n + 1, dtype=jnp.float32) / n)
    return s[0::2], s[1::2]


def banded_attention(q, k, v, slopes, window, sinks=None):
    B, S, G, R, Dh = q.shape
    nb = S // Q_BLOCK
    span = window + Q_BLOCK
    kp = jnp.pad(k, ((0, 0), (window, 0), (0, 0), (0, 0)))
    vp = jnp.pad(v, ((0, 0), (window, 0), (0, 0), (0, 0)))
    qb = q.reshape(B, nb, Q_BLOCK, G, R, Dh).swapaxes(0, 1)
    scale = Dh ** -0.5
    slope = slopes.astype(jnp.float32)[None, :, :, None, None]

    def block(args):
        j, qj = args
        kj = lax.dynamic_slice_in_dim(kp, j * Q_BLOCK, span, axis=1)
        vj = lax.dynamic_slice_in_dim(vp, j * Q_BLOCK, span, axis=1)
        t = j * Q_BLOCK + jnp.arange(Q_BLOCK)
        s = j * Q_BLOCK - window + jnp.arange(span)
        dist = t[:, None] - s[None, :]
        mask = (dist >= 0) & (dist < window) & (s[None, :] >= 0)
        logits = jnp.einsum('bqgrd,bkgd->bgrqk', qj, kj).astype(jnp.float32) * scale
        logits = logits - slope * dist.astype(jnp.float32)
        logits = jnp.where(mask, logits, -jnp.inf)
        m = jnp.max(logits, axis=-1, keepdims=True)
        if sinks is None:
            p = jnp.exp(logits - m)
            denom = jnp.sum(p, axis=-1, keepdims=True)
        else:
            sink = sinks.astype(jnp.float32)[None, :, :, None, None]
            m = jnp.maximum(m, sink)
            p = jnp.exp(logits - m)
            denom = jnp.sum(p, axis=-1, keepdims=True) + jnp.exp(sink - m)
        p = (p / denom).astype(vj.dtype)
        return jnp.einsum('bgrqk,bkgd->bqgrd', p, vj)

    out = lax.map(block, (jnp.arange(nb), qb))
    return out.swapaxes(0, 1).reshape(B, S, G, R, Dh)


def compress_blocks(kv, pe, w1, w2):
    B, S, G, Dh = kv.shape
    n_cmp = (S - NSA_CMP_LEN) // NSA_CMP_STRIDE + 1
    idx = jnp.arange(n_cmp)[:, None] * NSA_CMP_STRIDE + jnp.arange(NSA_CMP_LEN)[None, :]
    blocks = kv[:, idx] + pe[None, None, :, None, :]
    flat = blocks.transpose(0, 1, 3, 2, 4).reshape(B, n_cmp, G, NSA_CMP_LEN * Dh)
    return jax.nn.gelu(flat @ w1) @ w2


def nsa_compressed_selected(q, k_cmp, v_cmp, k_slc, v_slc, slopes):
    B, S, G, R, Dh = q.shape
    n_cmp = k_cmp.shape[1]
    n_slc = S // NSA_SLC_LEN
    k_sel = min(NSA_TOPK, n_slc)
    nc = S // NSA_Q_CHUNK
    scale = Dh ** -0.5
    slope = slopes.astype(jnp.float32)
    cmp_start = jnp.arange(n_cmp) * NSA_CMP_STRIDE
    cmp_end = cmp_start + NSA_CMP_LEN - 1
    slc_start = jnp.arange(n_slc) * NSA_SLC_LEN
    overlap = ((cmp_start[:, None] < slc_start[None, :] + NSA_SLC_LEN)
               & (cmp_end[:, None] >= slc_start[None, :])).astype(jnp.float32)
    ks_blocks = k_slc.reshape(B, n_slc, NSA_SLC_LEN, G, Dh).transpose(0, 3, 1, 2, 4)
    vs_blocks = v_slc.reshape(B, n_slc, NSA_SLC_LEN, G, Dh).transpose(0, 3, 1, 2, 4)
    bi = jnp.arange(B)[:, None, None, None]
    gi = jnp.arange(G)[None, :, None, None]
    blk = jnp.arange(n_slc)
    qc = q.reshape(B, nc, NSA_Q_CHUNK, G, R, Dh).swapaxes(0, 1)

    def chunk(args):
        c, qj = args
        t = c * NSA_Q_CHUNK + jnp.arange(NSA_Q_CHUNK)
        dist_c = (t[:, None] - cmp_end[None, :]).astype(jnp.float32)
        lc = jnp.einsum('bqgrd,bngd->bgrqn', qj, k_cmp).astype(jnp.float32) * scale
        lc = lc - slope[None, :, :, None, None] * dist_c
        lc = jnp.where(dist_c >= 0, lc, -jnp.inf)
        mc = jnp.max(lc, axis=-1, keepdims=True)
        mc = jnp.where(jnp.isfinite(mc), mc, 0.0)
        pc = jnp.exp(lc - mc)
        dc = jnp.sum(pc, axis=-1, keepdims=True)
        pc = pc / jnp.where(dc > 0, dc, 1.0)
        o_cmp = jnp.einsum('bgrqn,bngd->bqgrd', pc.astype(v_cmp.dtype), v_cmp)
        imp = jnp.einsum('bgrqn,nj->bgqj', pc, overlap)
        cur = t // NSA_SLC_LEN
        valid = slc_start[None, :] <= t[:, None]
        forced = (blk[None, :] == 0) | (blk[None, :] == cur[:, None]) | (blk[None, :] == cur[:, None] - 1)
        score = jnp.where(forced, jnp.inf, imp)
        score = jnp.where(valid, score, -jnp.inf)
        top_s, top_i = lax.top_k(score, k_sel)
        kg = ks_blocks[bi, gi, top_i]
        vg = vs_blocks[bi, gi, top_i]
        pos = top_i[..., None] * NSA_SLC_LEN + jnp.arange(NSA_SLC_LEN)
        dist_s = t[None, None, :, None, None] - pos
        ok = (top_s > -jnp.inf)[..., None] & (dist_s >= 0)
        ls = jnp.einsum('bqgrd,bgqkld->bgrqkl', qj, kg).astype(jnp.float32) * scale
        ls = ls - slope[None, :, :, None, None, None] * dist_s.astype(jnp.float32)[:, :, None]
        ls = jnp.where(ok[:, :, None], ls, -jnp.inf)
        ps = jax.nn.softmax(ls.reshape(B, G, R, NSA_Q_CHUNK, k_sel * NSA_SLC_LEN), axis=-1)
        ps = ps.reshape(B, G, R, NSA_Q_CHUNK, k_sel, NSA_SLC_LEN).astype(vg.dtype)
        o_slc = jnp.einsum('bgrqkl,bgqkld->bqgrd', ps, vg)
        return o_cmp, o_slc

    o_cmp, o_slc = lax.map(chunk, (jnp.arange(nc), qc))
    o_cmp = o_cmp.swapaxes(0, 1).reshape(B, S, G, R, Dh)
    o_slc = o_slc.swapaxes(0, 1).reshape(B, S, G, R, Dh)
    return o_cmp, o_slc


def hybrid_mixer(x, w_in, b_in, sinks, pe_k, w1_k, w2_k, pe_v, w1_v, w2_v, w_out, b_out):
    B, S, _ = x.shape
    Dh = HEAD_DIM
    proj = x @ w_in + b_in
    sizes = [SWA_Q_W, SWA_KV_W, SWA_KV_W, NSA_Q_W, 6 * NSA_KV_W, NSA_GATE_W]
    offs = []
    acc = 0
    for n in sizes[:-1]:
        acc += n
        offs.append(acc)
    qa, ka, va, qn, kvn, gn = jnp.split(proj, offs, axis=-1)
    slopes_a, slopes_n = alibi_slopes()
    ra = SWA_HEADS // SWA_KV_HEADS
    qa = qa.reshape(B, S, SWA_KV_HEADS, ra, Dh)
    ka = ka.reshape(B, S, SWA_KV_HEADS, Dh)
    va = va.reshape(B, S, SWA_KV_HEADS, Dh)
    o_a = banded_attention(qa, ka, va, slopes_a.reshape(SWA_KV_HEADS, ra), SWA_WINDOW,
                           sinks.reshape(SWA_KV_HEADS, ra))
    rn = NSA_HEADS // NSA_KV_GROUPS
    qn = qn.reshape(B, S, NSA_KV_GROUPS, rn, Dh)
    kvn = kvn.reshape(B, S, 6, NSA_KV_GROUPS, Dh)
    k_cmp = compress_blocks(kvn[:, :, 0], pe_k, w1_k, w2_k)
    v_cmp = compress_blocks(kvn[:, :, 1], pe_v, w1_v, w2_v)
    sl_n = slopes_n.reshape(NSA_KV_GROUPS, rn)
    o_cmp, o_slc = nsa_compressed_selected(qn, k_cmp, v_cmp, kvn[:, :, 2], kvn[:, :, 3], sl_n)
    o_win = banded_attention(qn, kvn[:, :, 4], kvn[:, :, 5], sl_n, NSA_WINDOW)
    g = jax.nn.sigmoid(gn).reshape(B, S, NSA_KV_GROUPS, rn, 3, 1)
    o_n = g[..., 0, :] * o_cmp + g[..., 1, :] * o_slc + g[..., 2, :] * o_win
    o = jnp.concatenate([o_a.reshape(B, S, SWA_Q_W), o_n.reshape(B, S, NSA_Q_W)], axis=-1)
    return o @ w_out + b_out


def hier_moe(x, w_group, b_group, w_expert, b_expert, we_gate, we_up, we_down):
    B, S, D = x.shape
    N = B * S
    T = EXPERT_ROWS
    xf = x.reshape(N, D)
    g_logits = (xf @ w_group + b_group).astype(jnp.float32)
    g_prob = jax.nn.softmax(g_logits, axis=-1)
    g_sel = jnp.argmax(g_logits, axis=-1)
    g_w = jnp.take_along_axis(g_prob, g_sel[:, None], axis=-1)
    e_logits = (xf @ w_expert + b_expert).astype(jnp.float32).reshape(N, N_GROUPS, EXPERTS_PER_GROUP)
    e_logits = jnp.take_along_axis(e_logits, g_sel[:, None, None], axis=1)[:, 0]
    top_v, top_local = lax.top_k(e_logits, EXPERT_TOPK)
    e_w = jax.nn.softmax(top_v, axis=-1) * g_w
    eid = (g_sel[:, None] * EXPERTS_PER_GROUP + top_local).reshape(-1)
    wts = e_w.reshape(-1)
    tok = jnp.repeat(jnp.arange(N, dtype=jnp.int32), EXPERT_TOPK)
    A = N * EXPERT_TOPK
    order = jnp.argsort(eid)
    eid_s, tok_s, w_s = eid[order], tok[order], wts[order]
    counts = jnp.bincount(eid, length=N_EXPERTS)
    padded = (counts + T - 1) // T * T
    start = jnp.cumsum(counts) - counts
    pend = jnp.cumsum(padded)
    pstart = pend - padded
    dest = pstart[eid_s] + (jnp.arange(A) - start[eid_s])
    P = A + N_EXPERTS * T
    nblk = P // T
    row_tok = jnp.full((P,), N, dtype=jnp.int32).at[dest].set(tok_s)
    x_pad = jnp.concatenate([xf, jnp.zeros((1, D), xf.dtype)], axis=0)
    xb = x_pad[row_tok].reshape(nblk, T, D)
    blk_e = jnp.minimum(jnp.searchsorted(pend, jnp.arange(nblk) * T, side='right'), N_EXPERTS - 1)

    def run(args):
        e, xr = args
        h = jax.nn.silu(xr @ we_gate[e]) * (xr @ we_up[e])
        return h @ we_down[e]

    yb = lax.map(run, (blk_e, xb)).reshape(P, D)
    y = jax.ops.segment_sum(yb[dest] * w_s[:, None].astype(yb.dtype), tok_s, num_segments=N)
    return y.reshape(B, S, D)


def setup_inputs(seed: int = 0) -> dict:
    key = jax.random.key(seed)
    ks = jax.random.split(key, 24)
    D, L, Dh = D_MODEL, DEPTH, HEAD_DIM
    nrm = jax.random.normal
    segs = [(SWA_Q_W, 1.0), (SWA_KV_W, 1.0), (SWA_KV_W, BETA), (NSA_Q_W, 1.0)]
    segs += [(NSA_KV_W, 1.0 if i % 2 == 0 else BETA) for i in range(6)]
    segs += [(NSA_GATE_W, 1.0)]
    col_scale = jnp.asarray(np.concatenate([np.full(n, s, np.float32) for n, s in segs]))
    flat_in = NSA_CMP_LEN * Dh
    return {
        'x': nrm(ks[0], (BATCH, SEQ, D), jnp.float32),
        'w_in': nrm(ks[1], (L, D, IN_COLS), jnp.float32) * D ** -0.5 * col_scale,
        'b_in': nrm(ks[2], (L, IN_COLS), jnp.float32) * 0.02,
        'swa_sinks': nrm(ks[3], (L, SWA_HEADS), jnp.float32) * 0.5,
        'cmp_pe_k': nrm(ks[4], (L, NSA_CMP_LEN, Dh), jnp.float32) * 0.5,
        'cmp_w1_k': nrm(ks[5], (L, flat_in, NSA_CMP_HIDDEN), jnp.float32) * flat_in ** -0.5,
        'cmp_w2_k': nrm(ks[6], (L, NSA_CMP_HIDDEN, Dh), jnp.float32) * NSA_CMP_HIDDEN ** -0.5,
        'cmp_pe_v': nrm(ks[7], (L, NSA_CMP_LEN, Dh), jnp.float32) * 0.5,
        'cmp_w1_v': nrm(ks[8], (L, flat_in, NSA_CMP_HIDDEN), jnp.float32) * flat_in ** -0.5,
        'cmp_w2_v': nrm(ks[9], (L, NSA_CMP_HIDDEN, Dh), jnp.float32) * NSA_CMP_HIDDEN ** -0.5,
        'w_out': nrm(ks[10], (L, MIX_WIDTH, D), jnp.float32) * MIX_WIDTH ** -0.5 * BETA,
        'b_out': nrm(ks[11], (L, D), jnp.float32) * 0.02,
        'ln1_g': 1.0 + 0.05 * nrm(ks[12], (L, D), jnp.float32),
        'ln1_b': 0.02 * nrm(ks[13], (L, D), jnp.float32),
        'w_group': nrm(ks[14], (L, D, N_GROUPS), jnp.float32) * D ** -0.5,
        'b_group': nrm(ks[15], (L, N_GROUPS), jnp.float32) * 0.01,
        'w_expert': nrm(ks[16], (L, D, N_EXPERTS), jnp.float32) * D ** -0.5,
        'b_expert': nrm(ks[17], (L, N_EXPERTS), jnp.float32) * 0.01,
        'we_gate': nrm(ks[18], (L, N_EXPERTS, D, EXPERT_HIDDEN), jnp.float32) * D ** -0.5,
        'we_up': nrm(ks[19], (L, N_EXPERTS, D, EXPERT_HIDDEN), jnp.float32) * D ** -0.5,
        'we_down': nrm(ks[20], (L, N_EXPERTS, EXPERT_HIDDEN, D), jnp.float32) * EXPERT_HIDDEN ** -0.5 * BETA,
        'ln2_g': 1.0 + 0.05 * nrm(ks[21], (L, D), jnp.float32),
        'ln2_b': 0.02 * nrm(ks[22], (L, D), jnp.float32),
    }


def reference(x, w_in, b_in, swa_sinks, cmp_pe_k, cmp_w1_k, cmp_w2_k, cmp_pe_v, cmp_w1_v,
              cmp_w2_v, w_out, b_out, ln1_g, ln1_b, w_group, b_group, w_expert, b_expert,
              we_gate, we_up, we_down, ln2_g, ln2_b):
    for l in range(DEPTH):
        mix = hybrid_mixer(x, w_in[l], b_in[l], swa_sinks[l], cmp_pe_k[l], cmp_w1_k[l], cmp_w2_k[l],
                           cmp_pe_v[l], cmp_w1_v[l], cmp_w2_v[l], w_out[l], b_out[l])
        x = layer_norm(ALPHA * x + mix, ln1_g[l], ln1_b[l])
        ffn = hier_moe(x, w_group[l], b_group[l], w_expert[l], b_expert[l],
                       we_gate[l], we_up[l], we_down[l])
        x = layer_norm(ALPHA * x + ffn, ln2_g[l], ln2_b[l])
    return x
```

```cpp
#include <hip/hip_runtime.h>
#include <cstdio>
#include <cstdint>
#include <cmath>

#ifndef ONE_LAUNCH
#define ONE_LAUNCH 0
#endif

#define LAS __attribute__((address_space(3)))
typedef unsigned short bf16;
typedef short bf16x8 __attribute__((ext_vector_type(8)));
typedef float f32x4 __attribute__((ext_vector_type(4)));
typedef unsigned u32x4 __attribute__((ext_vector_type(4)));

constexpr int DM = 2048, SEQ = 4096, NB = 4, MTOK = NB * SEQ, DEPTH = 2;
constexpr int INC = 3120, PP = 3200;
constexpr int C_QA = 0, C_KA = 1024, C_VA = 1152, C_QN = 1280, C_KV = 2304, C_GN = 3072;
constexpr int NCMP = 255, CMPROWS = NB * NCMP * 2;
constexpr int NE = 64, EH = 512, LCAP = MTOK;
constexpr int NLOG = 80;
constexpr float ALPHA = 1.41421356237309515f;
constexpr float LN_EPS = 1e-5f;
constexpr int NPH = 11;

constexpr size_t MiB = 1u << 20;
constexpr size_t WS_CTL = 0, CTL_BYTES = 1 * MiB;
constexpr size_t WS_PROJ = 2 * MiB;
constexpr size_t WS_O = 102 * MiB;
constexpr size_t WS_Y = 166 * MiB;
constexpr size_t WS_X1 = 294 * MiB;
constexpr size_t WS_X2 = 422 * MiB;
constexpr size_t WS_HB = 550 * MiB;
constexpr size_t WS_KVC = 554 * MiB;
constexpr size_t WS_LOG = 555 * MiB;
constexpr size_t WS_LSLOT = 561 * MiB;
constexpr size_t WS_LW = 565 * MiB;
constexpr size_t WS_H = 569 * MiB;
constexpr size_t WS_CONTRIB = 601 * MiB;
constexpr size_t WS_END = 857 * MiB;
constexpr int CW_BAR = 4096;
constexpr int CW_CNT = 16384;

constexpr int L_GEMM = 0;
constexpr int L_TAB = 24576;
constexpr int L_BARW = 28672;
constexpr int L_ATT = 32768;
constexpr int LDS_BYTES = 98304;

__device__ __forceinline__ float bf2f(unsigned h) { return __uint_as_float(h << 16); }
__device__ __forceinline__ unsigned cvt_pk_bf16(float lo, float hi) { unsigned r; asm("v_cvt_pk_bf16_f32 %0, %1, %2" : "=v"(r) : "v"(lo), "v"(hi)); return r; }
__device__ __forceinline__ bf16 f2bf(float f) { return (bf16)(cvt_pk_bf16(f, 0.f) & 0xffffu); }
__device__ __forceinline__ float wave_sum(float v) {
#pragma unroll
    for (int o = 1; o < 64; o <<= 1) v += __shfl_xor(v, o);
    return v;
}
__device__ __forceinline__ float wave_max(float v) {
#pragma unroll
    for (int o = 1; o < 64; o <<= 1) v = fmaxf(v, __shfl_xor(v, o));
    return v;
}
__device__ __forceinline__ float gelu_tanh(float x) {
    const float u = 0.7978845608028654f * (x + 0.044715f * x * x * x);
    const float e = expf(2.f * u);
    const float th = 1.f - 2.f / (e + 1.f);
    return 0.5f * x * (1.f + th);
}
__device__ __forceinline__ float sigmoidf(float x) { return 1.f / (1.f + expf(-x)); }
__device__ __forceinline__ float rfl(float v) { return __builtin_bit_cast(float, __builtin_amdgcn_readfirstlane(__builtin_bit_cast(int, v))); }
#define WAVE_LDS_FENCE() do { asm volatile("s_waitcnt lgkmcnt(0)" ::: "memory"); __builtin_amdgcn_wave_barrier(); } while (0)

#define XB_TMO      128
#define XB_XCNT(j)  (256  + 64 * (j))
#define XB_XSUB(j)  (1280 + 64 * (j))
#define XB_XGEN(j)  (2304 + 64 * (j))
#define XB_TOP      3328
#define XB_TOPGEN   3392
#define XCD_BAR_WORDS 3456
#define XB_SPIN_CAP (1u << 24)

__device__ __forceinline__ unsigned xb_ld(unsigned* p)              { return __hip_atomic_load(p, __ATOMIC_RELAXED, __HIP_MEMORY_SCOPE_AGENT); }
__device__ __forceinline__ unsigned xb_add(unsigned* p, unsigned v) { return __hip_atomic_fetch_add(p, v, __ATOMIC_RELAXED, __HIP_MEMORY_SCOPE_AGENT); }
__device__ __forceinline__ unsigned xb_xcc_id() { return (unsigned)__builtin_amdgcn_s_getreg((3 << 11) | 20) & 0xFu; }
#define XB_SPIN(cond, bar) do { unsigned _sp = 0; while (cond) { __builtin_amdgcn_s_sleep(1); \
    if ((++_sp & 255u) == 0u) { if (xb_ld(&(bar)[XB_TMO])) break; if (_sp > XB_SPIN_CAP) { atomicAdd(&(bar)[XB_TMO], 1u); break; } } } } while (0)

struct XcdBarrier { unsigned* bar; unsigned x; volatile LAS unsigned* st; };

__device__ __forceinline__ XcdBarrier xcd_barrier_post(unsigned* bar, volatile LAS unsigned* st) {
    XcdBarrier b; b.bar = bar; b.x = xb_xcc_id(); b.st = st;
    if (threadIdx.x == 0) (void)xb_add(&bar[XB_XCNT(b.x)], 1u);
    return b;
}
__device__ __forceinline__ void xcd_barrier_complete(unsigned* bar, unsigned x, unsigned& nloc, unsigned& nx) {
    const unsigned G = gridDim.x * gridDim.y * gridDim.z;
    unsigned sum, cnt, mine, sp = 0u;
    for (;;) {
        sum = 0u; cnt = 0u; mine = 0u;
#pragma unroll
        for (unsigned j = 0; j < 16; ++j) { const unsigned c = xb_ld(&bar[XB_XCNT(j)]); sum += c; cnt += (c > 0u) ? 1u : 0u; mine = (j == x) ? c : mine; }
        if (sum == G) break;
        __builtin_amdgcn_s_sleep(1);
        if ((++sp & 255u) == 0u) { if (xb_ld(&bar[XB_TMO])) break; if (sp > XB_SPIN_CAP) { atomicAdd(&bar[XB_TMO], 1u); break; } }
    }
    nloc = mine > 0u ? mine : 1u; nx = cnt > 0u ? cnt : 1u;
}
__device__ __forceinline__ void xcd_barrier(const XcdBarrier& b) {
    asm volatile("s_waitcnt vmcnt(0)" ::: "memory");
    __syncthreads();
    if (threadIdx.x == 0) {
        unsigned* bar = b.bar;
        __builtin_amdgcn_s_waitcnt(0);
        unsigned nloc = b.st[0], nx = b.st[1];
        if (nloc == 0u) { xcd_barrier_complete(bar, b.x, nloc, nx); b.st[0] = nloc; b.st[1] = nx; }
        const unsigned old = xb_add(&bar[XB_XSUB(b.x)], 1u);
        const unsigned gen = old / nloc;
        if (old + 1u == (gen + 1u) * nloc) {
            __builtin_amdgcn_fence(__ATOMIC_RELEASE, "agent");
            asm volatile("s_waitcnt vmcnt(0)" ::: "memory");
            const unsigned og = xb_add(&bar[XB_TOP], 1u);
            const unsigned tg = og / nx;
            if (og + 1u == (tg + 1u) * nx) xb_add(&bar[XB_TOPGEN], 1u);
            else XB_SPIN(xb_ld(&bar[XB_TOPGEN]) == tg, bar);
            __builtin_amdgcn_fence(__ATOMIC_ACQUIRE, "agent");
            xb_add(&bar[XB_XGEN(b.x)], 1u);
            asm volatile("s_waitcnt vmcnt(0)" ::: "memory");
        } else {
            XB_SPIN(xb_ld(&bar[XB_XGEN(b.x)]) == gen, bar);
            __builtin_amdgcn_fence(__ATOMIC_ACQUIRE, "agent");
            asm volatile("s_waitcnt vmcnt(0)" ::: "memory");
        }
    }
    __syncthreads();
}

template <class AL, class BL, class EP>
__device__ __forceinline__ void gemm_tile(LAS unsigned char* lds, const AL& al, const BL& bl, const EP& ep, int K) {
    const int tid = threadIdx.x, wid = tid >> 6, lane = tid & 63, wr = wid >> 2, wc = wid & 3, fr = lane & 15, fq = lane >> 4;
    LAS bf16* As = (LAS bf16*)(lds + L_GEMM);
    LAS bf16* Bs = As + 128 * 40;
    const int ar = tid >> 2, akq = (tid & 3) * 8;
    const int bn = tid & 127, bkg = (tid >> 7) * 8;
    f32x4 acc[4][2];
#pragma unroll
    for (int m = 0; m < 4; ++m)
#pragma unroll
        for (int n = 0; n < 2; ++n) acc[m][n] = (f32x4){0.f, 0.f, 0.f, 0.f};
    bf16x8 ra = al.load(akq);
    float rb0 = bl.load(bkg + 0), rb1 = bl.load(bkg + 1), rb2 = bl.load(bkg + 2), rb3 = bl.load(bkg + 3),
          rb4 = bl.load(bkg + 4), rb5 = bl.load(bkg + 5), rb6 = bl.load(bkg + 6), rb7 = bl.load(bkg + 7);
    for (int k0 = 0; k0 < K; k0 += 32) {
        *(LAS bf16x8*)(As + ar * 40 + akq) = ra;
        u32x4 pb; pb.x = cvt_pk_bf16(rb0, rb1); pb.y = cvt_pk_bf16(rb2, rb3); pb.z = cvt_pk_bf16(rb4, rb5); pb.w = cvt_pk_bf16(rb6, rb7);
        *(LAS u32x4*)(Bs + bn * 40 + bkg) = pb;
        __syncthreads();
        if (k0 + 32 < K) {
            const int kn = k0 + 32;
            ra = al.load(kn + akq);
            rb0 = bl.load(kn + bkg + 0); rb1 = bl.load(kn + bkg + 1); rb2 = bl.load(kn + bkg + 2); rb3 = bl.load(kn + bkg + 3);
            rb4 = bl.load(kn + bkg + 4); rb5 = bl.load(kn + bkg + 5); rb6 = bl.load(kn + bkg + 6); rb7 = bl.load(kn + bkg + 7);
        }
        bf16x8 af[4], bfr[2];
#pragma unroll
        for (int m = 0; m < 4; ++m) af[m] = *(const LAS bf16x8*)(As + (wr * 64 + m * 16 + fr) * 40 + fq * 8);
#pragma unroll
        for (int n = 0; n < 2; ++n) bfr[n] = *(const LAS bf16x8*)(Bs + (wc * 32 + n * 16 + fr) * 40 + fq * 8);
#pragma unroll
        for (int m = 0; m < 4; ++m)
#pragma unroll
            for (int n = 0; n < 2; ++n) acc[m][n] = __builtin_amdgcn_mfma_f32_16x16x32_bf16(af[m], bfr[n], acc[m][n], 0, 0, 0);
        __syncthreads();
    }
    ep(acc, wr, wc, fr, fq);
}

__device__ __forceinline__ bf16x8 pack8(f32x4 a, f32x4 b) {
    u32x4 p; p.x = cvt_pk_bf16(a.x, a.y); p.y = cvt_pk_bf16(a.z, a.w); p.z = cvt_pk_bf16(b.x, b.y); p.w = cvt_pk_bf16(b.z, b.w);
    return __builtin_bit_cast(bf16x8, p);
}
__device__ __forceinline__ bf16x8 zero8() { u32x4 p = {0u, 0u, 0u, 0u}; return __builtin_bit_cast(bf16x8, p); }

struct ALf32 { const float* rowp; __device__ __forceinline__ bf16x8 load(int k) const { if (!rowp) return zero8(); const f32x4 a = *(const f32x4*)(rowp + k), b = *(const f32x4*)(rowp + k + 4); return pack8(a, b); } };
struct ALbf16 { const bf16* rowp; __device__ __forceinline__ bf16x8 load(int k) const { if (!rowp) return zero8(); return *(const bf16x8*)(rowp + k); } };
struct ALcmp { const bf16* base; const float* pe; __device__ __forceinline__ bf16x8 load(int k) const {
        if (!base) return zero8();
        const int l = k >> 6, d = k & 63;
        const u32x4 v = *(const u32x4*)(base + (size_t)l * PP + d);
        const f32x4 p0 = *(const f32x4*)(pe + k), p1 = *(const f32x4*)(pe + k + 4);
        f32x4 a, b;
        a.x = bf2f(v.x & 0xffffu) + p0.x; a.y = bf2f(v.x >> 16) + p0.y; a.z = bf2f(v.y & 0xffffu) + p0.z; a.w = bf2f(v.y >> 16) + p0.w;
        b.x = bf2f(v.z & 0xffffu) + p1.x; b.y = bf2f(v.z >> 16) + p1.y; b.z = bf2f(v.w & 0xffffu) + p1.z; b.w = bf2f(v.w >> 16) + p1.w;
        return pack8(a, b); } };
struct BLf32 { const float* colp; size_t ldb; __device__ __forceinline__ float load(int k) const { return colp ? colp[(size_t)k * ldb] : 0.f; } };

struct Args { const float* in[23]; float* out; unsigned char* ws; int lo, hi; };

struct Ctx {
    LAS unsigned char* lds;
    int tid, lane, wid;
    const Args* a;
    __device__ __forceinline__ const float* x_in() const { return a->in[0]; }
    __device__ __forceinline__ const float* w_in() const { return a->in[1]; }
    __device__ __forceinline__ const float* b_in() const { return a->in[2]; }
    __device__ __forceinline__ const float* sinks() const { return a->in[3]; }
    __device__ __forceinline__ const float* pe_k() const { return a->in[4]; }
    __device__ __forceinline__ const float* w1_k() const { return a->in[5]; }
    __device__ __forceinline__ const float* w2_k() const { return a->in[6]; }
    __device__ __forceinline__ const float* pe_v() const { return a->in[7]; }
    __device__ __forceinline__ const float* w1_v() const { return a->in[8]; }
    __device__ __forceinline__ const float* w2_v() const { return a->in[9]; }
    __device__ __forceinline__ const float* w_out() const { return a->in[10]; }
    __device__ __forceinline__ const float* b_out() const { return a->in[11]; }
    __device__ __forceinline__ const float* ln1_g() const { return a->in[12]; }
    __device__ __forceinline__ const float* ln1_b() const { return a->in[13]; }
    __device__ __forceinline__ const float* w_group() const { return a->in[14]; }
    __device__ __forceinline__ const float* b_group() const { return a->in[15]; }
    __device__ __forceinline__ const float* w_expert() const { return a->in[16]; }
    __device__ __forceinline__ const float* b_expert() const { return a->in[17]; }
    __device__ __forceinline__ const float* we_gate() const { return a->in[18]; }
    __device__ __forceinline__ const float* we_up() const { return a->in[19]; }
    __device__ __forceinline__ const float* we_down() const { return a->in[20]; }
    __device__ __forceinline__ const float* ln2_g() const { return a->in[21]; }
    __device__ __forceinline__ const float* ln2_b() const { return a->in[22]; }
    __device__ __forceinline__ float* out() const { return a->out; }
    __device__ __forceinline__ bf16* proj() const { return (bf16*)(a->ws + WS_PROJ); }
    __device__ __forceinline__ bf16* o() const { return (bf16*)(a->ws + WS_O); }
    __device__ __forceinline__ bf16* kvc() const { return (bf16*)(a->ws + WS_KVC); }
    __device__ __forceinline__ bf16* H() const { return (bf16*)(a->ws + WS_H); }
    __device__ __forceinline__ float* y() const { return (float*)(a->ws + WS_Y); }
    __device__ __forceinline__ float* x1() const { return (float*)(a->ws + WS_X1); }
    __device__ __forceinline__ float* x2() const { return (float*)(a->ws + WS_X2); }
    __device__ __forceinline__ float* hb() const { return (float*)(a->ws + WS_HB); }
    __device__ __forceinline__ float* logits() const { return (float*)(a->ws + WS_LOG); }
    __device__ __forceinline__ float* lw() const { return (float*)(a->ws + WS_LW); }
    __device__ __forceinline__ float* contrib() const { return (float*)(a->ws + WS_CONTRIB); }
    __device__ __forceinline__ int* lslot() const { return (int*)(a->ws + WS_LSLOT); }
    __device__ __forceinline__ unsigned* cnt() const { return (unsigned*)(a->ws + WS_CTL) + CW_CNT; }
};

struct AttnState { float m[8], l[8], o[8]; };

__device__ __forceinline__ void load_q(LAS float* qs, const bf16* qrow, int lane) {
    const u32x4 v = *(const u32x4*)(qrow + lane * 8);
    const int h = lane >> 3, d0 = (lane & 7) * 8;
    qs[(d0 + 0) * 8 + h] = bf2f(v.x & 0xffffu) * 0.125f; qs[(d0 + 1) * 8 + h] = bf2f(v.x >> 16) * 0.125f;
    qs[(d0 + 2) * 8 + h] = bf2f(v.y & 0xffffu) * 0.125f; qs[(d0 + 3) * 8 + h] = bf2f(v.y >> 16) * 0.125f;
    qs[(d0 + 4) * 8 + h] = bf2f(v.z & 0xffffu) * 0.125f; qs[(d0 + 5) * 8 + h] = bf2f(v.z >> 16) * 0.125f;
    qs[(d0 + 6) * 8 + h] = bf2f(v.w & 0xffffu) * 0.125f; qs[(d0 + 7) * 8 + h] = bf2f(v.w >> 16) * 0.125f;
    WAVE_LDS_FENCE();
}
__device__ __forceinline__ void tile_scores(float (&s)[8], const bf16* krow, bool valid, const LAS float* qs) {
#pragma unroll
    for (int h = 0; h < 8; ++h) s[h] = 0.f;
    if (valid) {
#pragma unroll 1
        for (int i = 0; i < 8; ++i) {
            const u32x4 kv = *(const u32x4*)(krow + i * 8);
            const unsigned w[4] = {kv.x, kv.y, kv.z, kv.w};
#pragma unroll
            for (int wi = 0; wi < 4; ++wi) {
#pragma unroll
                for (int e = 0; e < 2; ++e) {
                    const float kf = e ? __uint_as_float(w[wi] & 0xffff0000u) : __uint_as_float(w[wi] << 16);
                    const int d = i * 8 + wi * 2 + e;
                    const f32x4 qa = *(const LAS f32x4*)(qs + d * 8), qb = *(const LAS f32x4*)(qs + d * 8 + 4);
                    s[0] += kf * qa.x; s[1] += kf * qa.y; s[2] += kf * qa.z; s[3] += kf * qa.w;
                    s[4] += kf * qb.x; s[5] += kf * qb.y; s[6] += kf * qb.z; s[7] += kf * qb.w;
                }
            }
        }
    }
}
__device__ __forceinline__ void tile_pv(float (&o)[8], const float (&p)[8], const bf16* vlane, long pitch, int jlo, int jhi, LAS float* ps, int lane) {
    *(LAS f32x4*)(ps + lane * 8) = (f32x4){p[0], p[1], p[2], p[3]};
    *(LAS f32x4*)(ps + lane * 8 + 4) = (f32x4){p[4], p[5], p[6], p[7]};
    WAVE_LDS_FENCE();
    for (int j = jlo; j <= jhi; ++j) {
        const float v = bf2f(vlane[(long)j * pitch]);
        const f32x4 pa = *(const LAS f32x4*)(ps + j * 8), pb = *(const LAS f32x4*)(ps + j * 8 + 4);
        o[0] += pa.x * v; o[1] += pa.y * v; o[2] += pa.z * v; o[3] += pa.w * v;
        o[4] += pb.x * v; o[5] += pb.y * v; o[6] += pb.z * v; o[7] += pb.w * v;
    }
    WAVE_LDS_FENCE();
}
__device__ __forceinline__ void tile_update(AttnState& st, const float (&s)[8], const bf16* vlane, long pitch, int jlo, int jhi, LAS float* ps, int lane) {
    float p[8];
#pragma unroll
    for (int h = 0; h < 8; ++h) {
        const float tm = wave_max(s[h]);
        const float mn = fmaxf(st.m[h], tm);
        float corr = 1.f, ph = 0.f;
        if (mn != -INFINITY) { corr = expf(st.m[h] - mn); ph = expf(s[h] - mn); }
        st.l[h] = rfl(st.l[h] * corr + wave_sum(ph));
        st.o[h] *= corr; st.m[h] = rfl(mn); p[h] = ph;
    }
    tile_pv(st.o, p, vlane, pitch, jlo, jhi, ps, lane);
}

__device__ __forceinline__ void swa_job(const Ctx& c, int L, int job, LAS float* qs, LAS float* ps) {
    const int lane = c.lane;
    const int t = job & (SEQ - 1), bg = job >> 12, g = bg & 1, b = bg >> 1;
    const size_t row = (size_t)b * SEQ + t;
    load_q(qs, c.proj() + row * PP + C_QA + g * 512, lane);
    AttnState st; float slope[8];
#pragma unroll
    for (int h = 0; h < 8; ++h) { const int a = g * 8 + h; slope[h] = rfl(exp2f(-(float)(2 * a + 1) * 0.25f)); st.m[h] = rfl(c.sinks()[L * 16 + a]); st.l[h] = 1.f; st.o[h] = 0.f; }
    for (int i = 0; i < 2; ++i) {
        const int r0 = t - 64 * (i + 1) + 1;
        if (r0 + 63 < 0) break;
        const int pos = r0 + lane; const bool valid = pos >= 0; const int jlo = r0 < 0 ? -r0 : 0;
        const bf16* krow = c.proj() + ((size_t)b * SEQ + (valid ? pos : 0)) * PP + C_KA + g * 64;
        float s[8]; tile_scores(s, krow, valid, qs);
        const float dist = (float)(t - pos);
#pragma unroll
        for (int h = 0; h < 8; ++h) s[h] = valid ? s[h] - slope[h] * dist : -INFINITY;
        const bf16* vlane = c.proj() + (long)((long)b * SEQ + r0) * PP + C_VA + g * 64 + lane;
        tile_update(st, s, vlane, PP, jlo, 63, ps, lane);
    }
#pragma unroll
    for (int h = 0; h < 8; ++h) c.o()[row * DM + (g * 8 + h) * 64 + lane] = f2bf(st.o[h] / st.l[h]);
}

__device__ __forceinline__ void nsa_job(const Ctx& c, int L, int job, LAS float* qs, LAS float* ps, LAS float* pimp) {
    const int lane = c.lane;
    const int t = job & (SEQ - 1), bg = job >> 12, g = bg & 1, b = bg >> 1;
    const size_t row = (size_t)b * SEQ + t;
    const bf16* prow = c.proj() + row * PP;
    load_q(qs, prow + C_QN + g * 512, lane);
    float slope[8];
#pragma unroll
    for (int h = 0; h < 8; ++h) slope[h] = rfl(exp2f(-(float)(g * 8 + h + 1) * 0.5f));
    float ocmp[8];
#pragma unroll
    for (int h = 0; h < 8; ++h) ocmp[h] = 0.f;
    float impv = 0.f;
    int nv = 0;
    if (t >= 31) { nv = ((t - 31) >> 4) + 1; if (nv > NCMP) nv = NCMP; }
    if (nv > 0) {
        const bf16* kc = c.kvc() + ((size_t)(b * NCMP) * 2 + g) * 64;
        const bf16* vc = c.kvc() + (size_t)2048 * 64 + ((size_t)(b * NCMP) * 2 + g) * 64;
        const int ntile = (nv + 63) >> 6;
        float cm[8], cl[8];
#pragma unroll
        for (int h = 0; h < 8; ++h) { cm[h] = -INFINITY; cl[h] = 0.f; }
#pragma unroll 1
        for (int ti = 0; ti < ntile; ++ti) {
            const int n = ti * 64 + lane; const bool valid = n < nv;
            float s[8]; tile_scores(s, kc + (size_t)(valid ? n : 0) * 128, valid, qs);
            const float dist = (float)(t - 16 * n - 31);
#pragma unroll
            for (int h = 0; h < 8; ++h) {
                const float sv = valid ? s[h] - slope[h] * dist : -INFINITY;
                const float mn = fmaxf(cm[h], wave_max(sv));
                cl[h] = rfl(cl[h] * expf(cm[h] - mn) + wave_sum(expf(sv - mn))); cm[h] = rfl(mn);
            }
        }
#pragma unroll
        for (int h = 0; h < 8; ++h) cl[h] = rfl(1.f / cl[h]);
#pragma unroll 1
        for (int ti = 0; ti < ntile; ++ti) {
            const int n = ti * 64 + lane; const bool valid = n < nv;
            float s[8]; tile_scores(s, kc + (size_t)(valid ? n : 0) * 128, valid, qs);
            const float dist = (float)(t - 16 * n - 31);
            float p[8]; float sh = 0.f;
#pragma unroll
            for (int h = 0; h < 8; ++h) { p[h] = valid ? expf(s[h] - slope[h] * dist - cm[h]) * cl[h] : 0.f; sh += p[h]; }
            pimp[n] = sh;
            int jhi = nv - 1 - ti * 64; if (jhi > 63) jhi = 63;
            tile_pv(ocmp, p, vc + (size_t)(ti * 64) * 128 + lane, 128, 0, jhi, ps, lane);
        }
        for (int n = ntile * 64 + lane; n < 256; n += 64) pimp[n] = 0.f;
        WAVE_LDS_FENCE();
        {
            const int nlo = (4 * lane - 1) < 0 ? 0 : (4 * lane - 1), nhi = (4 * lane + 3) > (NCMP - 1) ? (NCMP - 1) : (4 * lane + 3);
            for (int n = nlo; n <= nhi; ++n) impv += pimp[n];
        }
        WAVE_LDS_FENCE();
    }
    const int cur = t >> 6;
    float score;
    {
        const int j = lane; const bool forced = (j == 0) || (j == cur) || (j == cur - 1); const bool valid = j <= cur;
        score = valid ? (forced ? INFINITY : impv) : -INFINITY;
    }
    int rank = 0;
    for (int i = 0; i < 64; ++i) { const float si = __shfl(score, i); rank += ((si > score) || (si == score && i < lane)) ? 1 : 0; }
    const bool sel = (rank < 16) && (score > -INFINITY);
    unsigned long long mask = __ballot(sel);
    AttnState S;
#pragma unroll
    for (int h = 0; h < 8; ++h) { S.m[h] = -INFINITY; S.l[h] = 0.f; S.o[h] = 0.f; }
    while (mask) {
        const int j = __builtin_ctzll(mask); mask &= mask - 1;
        const int pos = 64 * j + lane; const bool valid = pos <= t; const int jhi = (j == cur) ? (t & 63) : 63;
        const bf16* krow = c.proj() + ((size_t)b * SEQ + pos) * PP + C_KV + 2 * 128 + g * 64;
        float s[8]; tile_scores(s, krow, valid, qs);
        const float dist = (float)(t - pos);
#pragma unroll
        for (int h = 0; h < 8; ++h) s[h] = valid ? s[h] - slope[h] * dist : -INFINITY;
        const bf16* vlane = c.proj() + ((size_t)b * SEQ + 64 * j) * PP + C_KV + 3 * 128 + g * 64 + lane;
        tile_update(S, s, vlane, PP, 0, jhi, ps, lane);
    }
    float oslc[8];
#pragma unroll
    for (int h = 0; h < 8; ++h) oslc[h] = S.o[h] / S.l[h];
    AttnState W;
#pragma unroll
    for (int h = 0; h < 8; ++h) { W.m[h] = -INFINITY; W.l[h] = 0.f; W.o[h] = 0.f; }
    for (int i = 0; i < 8; ++i) {
        const int r0 = t - 64 * (i + 1) + 1;
        if (r0 + 63 < 0) break;
        const int pos = r0 + lane; const bool valid = pos >= 0; const int jlo = r0 < 0 ? -r0 : 0;
        const bf16* krow = c.proj() + ((size_t)b * SEQ + (valid ? pos : 0)) * PP + C_KV + 4 * 128 + g * 64;
        float s[8]; tile_scores(s, krow, valid, qs);
        const float dist = (float)(t - pos);
#pragma unroll
        for (int h = 0; h < 8; ++h) s[h] = valid ? s[h] - slope[h] * dist : -INFINITY;
        const bf16* vlane = c.proj() + (long)((long)b * SEQ + r0) * PP + C_KV + 5 * 128 + g * 64 + lane;
        tile_update(W, s, vlane, PP, jlo, 63, ps, lane);
    }
#pragma unroll
    for (int h = 0; h < 8; ++h) {
        const bf16* gp = prow + C_GN + g * 24 + h * 3;
        const float g0 = sigmoidf(bf2f(gp[0])), g1 = sigmoidf(bf2f(gp[1])), g2 = sigmoidf(bf2f(gp[2]));
        const float on = g0 * ocmp[h] + g1 * oslc[h] + g2 * (W.o[h] / W.l[h]);
        c.o()[row * DM + 1024 + (g * 8 + h) * 64 + lane] = f2bf(on);
    }
}

#define EPI_LOOP for (int m = 0; m < 4; ++m) for (int n = 0; n < 2; ++n) for (int j = 0; j < 4; ++j)
struct EpiProj { bf16* proj; const float* bias; int row0, col0;
    __device__ __forceinline__ void operator()(const f32x4 (&acc)[4][2], int wr, int wc, int fr, int fq) const {
#pragma unroll
        for (int m = 0; m < 4; ++m)
#pragma unroll
            for (int n = 0; n < 2; ++n)
#pragma unroll
                for (int j = 0; j < 4; ++j) { const int r = row0 + wr * 64 + m * 16 + fq * 4 + j, cc = col0 + wc * 32 + n * 16 + fr;
                    const float v = cc < INC ? acc[m][n][j] + bias[cc] : 0.f; proj[(size_t)r * PP + cc] = f2bf(v); } } };
struct EpiCmp1 { float* hb; int row0, col0;
    __device__ __forceinline__ void operator()(const f32x4 (&acc)[4][2], int wr, int wc, int fr, int fq) const {
#pragma unroll
        for (int m = 0; m < 4; ++m)
#pragma unroll
            for (int n = 0; n < 2; ++n)
#pragma unroll
                for (int j = 0; j < 4; ++j) { const int r = row0 + wr * 64 + m * 16 + fq * 4 + j, cc = col0 + wc * 32 + n * 16 + fr;
                    hb[(size_t)r * 256 + cc] = gelu_tanh(acc[m][n][j]); } } };
struct EpiCmp2 { bf16* kvc; int row0;
    __device__ __forceinline__ void operator()(const f32x4 (&acc)[4][2], int wr, int wc, int fr, int fq) const {
#pragma unroll
        for (int m = 0; m < 4; ++m)
#pragma unroll
            for (int n = 0; n < 2; ++n)
#pragma unroll
                for (int j = 0; j < 4; ++j) { const int r = row0 + wr * 64 + m * 16 + fq * 4 + j, cc = wc * 32 + n * 16 + fr;
                    if (cc < 64) kvc[(size_t)r * 64 + cc] = f2bf(acc[m][n][j]); } } };
struct EpiOut { float* y; const float* bias; const float* xres; int row0, col0;
    __device__ __forceinline__ void operator()(const f32x4 (&acc)[4][2], int wr, int wc, int fr, int fq) const {
#pragma unroll
        for (int m = 0; m < 4; ++m)
#pragma unroll
            for (int n = 0; n < 2; ++n)
#pragma unroll
                for (int j = 0; j < 4; ++j) { const int r = row0 + wr * 64 + m * 16 + fq * 4 + j, cc = col0 + wc * 32 + n * 16 + fr;
                    y[(size_t)r * DM + cc] = acc[m][n][j] + bias[cc] + ALPHA * xres[(size_t)r * DM + cc]; } } };
struct EpiLogit { float* lg; const float* bg; const float* be; int row0;
    __device__ __forceinline__ void operator()(const f32x4 (&acc)[4][2], int wr, int wc, int fr, int fq) const {
#pragma unroll
        for (int m = 0; m < 4; ++m)
#pragma unroll
            for (int n = 0; n < 2; ++n)
#pragma unroll
                for (int j = 0; j < 4; ++j) { const int r = row0 + wr * 64 + m * 16 + fq * 4 + j, cc = wc * 32 + n * 16 + fr;
                    if (cc < 72) lg[(size_t)r * NLOG + cc] = acc[m][n][j] + (cc < 8 ? bg[cc] : be[cc - 8]); } } };
struct EpiMoe1 { bf16* H; int rowbase, cnt, rt, ct;
    __device__ __forceinline__ void operator()(const f32x4 (&acc)[4][2], int wr, int wc, int fr, int fq) const {
#pragma unroll
        for (int m = 0; m < 4; ++m)
#pragma unroll
            for (int j = 0; j < 4; ++j) { const int pos = rt * 128 + wr * 64 + m * 16 + fq * 4 + j;
                if (pos < cnt) { const float gv = acc[m][0][j], uv = acc[m][1][j]; const float hv = gv / (1.f + expf(-gv)) * uv;
                    H[(size_t)(rowbase + pos) * EH + ct * 64 + wc * 16 + fr] = f2bf(hv); } } } };
struct EpiMoe2 { float* contrib; const int* lslot; const float* lw; int cnt, rt, col0;
    __device__ __forceinline__ void operator()(const f32x4 (&acc)[4][2], int wr, int wc, int fr, int fq) const {
#pragma unroll
        for (int m = 0; m < 4; ++m)
#pragma unroll
            for (int j = 0; j < 4; ++j) { const int pos = rt * 128 + wr * 64 + m * 16 + fq * 4 + j;
                if (pos < cnt) { const int slot = lslot[pos]; const float w = lw[pos];
#pragma unroll
                    for (int n = 0; n < 2; ++n) contrib[(size_t)slot * DM + col0 + wc * 32 + n * 16 + fr] = acc[m][n][j] * w; } } } };

__device__ __forceinline__ void ph_inproj(const Ctx& c, int L, const float* xin) {
    const float* W = c.w_in() + (size_t)L * DM * INC; const float* bias = c.b_in() + L * INC;
    const int ar = c.tid >> 2, bn = c.tid & 127;
    for (int u = blockIdx.x; u < 128 * 25; u += gridDim.x) {
        const int rt = u / 25, ct = u % 25;
        ALf32 al{xin + (size_t)(rt * 128 + ar) * DM};
        const int col = ct * 128 + bn;
        BLf32 bl{col < INC ? W + col : nullptr, (size_t)INC};
        EpiProj ep{c.proj(), bias, rt * 128, ct * 128};
        gemm_tile(c.lds, al, bl, ep, DM);
    }
}
__device__ __forceinline__ void ph_cmp1_swa(const Ctx& c, int L) {
    const int ar = c.tid >> 2, bn = c.tid & 127;
    for (int u = blockIdx.x; u < 64; u += gridDim.x) {
        const int which = u >> 5, rt = (u >> 1) & 15, ct = u & 1;
        const int r = rt * 128 + ar;
        const bf16* base = nullptr;
        if (r < CMPROWS) { const int g = r & 1, bn_ = r >> 1, n = bn_ % NCMP, b = bn_ / NCMP;
            base = c.proj() + ((size_t)b * SEQ + 16 * n) * PP + C_KV + which * 128 + g * 64; }
        ALcmp al{base, (which ? c.pe_v() : c.pe_k()) + (size_t)L * 2048};
        BLf32 bl{(which ? c.w1_v() : c.w1_k()) + (size_t)L * 2048 * 256 + ct * 128 + bn, (size_t)256};
        EpiCmp1 ep{c.hb() + (size_t)which * 2048 * 256, rt * 128, ct * 128};
        gemm_tile(c.lds, al, bl, ep, 2048);
    }
    LAS float* qs = (LAS float*)(c.lds + L_ATT + c.wid * 5120); LAS float* ps = qs + 512;
    for (int job = blockIdx.x * 8 + c.wid; job < NB * 2 * SEQ; job += gridDim.x * 8) swa_job(c, L, job, qs, ps);
}
__device__ __forceinline__ void ph_cmp2(const Ctx& c, int L) {
    const int ar = c.tid >> 2, bn = c.tid & 127;
    for (int u = blockIdx.x; u < 32; u += gridDim.x) {
        const int which = u >> 4, rt = u & 15;
        ALf32 al{c.hb() + (size_t)which * 2048 * 256 + (size_t)(rt * 128 + ar) * 256};
        BLf32 bl{bn < 64 ? (which ? c.w2_v() : c.w2_k()) + (size_t)L * 256 * 64 + bn : nullptr, (size_t)64};
        EpiCmp2 ep{c.kvc() + (size_t)which * 2048 * 64, rt * 128};
        gemm_tile(c.lds, al, bl, ep, 256);
    }
}
__device__ __forceinline__ void ph_nsa(const Ctx& c, int L) {
    LAS float* qs = (LAS float*)(c.lds + L_ATT + c.wid * 5120); LAS float* ps = qs + 512; LAS float* pimp = qs + 1024;
    for (int job = blockIdx.x * 8 + c.wid; job < NB * 2 * SEQ; job += gridDim.x * 8) nsa_job(c, L, job, qs, ps, pimp);
}
__device__ __forceinline__ void ph_outproj(const Ctx& c, int L, const float* xin) {
    const float* W = c.w_out() + (size_t)L * DM * DM; const float* bias = c.b_out() + L * DM;
    const int ar = c.tid >> 2, bn = c.tid & 127;
    for (int u = blockIdx.x; u < 128 * 16; u += gridDim.x) {
        const int rt = u / 16, ct = u % 16;
        ALbf16 al{c.o() + (size_t)(rt * 128 + ar) * DM};
        BLf32 bl{W + ct * 128 + bn, (size_t)DM};
        EpiOut ep{c.y(), bias, xin, rt * 128, ct * 128};
        gemm_tile(c.lds, al, bl, ep, DM);
    }
}
__device__ __forceinline__ void ph_ln(const Ctx& c, const float* src, float sscale, const float* add, float* dst, const float* gam, const float* bet) {
    const int lane = c.lane;
    for (int r = blockIdx.x * 8 + c.wid; r < MTOK; r += gridDim.x * 8) {
        const f32x4* sp = (const f32x4*)(src + (size_t)r * DM) + lane;
        f32x4 v[8]; float s = 0.f;
#pragma unroll
        for (int j = 0; j < 8; ++j) { v[j] = sp[64 * j] * sscale; }
        if (add) {
            const f32x4* a0 = (const f32x4*)(add + (size_t)(2 * r) * DM) + lane; const f32x4* a1 = (const f32x4*)(add + (size_t)(2 * r + 1) * DM) + lane;
#pragma unroll
            for (int j = 0; j < 8; ++j) v[j] = v[j] + (a0[64 * j] + a1[64 * j]);
        }
#pragma unroll
        for (int j = 0; j < 8; ++j) s += (v[j].x + v[j].y) + (v[j].z + v[j].w);
        const float mean = wave_sum(s) * (1.f / DM); float s2 = 0.f;
#pragma unroll
        for (int j = 0; j < 8; ++j) { v[j] = v[j] - mean; s2 += (v[j].x * v[j].x + v[j].y * v[j].y) + (v[j].z * v[j].z + v[j].w * v[j].w); }
        const float rstd = 1.f / sqrtf(wave_sum(s2) * (1.f / DM) + LN_EPS);
        f32x4* dp = (f32x4*)(dst + (size_t)r * DM) + lane; const f32x4* gp = (const f32x4*)gam + lane; const f32x4* bp = (const f32x4*)bet + lane;
#pragma unroll
        for (int j = 0; j < 8; ++j) dp[64 * j] = v[j] * rstd * gp[64 * j] + bp[64 * j];
    }
}
__device__ __forceinline__ void ph_router(const Ctx& c, int L) {
    const int ar = c.tid >> 2, bn = c.tid & 127;
    const float* colp = nullptr; size_t ldb = 8;
    if (bn < 8) { colp = c.w_group() + (size_t)L * DM * 8 + bn; ldb = 8; } else if (bn < 72) { colp = c.w_expert() + (size_t)L * DM * 64 + (bn - 8); ldb = 64; }
    for (int u = blockIdx.x; u < 128; u += gridDim.x) {
        ALf32 al{c.x1() + (size_t)(u * 128 + ar) * DM};
        BLf32 bl{colp, ldb};
        EpiLogit ep{c.logits(), c.b_group() + L * 8, c.b_expert() + L * 64, u * 128};
        gemm_tile(c.lds, al, bl, ep, DM);
    }
}
__device__ __forceinline__ void ph_route(const Ctx& c, int L) {
    unsigned* cnt = c.cnt() + L * 64;
    for (int tok = blockIdx.x * 512 + c.tid; tok < MTOK; tok += gridDim.x * 512) {
        const float* lg = c.logits() + (size_t)tok * NLOG;
        float gl[8];
#pragma unroll
        for (int i = 0; i < 8; ++i) gl[i] = lg[i];
        int gs = 0; float gm = gl[0];
#pragma unroll
        for (int i = 1; i < 8; ++i) if (gl[i] > gm) { gm = gl[i]; gs = i; }
        float gsum = 0.f;
#pragma unroll
        for (int i = 0; i < 8; ++i) gsum += expf(gl[i] - gm);
        const float gw = 1.f / gsum;
        float el[8];
#pragma unroll
        for (int i = 0; i < 8; ++i) el[i] = lg[8 + gs * 8 + i];
        int i0 = 0; float v0 = el[0];
#pragma unroll
        for (int i = 1; i < 8; ++i) if (el[i] > v0) { v0 = el[i]; i0 = i; }
        int i1 = -1; float v1 = -INFINITY;
#pragma unroll
        for (int i = 0; i < 8; ++i) if (i != i0 && el[i] > v1) { v1 = el[i]; i1 = i; }
        const float e1 = expf(v1 - v0);
        const float w0 = gw / (1.f + e1), w1 = gw * e1 / (1.f + e1);
        const int ea = gs * 8 + i0, eb = gs * 8 + i1;
        const unsigned pa = atomicAdd(&cnt[ea], 1u); c.lslot()[(size_t)ea * LCAP + pa] = tok * 2; c.lw()[(size_t)ea * LCAP + pa] = w0;
        const unsigned pb = atomicAdd(&cnt[eb], 1u); c.lslot()[(size_t)eb * LCAP + pb] = tok * 2 + 1; c.lw()[(size_t)eb * LCAP + pb] = w1;
    }
}
__device__ __forceinline__ void moe_tables(const Ctx& c, int L) {
    LAS int* tab = (LAS int*)(c.lds + L_TAB);
    __syncthreads();
    if (c.tid < 64) tab[c.tid] = (int)c.cnt()[L * 64 + c.tid];
    __syncthreads();
    if (c.tid == 0) { int rb = 0, tb = 0; for (int e = 0; e < 64; ++e) { tab[64 + e] = rb; tab[128 + e] = tb; rb += tab[e]; tb += (tab[e] + 127) >> 7; } tab[192] = tb; }
    __syncthreads();
}
__device__ __forceinline__ int moe_find(const LAS int* tab, int rtg) { int e = 0; for (int i = 1; i < 64; ++i) if (tab[128 + i] <= rtg) e = i; return e; }
__device__ __forceinline__ void ph_moe1(const Ctx& c, int L) {
    moe_tables(c, L);
    const LAS int* tab = (const LAS int*)(c.lds + L_TAB);
    const int ar = c.tid >> 2, bn = c.tid & 127;
    const int ntile = tab[192];
    for (int u = blockIdx.x; u < ntile * 8; u += gridDim.x) {
        const int rtg = u >> 3, ct = u & 7; const int e = moe_find(tab, rtg); const int rt = rtg - tab[128 + e], cnt = tab[e], rowbase = tab[64 + e];
        const int pos = rt * 128 + ar;
        const float* rowp = nullptr;
        if (pos < cnt) { const int slot = c.lslot()[(size_t)e * LCAP + pos]; rowp = c.x1() + (size_t)(slot >> 1) * DM; }
        ALf32 al{rowp};
        const int wcv = bn >> 5, nsel = (bn >> 4) & 1, cc = bn & 15; const int hcol = ct * 64 + wcv * 16 + cc;
        const float* Wsel = (nsel ? c.we_up() : c.we_gate()) + ((size_t)L * NE + e) * DM * EH;
        BLf32 bl{Wsel + hcol, (size_t)EH};
        EpiMoe1 ep{c.H(), rowbase, cnt, rt, ct};
        gemm_tile(c.lds, al, bl, ep, DM);
    }
}
__device__ __forceinline__ void ph_moe2(const Ctx& c, int L) {
    moe_tables(c, L);
    const LAS int* tab = (const LAS int*)(c.lds + L_TAB);
    const int ar = c.tid >> 2, bn = c.tid & 127;
    const int ntile = tab[192];
    for (int u = blockIdx.x; u < ntile * 16; u += gridDim.x) {
        const int rtg = u >> 4, ct = u & 15; const int e = moe_find(tab, rtg); const int rt = rtg - tab[128 + e], cnt = tab[e], rowbase = tab[64 + e];
        const int pos = rt * 128 + ar;
        ALbf16 al{pos < cnt ? c.H() + (size_t)(rowbase + pos) * EH : nullptr};
        BLf32 bl{c.we_down() + ((size_t)L * NE + e) * EH * DM + ct * 128 + bn, (size_t)DM};
        EpiMoe2 ep{c.contrib(), c.lslot() + (size_t)e * LCAP, c.lw() + (size_t)e * LCAP, cnt, rt, ct * 128};
        gemm_tile(c.lds, al, bl, ep, EH);
    }
}

__global__ void __launch_bounds__(512, 2) fwd(Args a) {
    extern __shared__ __attribute__((aligned(16))) unsigned char smem[];
    unsigned char* ws = a.ws;
    const int tid0 = threadIdx.x;
    volatile LAS unsigned* barw = (volatile LAS unsigned*)((LAS unsigned char*)smem + L_BARW);
    if (tid0 < 4) barw[tid0] = 0u;
    __syncthreads();
    const int lo = a.lo, hi = a.hi;
    XcdBarrier bar; bar.bar = (unsigned*)(ws + WS_CTL) + CW_BAR; bar.x = 0; bar.st = barw;
    if (hi - lo > 1) bar = xcd_barrier_post((unsigned*)(ws + WS_CTL) + CW_BAR, barw);
#ifndef PHMASK
#define PHMASK 0x7ff
#endif
#define IN(k) (((PHMASK >> ((k) % NPH)) & 1) && lo <= (k) && (k) < hi)
#define SEAM(k) do { if ((k) + 1 < hi) xcd_barrier(bar); } while (0)
#define PCTX() Ctx c; { int t_ = threadIdx.x; asm volatile("" : "+v"(t_)); c.tid = t_; c.lane = t_ & 63; c.wid = __builtin_amdgcn_readfirstlane(t_ >> 6); c.lds = (LAS unsigned char*)smem; c.a = &a; }
    for (int L = 0; L < DEPTH; ++L) {
        const int pb = L * NPH;
        if (IN(pb + 0)) { PCTX(); ph_inproj(c, L, L == 0 ? c.x_in() : c.x2()); SEAM(pb + 0); }
        if (IN(pb + 1)) { PCTX(); ph_cmp1_swa(c, L); SEAM(pb + 1); }
        if (IN(pb + 2)) { PCTX(); ph_cmp2(c, L); SEAM(pb + 2); }
        if (IN(pb + 3)) { PCTX(); ph_nsa(c, L); SEAM(pb + 3); }
        if (IN(pb + 4)) { PCTX(); ph_outproj(c, L, L == 0 ? c.x_in() : c.x2()); SEAM(pb + 4); }
        if (IN(pb + 5)) { PCTX(); ph_ln(c, c.y(), 1.f, nullptr, c.x1(), c.ln1_g() + L * DM, c.ln1_b() + L * DM); SEAM(pb + 5); }
        if (IN(pb + 6)) { PCTX(); ph_router(c, L); SEAM(pb + 6); }
        if (IN(pb + 7)) { PCTX(); ph_route(c, L); SEAM(pb + 7); }
        if (IN(pb + 8)) { PCTX(); ph_moe1(c, L); SEAM(pb + 8); }
        if (IN(pb + 9)) { PCTX(); ph_moe2(c, L); SEAM(pb + 9); }
        if (IN(pb + 10)) { PCTX(); ph_ln(c, c.x1(), ALPHA, c.contrib(), L == DEPTH - 1 ? c.out() : c.x2(), c.ln2_g() + L * DM, c.ln2_b() + L * DM); SEAM(pb + 10); }
    }
#undef IN
#undef SEAM
}

extern "C" void kernel_launch(void* const* d_in, const int* in_sizes, int n_in, void* d_out, int out_size, void* d_ws, size_t ws_size, hipStream_t stream) {
    static int grid = 0;
    if (grid == 0) {
        if (n_in != 23 || out_size != MTOK * DM || ws_size < WS_END) { fprintf(stderr, "kernel_launch: unexpected shapes (n_in %d out %d ws %zu)\n", n_in, out_size, ws_size); grid = -1; return; }
        int dev = 0, cus = 0;
        if (hipGetDevice(&dev) != hipSuccess || hipDeviceGetAttribute(&cus, hipDeviceAttributeMultiprocessorCount, dev) != hipSuccess) { grid = -1; return; }
        if (hipFuncSetAttribute((const void*)fwd, hipFuncAttributeMaxDynamicSharedMemorySize, LDS_BYTES) != hipSuccess) { fprintf(stderr, "kernel_launch: hipFuncSetAttribute failed\n"); grid = -1; return; }
        int per_cu = 0;
        (void)hipOccupancyMaxActiveBlocksPerMultiprocessor(&per_cu, (const void*)fwd, 512, LDS_BYTES);
        (void)hipGetLastError();
        grid = cus;
    }
    if (grid < 0) return;
    (void)hipMemsetAsync((char*)d_ws + WS_CTL, 0, CTL_BYTES, stream);
    Args a{};
    for (int i = 0; i < 23; ++i) a.in[i] = (const float*)d_in[i];
    a.out = (float*)d_out; a.ws = (unsigned char*)d_ws;
#if ONE_LAUNCH
    a.lo = 0; a.hi = DEPTH * NPH;
    hipLaunchKernelGGL(fwd, dim3(grid), dim3(512), LDS_BYTES, stream, a);
#else
    for (int k = 0; k < DEPTH * NPH; ++k) { a.lo = k; a.hi = k + 1; hipLaunchKernelGGL(fwd, dim3(grid), dim3(512), LDS_BYTES, stream, a); }
#endif
}
```

```cpp
#include <hip/hip_runtime.h>
#include <cstdio>
#include <cstdint>
#include <cmath>

#ifndef ONE_LAUNCH
#define ONE_LAUNCH 1
#endif

#define LAS __attribute__((address_space(3)))
typedef unsigned short bf16;
typedef short bf16x8 __attribute__((ext_vector_type(8)));
typedef float f32x4 __attribute__((ext_vector_type(4)));
typedef unsigned u32x4 __attribute__((ext_vector_type(4)));

constexpr int DM = 2048, SEQ = 4096, NB = 4, MTOK = NB * SEQ, DEPTH = 2;
constexpr int INC = 3120, PP = 3200;
constexpr int C_QA = 0, C_KA = 1024, C_VA = 1152, C_QN = 1280, C_KV = 2304, C_GN = 3072;
constexpr int NCMP = 255, CMPROWS = NB * NCMP * 2;
constexpr int NE = 64, EH = 512, LCAP = MTOK;
constexpr int NLOG = 80;
constexpr float ALPHA = 1.41421356237309515f;
constexpr float LN_EPS = 1e-5f;
constexpr int NPH = 11;

constexpr size_t MiB = 1u << 20;
constexpr size_t WS_CTL = 0, CTL_BYTES = 1 * MiB;
constexpr size_t WS_PROJ = 2 * MiB;
constexpr size_t WS_O = 102 * MiB;
constexpr size_t WS_Y = 166 * MiB;
constexpr size_t WS_X1 = 294 * MiB;
constexpr size_t WS_X2 = 422 * MiB;
constexpr size_t WS_HB = 550 * MiB;
constexpr size_t WS_KVC = 554 * MiB;
constexpr size_t WS_LOG = 555 * MiB;
constexpr size_t WS_LSLOT = 561 * MiB;
constexpr size_t WS_LW = 565 * MiB;
constexpr size_t WS_H = 569 * MiB;
constexpr size_t WS_CONTRIB = 601 * MiB;
constexpr size_t WS_END = 857 * MiB;
constexpr int CW_BAR = 4096;
constexpr int CW_CNT = 16384;

constexpr int L_GEMM = 0;
constexpr int L_TAB = 24576;
constexpr int L_BARW = 28672;
constexpr int L_ATT = 32768;
constexpr int LDS_BYTES = 98304;

__device__ __forceinline__ float bf2f(unsigned h) { return __uint_as_float(h << 16); }
__device__ __forceinline__ unsigned cvt_pk_bf16(float lo, float hi) { unsigned r; asm("v_cvt_pk_bf16_f32 %0, %1, %2" : "=v"(r) : "v"(lo), "v"(hi)); return r; }
__device__ __forceinline__ bf16 f2bf(float f) { return (bf16)(cvt_pk_bf16(f, 0.f) & 0xffffu); }
__device__ __forceinline__ float wave_sum(float v) {
#pragma unroll
    for (int o = 1; o < 64; o <<= 1) v += __shfl_xor(v, o);
    return v;
}
__device__ __forceinline__ float wave_max(float v) {
#pragma unroll
    for (int o = 1; o < 64; o <<= 1) v = fmaxf(v, __shfl_xor(v, o));
    return v;
}
__device__ __forceinline__ float gelu_tanh(float x) {
    const float u = 0.7978845608028654f * (x + 0.044715f * x * x * x);
    const float e = expf(2.f * u);
    const float th = 1.f - 2.f / (e + 1.f);
    return 0.5f * x * (1.f + th);
}
__device__ __forceinline__ float sigmoidf(float x) { return 1.f / (1.f + expf(-x)); }
__device__ __forceinline__ float rfl(float v) { return __builtin_bit_cast(float, __builtin_amdgcn_readfirstlane(__builtin_bit_cast(int, v))); }
#define WAVE_LDS_FENCE() do { asm volatile("s_waitcnt lgkmcnt(0)" ::: "memory"); __builtin_amdgcn_wave_barrier(); } while (0)

#define XB_TMO      128
#define XB_XCNT(j)  (256  + 64 * (j))
#define XB_XSUB(j)  (1280 + 64 * (j))
#define XB_XGEN(j)  (2304 + 64 * (j))
#define XB_TOP      3328
#define XB_TOPGEN   3392
#define XCD_BAR_WORDS 3456
#define XB_SPIN_CAP (1u << 24)

__device__ __forceinline__ unsigned xb_ld(unsigned* p)              { return __hip_atomic_load(p, __ATOMIC_RELAXED, __HIP_MEMORY_SCOPE_AGENT); }
__device__ __forceinline__ unsigned xb_add(unsigned* p, unsigned v) { return __hip_atomic_fetch_add(p, v, __ATOMIC_RELAXED, __HIP_MEMORY_SCOPE_AGENT); }
__device__ __forceinline__ unsigned xb_xcc_id() { return (unsigned)__builtin_amdgcn_s_getreg((3 << 11) | 20) & 0xFu; }
#define XB_SPIN(cond, bar) do { unsigned _sp = 0; while (cond) { __builtin_amdgcn_s_sleep(1); \
    if ((++_sp & 255u) == 0u) { if (xb_ld(&(bar)[XB_TMO])) break; if (_sp > XB_SPIN_CAP) { atomicAdd(&(bar)[XB_TMO], 1u); break; } } } } while (0)

struct XcdBarrier { unsigned* bar; unsigned x; volatile LAS unsigned* st; };

__device__ __forceinline__ XcdBarrier xcd_barrier_post(unsigned* bar, volatile LAS unsigned* st) {
    XcdBarrier b; b.bar = bar; b.x = xb_xcc_id(); b.st = st;
    if (threadIdx.x == 0) (void)xb_add(&bar[XB_XCNT(b.x)], 1u);
    return b;
}
__device__ __forceinline__ void xcd_barrier_complete(unsigned* bar, unsigned x, unsigned& nloc, unsigned& nx) {
    const unsigned G = gridDim.x * gridDim.y * gridDim.z;
    unsigned sum, cnt, mine, sp = 0u;
    for (;;) {
        sum = 0u; cnt = 0u; mine = 0u;
#pragma unroll
        for (unsigned j = 0; j < 16; ++j) { const unsigned c = xb_ld(&bar[XB_XCNT(j)]); sum += c; cnt += (c > 0u) ? 1u : 0u; mine = (j == x) ? c : mine; }
        if (sum == G) break;
        __builtin_amdgcn_s_sleep(1);
        if ((++sp & 255u) == 0u) { if (xb_ld(&bar[XB_TMO])) break; if (sp > XB_SPIN_CAP) { atomicAdd(&bar[XB_TMO], 1u); break; } }
    }
    nloc = mine > 0u ? mine : 1u; nx = cnt > 0u ? cnt : 1u;
}
__device__ __forceinline__ void xcd_barrier(const XcdBarrier& b) {
    asm volatile("s_waitcnt vmcnt(0)" ::: "memory");
    __syncthreads();
    if (threadIdx.x == 0) {
        unsigned* bar = b.bar;
        __builtin_amdgcn_s_waitcnt(0);
        unsigned nloc = b.st[0], nx = b.st[1];
        if (nloc == 0u) { xcd_barrier_complete(bar, b.x, nloc, nx); b.st[0] = nloc; b.st[1] = nx; }
        const unsigned old = xb_add(&bar[XB_XSUB(b.x)], 1u);
        const unsigned gen = old / nloc;
        if (old + 1u == (gen + 1u) * nloc) {
            __builtin_amdgcn_fence(__ATOMIC_RELEASE, "agent");
            asm volatile("s_waitcnt vmcnt(0)" ::: "memory");
            const unsigned og = xb_add(&bar[XB_TOP], 1u);
            const unsigned tg = og / nx;
            if (og + 1u == (tg + 1u) * nx) xb_add(&bar[XB_TOPGEN], 1u);
            else XB_SPIN(xb_ld(&bar[XB_TOPGEN]) == tg, bar);
            __builtin_amdgcn_fence(__ATOMIC_ACQUIRE, "agent");
            xb_add(&bar[XB_XGEN(b.x)], 1u);
            asm volatile("s_waitcnt vmcnt(0)" ::: "memory");
        } else {
            XB_SPIN(xb_ld(&bar[XB_XGEN(b.x)]) == gen, bar);
            __builtin_amdgcn_fence(__ATOMIC_ACQUIRE, "agent");
            asm volatile("s_waitcnt vmcnt(0)" ::: "memory");
        }
    }
    __syncthreads();
}

template <class AL, class BL, class EP>
__device__ __forceinline__ void gemm_tile(LAS unsigned char* lds, const AL& al, const BL& bl, const EP& ep, int K) {
    const int tid = threadIdx.x, wid = tid >> 6, lane = tid & 63, wr = wid >> 2, wc = wid & 3, fr = lane & 15, fq = lane >> 4;
    LAS bf16* As = (LAS bf16*)(lds + L_GEMM);
    LAS bf16* Bs = As + 128 * 40;
    const int ar = tid >> 2, akq = (tid & 3) * 8;
    const int bn = tid & 127, bkg = (tid >> 7) * 8;
    f32x4 acc[4][2];
#pragma unroll
    for (int m = 0; m < 4; ++m)
#pragma unroll
        for (int n = 0; n < 2; ++n) acc[m][n] = (f32x4){0.f, 0.f, 0.f, 0.f};
    bf16x8 ra = al.load(akq);
    float rb0 = bl.load(bkg + 0), rb1 = bl.load(bkg + 1), rb2 = bl.load(bkg + 2), rb3 = bl.load(bkg + 3),
          rb4 = bl.load(bkg + 4), rb5 = bl.load(bkg + 5), rb6 = bl.load(bkg + 6), rb7 = bl.load(bkg + 7);
    for (int k0 = 0; k0 < K; k0 += 32) {
        *(LAS bf16x8*)(As + ar * 40 + akq) = ra;
        u32x4 pb; pb.x = cvt_pk_bf16(rb0, rb1); pb.y = cvt_pk_bf16(rb2, rb3); pb.z = cvt_pk_bf16(rb4, rb5); pb.w = cvt_pk_bf16(rb6, rb7);
        *(LAS u32x4*)(Bs + bn * 40 + bkg) = pb;
        __syncthreads();
        if (k0 + 32 < K) {
            const int kn = k0 + 32;
            ra = al.load(kn + akq);
            rb0 = bl.load(kn + bkg + 0); rb1 = bl.load(kn + bkg + 1); rb2 = bl.load(kn + bkg + 2); rb3 = bl.load(kn + bkg + 3);
            rb4 = bl.load(kn + bkg + 4); rb5 = bl.load(kn + bkg + 5); rb6 = bl.load(kn + bkg + 6); rb7 = bl.load(kn + bkg + 7);
        }
        bf16x8 af[4], bfr[2];
#pragma unroll
        for (int m = 0; m < 4; ++m) af[m] = *(const LAS bf16x8*)(As + (wr * 64 + m * 16 + fr) * 40 + fq * 8);
#pragma unroll
        for (int n = 0; n < 2; ++n) bfr[n] = *(const LAS bf16x8*)(Bs + (wc * 32 + n * 16 + fr) * 40 + fq * 8);
#pragma unroll
        for (int m = 0; m < 4; ++m)
#pragma unroll
            for (int n = 0; n < 2; ++n) acc[m][n] = __builtin_amdgcn_mfma_f32_16x16x32_bf16(af[m], bfr[n], acc[m][n], 0, 0, 0);
        __syncthreads();
    }
    ep(acc, wr, wc, fr, fq);
}

__device__ __forceinline__ bf16x8 pack8(f32x4 a, f32x4 b) {
    u32x4 p; p.x = cvt_pk_bf16(a.x, a.y); p.y = cvt_pk_bf16(a.z, a.w); p.z = cvt_pk_bf16(b.x, b.y); p.w = cvt_pk_bf16(b.z, b.w);
    return __builtin_bit_cast(bf16x8, p);
}
__device__ __forceinline__ bf16x8 zero8() { u32x4 p = {0u, 0u, 0u, 0u}; return __builtin_bit_cast(bf16x8, p); }

struct ALf32 { const float* rowp; __device__ __forceinline__ bf16x8 load(int k) const { if (!rowp) return zero8(); const f32x4 a = *(const f32x4*)(rowp + k), b = *(const f32x4*)(rowp + k + 4); return pack8(a, b); } };
struct ALbf16 { const bf16* rowp; __device__ __forceinline__ bf16x8 load(int k) const { if (!rowp) return zero8(); return *(const bf16x8*)(rowp + k); } };
struct ALcmp { const bf16* base; const float* pe; __device__ __forceinline__ bf16x8 load(int k) const {
        if (!base) return zero8();
        const int l = k >> 6, d = k & 63;
        const u32x4 v = *(const u32x4*)(base + (size_t)l * PP + d);
        const f32x4 p0 = *(const f32x4*)(pe + k), p1 = *(const f32x4*)(pe + k + 4);
        f32x4 a, b;
        a.x = bf2f(v.x & 0xffffu) + p0.x; a.y = bf2f(v.x >> 16) + p0.y; a.z = bf2f(v.y & 0xffffu) + p0.z; a.w = bf2f(v.y >> 16) + p0.w;
        b.x = bf2f(v.z & 0xffffu) + p1.x; b.y = bf2f(v.z >> 16) + p1.y; b.z = bf2f(v.w & 0xffffu) + p1.z; b.w = bf2f(v.w >> 16) + p1.w;
        return pack8(a, b); } };
struct BLf32 { const float* colp; size_t ldb; __device__ __forceinline__ float load(int k) const { return colp ? colp[(size_t)k * ldb] : 0.f; } };

struct Args { const float* in[23]; float* out; unsigned char* ws; int lo, hi; };

struct Ctx {
    LAS unsigned char* lds;
    int tid, lane, wid;
    const Args* a;
    __device__ __forceinline__ const float* x_in() const { return a->in[0]; }
    __device__ __forceinline__ const float* w_in() const { return a->in[1]; }
    __device__ __forceinline__ const float* b_in() const { return a->in[2]; }
    __device__ __forceinline__ const float* sinks() const { return a->in[3]; }
    __device__ __forceinline__ const float* pe_k() const { return a->in[4]; }
    __device__ __forceinline__ const float* w1_k() const { return a->in[5]; }
    __device__ __forceinline__ const float* w2_k() const { return a->in[6]; }
    __device__ __forceinline__ const float* pe_v() const { return a->in[7]; }
    __device__ __forceinline__ const float* w1_v() const { return a->in[8]; }
    __device__ __forceinline__ const float* w2_v() const { return a->in[9]; }
    __device__ __forceinline__ const float* w_out() const { return a->in[10]; }
    __device__ __forceinline__ const float* b_out() const { return a->in[11]; }
    __device__ __forceinline__ const float* ln1_g() const { return a->in[12]; }
    __device__ __forceinline__ const float* ln1_b() const { return a->in[13]; }
    __device__ __forceinline__ const float* w_group() const { return a->in[14]; }
    __device__ __forceinline__ const float* b_group() const { return a->in[15]; }
    __device__ __forceinline__ const float* w_expert() const { return a->in[16]; }
    __device__ __forceinline__ const float* b_expert() const { return a->in[17]; }
    __device__ __forceinline__ const float* we_gate() const { return a->in[18]; }
    __device__ __forceinline__ const float* we_up() const { return a->in[19]; }
    __device__ __forceinline__ const float* we_down() const { return a->in[20]; }
    __device__ __forceinline__ const float* ln2_g() const { return a->in[21]; }
    __device__ __forceinline__ const float* ln2_b() const { return a->in[22]; }
    __device__ __forceinline__ float* out() const { return a->out; }
    __device__ __forceinline__ bf16* proj() const { return (bf16*)(a->ws + WS_PROJ); }
    __device__ __forceinline__ bf16* o() const { return (bf16*)(a->ws + WS_O); }
    __device__ __forceinline__ bf16* kvc() const { return (bf16*)(a->ws + WS_KVC); }
    __device__ __forceinline__ bf16* H() const { return (bf16*)(a->ws + WS_H); }
    __device__ __forceinline__ float* y() const { return (float*)(a->ws + WS_Y); }
    __device__ __forceinline__ float* x1() const { return (float*)(a->ws + WS_X1); }
    __device__ __forceinline__ float* x2() const { return (float*)(a->ws + WS_X2); }
    __device__ __forceinline__ float* hb() const { return (float*)(a->ws + WS_HB); }
    __device__ __forceinline__ float* logits() const { return (float*)(a->ws + WS_LOG); }
    __device__ __forceinline__ float* lw() const { return (float*)(a->ws + WS_LW); }
    __device__ __forceinline__ float* contrib() const { return (float*)(a->ws + WS_CONTRIB); }
    __device__ __forceinline__ int* lslot() const { return (int*)(a->ws + WS_LSLOT); }
    __device__ __forceinline__ unsigned* cnt() const { return (unsigned*)(a->ws + WS_CTL) + CW_CNT; }
};

struct AttnState { float m[8], l[8], o[8]; };

__device__ __forceinline__ void load_q(LAS float* qs, const bf16* qrow, int lane) {
    const u32x4 v = *(const u32x4*)(qrow + lane * 8);
    const int h = lane >> 3, d0 = (lane & 7) * 8;
    qs[(d0 + 0) * 8 + h] = bf2f(v.x & 0xffffu) * 0.125f; qs[(d0 + 1) * 8 + h] = bf2f(v.x >> 16) * 0.125f;
    qs[(d0 + 2) * 8 + h] = bf2f(v.y & 0xffffu) * 0.125f; qs[(d0 + 3) * 8 + h] = bf2f(v.y >> 16) * 0.125f;
    qs[(d0 + 4) * 8 + h] = bf2f(v.z & 0xffffu) * 0.125f; qs[(d0 + 5) * 8 + h] = bf2f(v.z >> 16) * 0.125f;
    qs[(d0 + 6) * 8 + h] = bf2f(v.w & 0xffffu) * 0.125f; qs[(d0 + 7) * 8 + h] = bf2f(v.w >> 16) * 0.125f;
    WAVE_LDS_FENCE();
}
__device__ __forceinline__ void tile_scores(float (&s)[8], const bf16* krow, bool valid, const LAS float* qs) {
#pragma unroll
    for (int h = 0; h < 8; ++h) s[h] = 0.f;
    if (valid) {
#pragma unroll 1
        for (int i = 0; i < 8; ++i) {
            const u32x4 kv = *(const u32x4*)(krow + i * 8);
            const unsigned w[4] = {kv.x, kv.y, kv.z, kv.w};
#pragma unroll
            for (int wi = 0; wi < 4; ++wi) {
#pragma unroll
                for (int e = 0; e < 2; ++e) {
                    const float kf = e ? __uint_as_float(w[wi] & 0xffff0000u) : __uint_as_float(w[wi] << 16);
                    const int d = i * 8 + wi * 2 + e;
                    const f32x4 qa = *(const LAS f32x4*)(qs + d * 8), qb = *(const LAS f32x4*)(qs + d * 8 + 4);
                    s[0] += kf * qa.x; s[1] += kf * qa.y; s[2] += kf * qa.z; s[3] += kf * qa.w;
                    s[4] += kf * qb.x; s[5] += kf * qb.y; s[6] += kf * qb.z; s[7] += kf * qb.w;
                }
            }
        }
    }
}
__device__ __forceinline__ void tile_pv(float (&o)[8], const float (&p)[8], const bf16* vlane, long pitch, int jlo, int jhi, LAS float* ps, int lane) {
    *(LAS f32x4*)(ps + lane * 8) = (f32x4){p[0], p[1], p[2], p[3]};
    *(LAS f32x4*)(ps + lane * 8 + 4) = (f32x4){p[4], p[5], p[6], p[7]};
    WAVE_LDS_FENCE();
    for (int j = jlo; j <= jhi; ++j) {
        const float v = bf2f(vlane[(long)j * pitch]);
        const f32x4 pa = *(const LAS f32x4*)(ps + j * 8), pb = *(const LAS f32x4*)(ps + j * 8 + 4);
        o[0] += pa.x * v; o[1] += pa.y * v; o[2] += pa.z * v; o[3] += pa.w * v;
        o[4] += pb.x * v; o[5] += pb.y * v; o[6] += pb.z * v; o[7] += pb.w * v;
    }
    WAVE_LDS_FENCE();
}
__device__ __forceinline__ void tile_update(AttnState& st, const float (&s)[8], const bf16* vlane, long pitch, int jlo, int jhi, LAS float* ps, int lane) {
    float p[8];
#pragma unroll
    for (int h = 0; h < 8; ++h) {
        const float tm = wave_max(s[h]);
        const float mn = fmaxf(st.m[h], tm);
        float corr = 1.f, ph = 0.f;
        if (mn != -INFINITY) { corr = expf(st.m[h] - mn); ph = expf(s[h] - mn); }
        st.l[h] = rfl(st.l[h] * corr + wave_sum(ph));
        st.o[h] *= corr; st.m[h] = rfl(mn); p[h] = ph;
    }
    tile_pv(st.o, p, vlane, pitch, jlo, jhi, ps, lane);
}

__device__ __forceinline__ void swa_job(const Ctx& c, int L, int job, LAS float* qs, LAS float* ps) {
    const int lane = c.lane;
    const int t = job & (SEQ - 1), bg = job >> 12, g = bg & 1, b = bg >> 1;
    const size_t row = (size_t)b * SEQ + t;
    load_q(qs, c.proj() + row * PP + C_QA + g * 512, lane);
    AttnState st; float slope[8];
#pragma unroll
    for (int h = 0; h < 8; ++h) { const int a = g * 8 + h; slope[h] = rfl(exp2f(-(float)(2 * a + 1) * 0.25f)); st.m[h] = rfl(c.sinks()[L * 16 + a]); st.l[h] = 1.f; st.o[h] = 0.f; }
    for (int i = 0; i < 2; ++i) {
        const int r0 = t - 64 * (i + 1) + 1;
        if (r0 + 63 < 0) break;
        const int pos = r0 + lane; const bool valid = pos >= 0; const int jlo = r0 < 0 ? -r0 : 0;
        const bf16* krow = c.proj() + ((size_t)b * SEQ + (valid ? pos : 0)) * PP + C_KA + g * 64;
        float s[8]; tile_scores(s, krow, valid, qs);
        const float dist = (float)(t - pos);
#pragma unroll
        for (int h = 0; h < 8; ++h) s[h] = valid ? s[h] - slope[h] * dist : -INFINITY;
        const bf16* vlane = c.proj() + (long)((long)b * SEQ + r0) * PP + C_VA + g * 64 + lane;
        tile_update(st, s, vlane, PP, jlo, 63, ps, lane);
    }
#pragma unroll
    for (int h = 0; h < 8; ++h) c.o()[row * DM + (g * 8 + h) * 64 + lane] = f2bf(st.o[h] / st.l[h]);
}

__device__ __forceinline__ void nsa_job(const Ctx& c, int L, int job, LAS float* qs, LAS float* ps, LAS float* pimp) {
    const int lane = c.lane;
    const int t = job & (SEQ - 1), bg = job >> 12, g = bg & 1, b = bg >> 1;
    const size_t row = (size_t)b * SEQ + t;
    const bf16* prow = c.proj() + row * PP;
    load_q(qs, prow + C_QN + g * 512, lane);
    float slope[8];
#pragma unroll
    for (int h = 0; h < 8; ++h) slope[h] = rfl(exp2f(-(float)(g * 8 + h + 1) * 0.5f));
    float ocmp[8];
#pragma unroll
    for (int h = 0; h < 8; ++h) ocmp[h] = 0.f;
    float impv = 0.f;
    int nv = 0;
    if (t >= 31) { nv = ((t - 31) >> 4) + 1; if (nv > NCMP) nv = NCMP; }
    if (nv > 0) {
        const bf16* kc = c.kvc() + ((size_t)(b * NCMP) * 2 + g) * 64;
        const bf16* vc = c.kvc() + (size_t)2048 * 64 + ((size_t)(b * NCMP) * 2 + g) * 64;
        const int ntile = (nv + 63) >> 6;
        float cm[8], cl[8];
#pragma unroll
        for (int h = 0; h < 8; ++h) { cm[h] = -INFINITY; cl[h] = 0.f; }
#pragma unroll 1
        for (int ti = 0; ti < ntile; ++ti) {
            const int n = ti * 64 + lane; const bool valid = n < nv;
            float s[8]; tile_scores(s, kc + (size_t)(valid ? n : 0) * 128, valid, qs);
            const float dist = (float)(t - 16 * n - 31);
#pragma unroll
            for (int h = 0; h < 8; ++h) {
                const float sv = valid ? s[h] - slope[h] * dist : -INFINITY;
                const float mn = fmaxf(cm[h], wave_max(sv));
                cl[h] = rfl(cl[h] * expf(cm[h] - mn) + wave_sum(expf(sv - mn))); cm[h] = rfl(mn);
            }
        }
#pragma unroll
        for (int h = 0; h < 8; ++h) cl[h] = rfl(1.f / cl[h]);
#pragma unroll 1
        for (int ti = 0; ti < ntile; ++ti) {
            const int n = ti * 64 + lane; const bool valid = n < nv;
            float s[8]; tile_scores(s, kc + (size_t)(valid ? n : 0) * 128, valid, qs);
            const float dist = (float)(t - 16 * n - 31);
            float p[8]; float sh = 0.f;
#pragma unroll
            for (int h = 0; h < 8; ++h) { p[h] = valid ? expf(s[h] - slope[h] * dist - cm[h]) * cl[h] : 0.f; sh += p[h]; }
            pimp[n] = sh;
            int jhi = nv - 1 - ti * 64; if (jhi > 63) jhi = 63;
            tile_pv(ocmp, p, vc + (size_t)(ti * 64) * 128 + lane, 128, 0, jhi, ps, lane);
        }
        for (int n = ntile * 64 + lane; n < 256; n += 64) pimp[n] = 0.f;
        WAVE_LDS_FENCE();
        {
            const int nlo = (4 * lane - 1) < 0 ? 0 : (4 * lane - 1), nhi = (4 * lane + 3) > (NCMP - 1) ? (NCMP - 1) : (4 * lane + 3);
            for (int n = nlo; n <= nhi; ++n) impv += pimp[n];
        }
        WAVE_LDS_FENCE();
    }
    const int cur = t >> 6;
    float score;
    {
        const int j = lane; const bool forced = (j == 0) || (j == cur) || (j == cur - 1); const bool valid = j <= cur;
        score = valid ? (forced ? INFINITY : impv) : -INFINITY;
    }
    int rank = 0;
    for (int i = 0; i < 64; ++i) { const float si = __shfl(score, i); rank += ((si > score) || (si == score && i < lane)) ? 1 : 0; }
    const bool sel = (rank < 16) && (score > -INFINITY);
    unsigned long long mask = __ballot(sel);
    AttnState S;
#pragma unroll
    for (int h = 0; h < 8; ++h) { S.m[h] = -INFINITY; S.l[h] = 0.f; S.o[h] = 0.f; }
    while (mask) {
        const int j = __builtin_ctzll(mask); mask &= mask - 1;
        const int pos = 64 * j + lane; const bool valid = pos <= t; const int jhi = (j == cur) ? (t & 63) : 63;
        const bf16* krow = c.proj() + ((size_t)b * SEQ + pos) * PP + C_KV + 2 * 128 + g * 64;
        float s[8]; tile_scores(s, krow, valid, qs);
        const float dist = (float)(t - pos);
#pragma unroll
        for (int h = 0; h < 8; ++h) s[h] = valid ? s[h] - slope[h] * dist : -INFINITY;
        const bf16* vlane = c.proj() + ((size_t)b * SEQ + 64 * j) * PP + C_KV + 3 * 128 + g * 64 + lane;
        tile_update(S, s, vlane, PP, 0, jhi, ps, lane);
    }
    float oslc[8];
#pragma unroll
    for (int h = 0; h < 8; ++h) oslc[h] = S.o[h] / S.l[h];
    AttnState W;
#pragma unroll
    for (int h = 0; h < 8; ++h) { W.m[h] = -INFINITY; W.l[h] = 0.f; W.o[h] = 0.f; }
    for (int i = 0; i < 8; ++i) {
        const int r0 = t - 64 * (i + 1) + 1;
        if (r0 + 63 < 0) break;
        const int pos = r0 + lane; const bool valid = pos >= 0; const int jlo = r0 < 0 ? -r0 : 0;
        const bf16* krow = c.proj() + ((size_t)b * SEQ + (valid ? pos : 0)) * PP + C_KV + 4 * 128 + g * 64;
        float s[8]; tile_scores(s, krow, valid, qs);
        const float dist = (float)(t - pos);
#pragma unroll
        for (int h = 0; h < 8; ++h) s[h] = valid ? s[h] - slope[h] * dist : -INFINITY;
        const bf16* vlane = c.proj() + (long)((long)b * SEQ + r0) * PP + C_KV + 5 * 128 + g * 64 + lane;
        tile_update(W, s, vlane, PP, jlo, 63, ps, lane);
    }
#pragma unroll
    for (int h = 0; h < 8; ++h) {
        const bf16* gp = prow + C_GN + g * 24 + h * 3;
        const float g0 = sigmoidf(bf2f(gp[0])), g1 = sigmoidf(bf2f(gp[1])), g2 = sigmoidf(bf2f(gp[2]));
        const float on = g0 * ocmp[h] + g1 * oslc[h] + g2 * (W.o[h] / W.l[h]);
        c.o()[row * DM + 1024 + (g * 8 + h) * 64 + lane] = f2bf(on);
    }
}

#define EPI_LOOP for (int m = 0; m < 4; ++m) for (int n = 0; n < 2; ++n) for (int j = 0; j < 4; ++j)
struct EpiProj { bf16* proj; const float* bias; int row0, col0;
    __device__ __forceinline__ void operator()(const f32x4 (&acc)[4][2], int wr, int wc, int fr, int fq) const {
#pragma unroll
        for (int m = 0; m < 4; ++m)
#pragma unroll
            for (int n = 0; n < 2; ++n)
#pragma unroll
                for (int j = 0; j < 4; ++j) { const int r = row0 + wr * 64 + m * 16 + fq * 4 + j, cc = col0 + wc * 32 + n * 16 + fr;
                    const float v = cc < INC ? acc[m][n][j] + bias[cc] : 0.f; proj[(size_t)r * PP + cc] = f2bf(v); } } };
struct EpiCmp1 { float* hb; int row0, col0;
    __device__ __forceinline__ void operator()(const f32x4 (&acc)[4][2], int wr, int wc, int fr, int fq) const {
#pragma unroll
        for (int m = 0; m < 4; ++m)
#pragma unroll
            for (int n = 0; n < 2; ++n)
#pragma unroll
                for (int j = 0; j < 4; ++j) { const int r = row0 + wr * 64 + m * 16 + fq * 4 + j, cc = col0 + wc * 32 + n * 16 + fr;
                    hb[(size_t)r * 256 + cc] = gelu_tanh(acc[m][n][j]); } } };
struct EpiCmp2 { bf16* kvc; int row0;
    __device__ __forceinline__ void operator()(const f32x4 (&acc)[4][2], int wr, int wc, int fr, int fq) const {
#pragma unroll
        for (int m = 0; m < 4; ++m)
#pragma unroll
            for (int n = 0; n < 2; ++n)
#pragma unroll
                for (int j = 0; j < 4; ++j) { const int r = row0 + wr * 64 + m * 16 + fq * 4 + j, cc = wc * 32 + n * 16 + fr;
                    if (cc < 64) kvc[(size_t)r * 64 + cc] = f2bf(acc[m][n][j]); } } };
struct EpiOut { float* y; const float* bias; const float* xres; int row0, col0;
    __device__ __forceinline__ void operator()(const f32x4 (&acc)[4][2], int wr, int wc, int fr, int fq) const {
#pragma unroll
        for (int m = 0; m < 4; ++m)
#pragma unroll
            for (int n = 0; n < 2; ++n)
#pragma unroll
                for (int j = 0; j < 4; ++j) { const int r = row0 + wr * 64 + m * 16 + fq * 4 + j, cc = col0 + wc * 32 + n * 16 + fr;
                    y[(size_t)r * DM + cc] = acc[m][n][j] + bias[cc] + ALPHA * xres[(size_t)r * DM + cc]; } } };
struct EpiLogit { float* lg; const float* bg; const float* be; int row0;
    __device__ __forceinline__ void operator()(const f32x4 (&acc)[4][2], int wr, int wc, int fr, int fq) const {
#pragma unroll
        for (int m = 0; m < 4; ++m)
#pragma unroll
            for (int n = 0; n < 2; ++n)
#pragma unroll
                for (int j = 0; j < 4; ++j) { const int r = row0 + wr * 64 + m * 16 + fq * 4 + j, cc = wc * 32 + n * 16 + fr;
                    if (cc < 72) lg[(size_t)r * NLOG + cc] = acc[m][n][j] + (cc < 8 ? bg[cc] : be[cc - 8]); } } };
struct EpiMoe1 { bf16* H; int rowbase, cnt, rt, ct;
    __device__ __forceinline__ void operator()(const f32x4 (&acc)[4][2], int wr, int wc, int fr, int fq) const {
#pragma unroll
        for (int m = 0; m < 4; ++m)
#pragma unroll
            for (int j = 0; j < 4; ++j) { const int pos = rt * 128 + wr * 64 + m * 16 + fq * 4 + j;
                if (pos < cnt) { const float gv = acc[m][0][j], uv = acc[m][1][j]; const float hv = gv / (1.f + expf(-gv)) * uv;
                    H[(size_t)(rowbase + pos) * EH + ct * 64 + wc * 16 + fr] = f2bf(hv); } } } };
struct EpiMoe2 { float* contrib; const int* lslot; const float* lw; int cnt, rt, col0;
    __device__ __forceinline__ void operator()(const f32x4 (&acc)[4][2], int wr, int wc, int fr, int fq) const {
#pragma unroll
        for (int m = 0; m < 4; ++m)
#pragma unroll
            for (int j = 0; j < 4; ++j) { const int pos = rt * 128 + wr * 64 + m * 16 + fq * 4 + j;
                if (pos < cnt) { const int slot = lslot[pos]; const float w = lw[pos];
#pragma unroll
                    for (int n = 0; n < 2; ++n) contrib[(size_t)slot * DM + col0 + wc * 32 + n * 16 + fr] = acc[m][n][j] * w; } } } };

__device__ __forceinline__ void ph_inproj(const Ctx& c, int L, const float* xin) {
    const float* W = c.w_in() + (size_t)L * DM * INC; const float* bias = c.b_in() + L * INC;
    const int ar = c.tid >> 2, bn = c.tid & 127;
    for (int u = blockIdx.x; u < 128 * 25; u += gridDim.x) {
        const int rt = u / 25, ct = u % 25;
        ALf32 al{xin + (size_t)(rt * 128 + ar) * DM};
        const int col = ct * 128 + bn;
        BLf32 bl{col < INC ? W + col : nullptr, (size_t)INC};
        EpiProj ep{c.proj(), bias, rt * 128, ct * 128};
        gemm_tile(c.lds, al, bl, ep, DM);
    }
}
__device__ __forceinline__ void ph_cmp1_swa(const Ctx& c, int L) {
    const int ar = c.tid >> 2, bn = c.tid & 127;
    for (int u = blockIdx.x; u < 64; u += gridDim.x) {
        const int which = u >> 5, rt = (u >> 1) & 15, ct = u & 1;
        const int r = rt * 128 + ar;
        const bf16* base = nullptr;
        if (r < CMPROWS) { const int g = r & 1, bn_ = r >> 1, n = bn_ % NCMP, b = bn_ / NCMP;
            base = c.proj() + ((size_t)b * SEQ + 16 * n) * PP + C_KV + which * 128 + g * 64; }
        ALcmp al{base, (which ? c.pe_v() : c.pe_k()) + (size_t)L * 2048};
        BLf32 bl{(which ? c.w1_v() : c.w1_k()) + (size_t)L * 2048 * 256 + ct * 128 + bn, (size_t)256};
        EpiCmp1 ep{c.hb() + (size_t)which * 2048 * 256, rt * 128, ct * 128};
        gemm_tile(c.lds, al, bl, ep, 2048);
    }
    LAS float* qs = (LAS float*)(c.lds + L_ATT + c.wid * 5120); LAS float* ps = qs + 512;
    for (int job = blockIdx.x * 8 + c.wid; job < NB * 2 * SEQ; job += gridDim.x * 8) swa_job(c, L, job, qs, ps);
}
__device__ __forceinline__ void ph_cmp2(const Ctx& c, int L) {
    const int ar = c.tid >> 2, bn = c.tid & 127;
    for (int u = blockIdx.x; u < 32; u += gridDim.x) {
        const int which = u >> 4, rt = u & 15;
        ALf32 al{c.hb() + (size_t)which * 2048 * 256 + (size_t)(rt * 128 + ar) * 256};
        BLf32 bl{bn < 64 ? (which ? c.w2_v() : c.w2_k()) + (size_t)L * 256 * 64 + bn : nullptr, (size_t)64};
        EpiCmp2 ep{c.kvc() + (size_t)which * 2048 * 64, rt * 128};
        gemm_tile(c.lds, al, bl, ep, 256);
    }
}
__device__ __forceinline__ void ph_nsa(const Ctx& c, int L) {
    LAS float* qs = (LAS float*)(c.lds + L_ATT + c.wid * 5120); LAS float* ps = qs + 512; LAS float* pimp = qs + 1024;
    for (int job = blockIdx.x * 8 + c.wid; job < NB * 2 * SEQ; job += gridDim.x * 8) nsa_job(c, L, job, qs, ps, pimp);
}
__device__ __forceinline__ void ph_outproj(const Ctx& c, int L, const float* xin) {
    const float* W = c.w_out() + (size_t)L * DM * DM; const float* bias = c.b_out() + L * DM;
    const int ar = c.tid >> 2, bn = c.tid & 127;
    for (int u = blockIdx.x; u < 128 * 16; u += gridDim.x) {
        const int rt = u / 16, ct = u % 16;
        ALbf16 al{c.o() + (size_t)(rt * 128 + ar) * DM};
        BLf32 bl{W + ct * 128 + bn, (size_t)DM};
        EpiOut ep{c.y(), bias, xin, rt * 128, ct * 128};
        gemm_tile(c.lds, al, bl, ep, DM);
    }
}
__device__ __forceinline__ void ph_ln(const Ctx& c, const float* src, float sscale, const float* add, float* dst, const float* gam, const float* bet) {
    const int lane = c.lane;
    for (int r = blockIdx.x * 8 + c.wid; r < MTOK; r += gridDim.x * 8) {
        const f32x4* sp = (const f32x4*)(src + (size_t)r * DM) + lane;
        f32x4 v[8]; float s = 0.f;
#pragma unroll
        for (int j = 0; j < 8; ++j) { v[j] = sp[64 * j] * sscale; }
        if (add) {
            const f32x4* a0 = (const f32x4*)(add + (size_t)(2 * r) * DM) + lane; const f32x4* a1 = (const f32x4*)(add + (size_t)(2 * r + 1) * DM) + lane;
#pragma unroll
            for (int j = 0; j < 8; ++j) v[j] = v[j] + (a0[64 * j] + a1[64 * j]);
        }
#pragma unroll
        for (int j = 0; j < 8; ++j) s += (v[j].x + v[j].y) + (v[j].z + v[j].w);
        const float mean = wave_sum(s) * (1.f / DM); float s2 = 0.f;
#pragma unroll
        for (int j = 0; j < 8; ++j) { v[j] = v[j] - mean; s2 += (v[j].x * v[j].x + v[j].y * v[j].y) + (v[j].z * v[j].z + v[j].w * v[j].w); }
        const float rstd = 1.f / sqrtf(wave_sum(s2) * (1.f / DM) + LN_EPS);
        f32x4* dp = (f32x4*)(dst + (size_t)r * DM) + lane; const f32x4* gp = (const f32x4*)gam + lane; const f32x4* bp = (const f32x4*)bet + lane;
#pragma unroll
        for (int j = 0; j < 8; ++j) dp[64 * j] = v[j] * rstd * gp[64 * j] + bp[64 * j];
    }
}
__device__ __forceinline__ void ph_router(const Ctx& c, int L) {
    const int ar = c.tid >> 2, bn = c.tid & 127;
    const float* colp = nullptr; size_t ldb = 8;
    if (bn < 8) { colp = c.w_group() + (size_t)L * DM * 8 + bn; ldb = 8; } else if (bn < 72) { colp = c.w_expert() + (size_t)L * DM * 64 + (bn - 8); ldb = 64; }
    for (int u = blockIdx.x; u < 128; u += gridDim.x) {
        ALf32 al{c.x1() + (size_t)(u * 128 + ar) * DM};
        BLf32 bl{colp, ldb};
        EpiLogit ep{c.logits(), c.b_group() + L * 8, c.b_expert() + L * 64, u * 128};
        gemm_tile(c.lds, al, bl, ep, DM);
    }
}
__device__ __forceinline__ void ph_route(const Ctx& c, int L) {
    unsigned* cnt = c.cnt() + L * 64;
    for (int tok = blockIdx.x * 512 + c.tid; tok < MTOK; tok += gridDim.x * 512) {
        const float* lg = c.logits() + (size_t)tok * NLOG;
        float gl[8];
#pragma unroll
        for (int i = 0; i < 8; ++i) gl[i] = lg[i];
        int gs = 0; float gm = gl[0];
#pragma unroll
        for (int i = 1; i < 8; ++i) if (gl[i] > gm) { gm = gl[i]; gs = i; }
        float gsum = 0.f;
#pragma unroll
        for (int i = 0; i < 8; ++i) gsum += expf(gl[i] - gm);
        const float gw = 1.f / gsum;
        float el[8];
#pragma unroll
        for (int i = 0; i < 8; ++i) el[i] = lg[8 + gs * 8 + i];
        int i0 = 0; float v0 = el[0];
#pragma unroll
        for (int i = 1; i < 8; ++i) if (el[i] > v0) { v0 = el[i]; i0 = i; }
        int i1 = -1; float v1 = -INFINITY;
#pragma unroll
        for (int i = 0; i < 8; ++i) if (i != i0 && el[i] > v1) { v1 = el[i]; i1 = i; }
        const float e1 = expf(v1 - v0);
        const float w0 = gw / (1.f + e1), w1 = gw * e1 / (1.f + e1);
        const int ea = gs * 8 + i0, eb = gs * 8 + i1;
        const unsigned pa = atomicAdd(&cnt[ea], 1u); c.lslot()[(size_t)ea * LCAP + pa] = tok * 2; c.lw()[(size_t)ea * LCAP + pa] = w0;
        const unsigned pb = atomicAdd(&cnt[eb], 1u); c.lslot()[(size_t)eb * LCAP + pb] = tok * 2 + 1; c.lw()[(size_t)eb * LCAP + pb] = w1;
    }
}
__device__ __forceinline__ void moe_tables(const Ctx& c, int L) {
    LAS int* tab = (LAS int*)(c.lds + L_TAB);
    __syncthreads();
    if (c.tid < 64) tab[c.tid] = (int)c.cnt()[L * 64 + c.tid];
    __syncthreads();
    if (c.tid == 0) { int rb = 0, tb = 0; for (int e = 0; e < 64; ++e) { tab[64 + e] = rb; tab[128 + e] = tb; rb += tab[e]; tb += (tab[e] + 127) >> 7; } tab[192] = tb; }
    __syncthreads();
}
__device__ __forceinline__ int moe_find(const LAS int* tab, int rtg) { int e = 0; for (int i = 1; i < 64; ++i) if (tab[128 + i] <= rtg) e = i; return e; }
__device__ __forceinline__ void ph_moe1(const Ctx& c, int L) {
    moe_tables(c, L);
    const LAS int* tab = (const LAS int*)(c.lds + L_TAB);
    const int ar = c.tid >> 2, bn = c.tid & 127;
    const int ntile = tab[192];
    for (int u = blockIdx.x; u < ntile * 8; u += gridDim.x) {
        const int rtg = u >> 3, ct = u & 7; const int e = moe_find(tab, rtg); const int rt = rtg - tab[128 + e], cnt = tab[e], rowbase = tab[64 + e];
        const int pos = rt * 128 + ar;
        const float* rowp = nullptr;
        if (pos < cnt) { const int slot = c.lslot()[(size_t)e * LCAP + pos]; rowp = c.x1() + (size_t)(slot >> 1) * DM; }
        ALf32 al{rowp};
        const int wcv = bn >> 5, nsel = (bn >> 4) & 1, cc = bn & 15; const int hcol = ct * 64 + wcv * 16 + cc;
        const float* Wsel = (nsel ? c.we_up() : c.we_gate()) + ((size_t)L * NE + e) * DM * EH;
        BLf32 bl{Wsel + hcol, (size_t)EH};
        EpiMoe1 ep{c.H(), rowbase, cnt, rt, ct};
        gemm_tile(c.lds, al, bl, ep, DM);
    }
}
__device__ __forceinline__ void ph_moe2(const Ctx& c, int L) {
    moe_tables(c, L);
    const LAS int* tab = (const LAS int*)(c.lds + L_TAB);
    const int ar = c.tid >> 2, bn = c.tid & 127;
    const int ntile = tab[192];
    for (int u = blockIdx.x; u < ntile * 16; u += gridDim.x) {
        const int rtg = u >> 4, ct = u & 15; const int e = moe_find(tab, rtg); const int rt = rtg - tab[128 + e], cnt = tab[e], rowbase = tab[64 + e];
        const int pos = rt * 128 + ar;
        ALbf16 al{pos < cnt ? c.H() + (size_t)(rowbase + pos) * EH : nullptr};
        BLf32 bl{c.we_down() + ((size_t)L * NE + e) * EH * DM + ct * 128 + bn, (size_t)DM};
        EpiMoe2 ep{c.contrib(), c.lslot() + (size_t)e * LCAP, c.lw() + (size_t)e * LCAP, cnt, rt, ct * 128};
        gemm_tile(c.lds, al, bl, ep, EH);
    }
}

__global__ void __launch_bounds__(512, 2) fwd(Args a) {
    extern __shared__ __attribute__((aligned(16))) unsigned char smem[];
    unsigned char* ws = a.ws;
    const int tid0 = threadIdx.x;
    volatile LAS unsigned* barw = (volatile LAS unsigned*)((LAS unsigned char*)smem + L_BARW);
    if (tid0 < 4) barw[tid0] = 0u;
    __syncthreads();
    const int lo = a.lo, hi = a.hi;
    XcdBarrier bar; bar.bar = (unsigned*)(ws + WS_CTL) + CW_BAR; bar.x = 0; bar.st = barw;
    if (hi - lo > 1) bar = xcd_barrier_post((unsigned*)(ws + WS_CTL) + CW_BAR, barw);
#ifndef PHMASK
#define PHMASK 0x7ff
#endif
#define IN(k) (((PHMASK >> ((k) % NPH)) & 1) && lo <= (k) && (k) < hi)
#define SEAM(k) do { if ((k) + 1 < hi) xcd_barrier(bar); } while (0)
#define PCTX() Ctx c; { int t_ = threadIdx.x; asm volatile("" : "+v"(t_)); c.tid = t_; c.lane = t_ & 63; c.wid = __builtin_amdgcn_readfirstlane(t_ >> 6); c.lds = (LAS unsigned char*)smem; c.a = &a; }
    for (int L = 0; L < DEPTH; ++L) {
        const int pb = L * NPH;
        if (IN(pb + 0)) { PCTX(); ph_inproj(c, L, L == 0 ? c.x_in() : c.x2()); SEAM(pb + 0); }
        if (IN(pb + 1)) { PCTX(); ph_cmp1_swa(c, L); SEAM(pb + 1); }
        if (IN(pb + 2)) { PCTX(); ph_cmp2(c, L); SEAM(pb + 2); }
        if (IN(pb + 3)) { PCTX(); ph_nsa(c, L); SEAM(pb + 3); }
        if (IN(pb + 4)) { PCTX(); ph_outproj(c, L, L == 0 ? c.x_in() : c.x2()); SEAM(pb + 4); }
        if (IN(pb + 5)) { PCTX(); ph_ln(c, c.y(), 1.f, nullptr, c.x1(), c.ln1_g() + L * DM, c.ln1_b() + L * DM); SEAM(pb + 5); }
        if (IN(pb + 6)) { PCTX(); ph_router(c, L); SEAM(pb + 6); }
        if (IN(pb + 7)) { PCTX(); ph_route(c, L); SEAM(pb + 7); }
        if (IN(pb + 8)) { PCTX(); ph_moe1(c, L); SEAM(pb + 8); }
        if (IN(pb + 9)) { PCTX(); ph_moe2(c, L); SEAM(pb + 9); }
        if (IN(pb + 10)) { PCTX(); ph_ln(c, c.x1(), ALPHA, c.contrib(), L == DEPTH - 1 ? c.out() : c.x2(), c.ln2_g() + L * DM, c.ln2_b() + L * DM); SEAM(pb + 10); }
    }
#undef IN
#undef SEAM
}

extern "C" void kernel_launch(void* const* d_in, const int* in_sizes, int n_in, void* d_out, int out_size, void* d_ws, size_t ws_size, hipStream_t stream) {
    static int grid = 0;
    if (grid == 0) {
        if (n_in != 23 || out_size != MTOK * DM || ws_size < WS_END) { fprintf(stderr, "kernel_launch: unexpected shapes (n_in %d out %d ws %zu)\n", n_in, out_size, ws_size); grid = -1; return; }
        int dev = 0, cus = 0;
        if (hipGetDevice(&dev) != hipSuccess || hipDeviceGetAttribute(&cus, hipDeviceAttributeMultiprocessorCount, dev) != hipSuccess) { grid = -1; return; }
        if (hipFuncSetAttribute((const void*)fwd, hipFuncAttributeMaxDynamicSharedMemorySize, LDS_BYTES) != hipSuccess) { fprintf(stderr, "kernel_launch: hipFuncSetAttribute failed\n"); grid = -1; return; }
        int per_cu = 0;
        (void)hipOccupancyMaxActiveBlocksPerMultiprocessor(&per_cu, (const void*)fwd, 512, LDS_BYTES);
        (void)hipGetLastError();
        grid = cus;
    }
    if (grid < 0) return;
    (void)hipMemsetAsync((char*)d_ws + WS_CTL, 0, CTL_BYTES, stream);
    Args a{};
    for (int i = 0; i < 23; ++i) a.in[i] = (const float*)d_in[i];
    a.out = (float*)d_out; a.ws = (unsigned char*)d_ws;
#if ONE_LAUNCH
    a.lo = 0; a.hi = DEPTH * NPH;
    hipLaunchKernelGGL(fwd, dim3(grid), dim3(512), LDS_BYTES, stream, a);
#else
    for (int k = 0; k < DEPTH * NPH; ++k) { a.lo = k; a.hi = k + 1; hipLaunchKernelGGL(fwd, dim3(grid), dim3(512), LDS_BYTES, stream, a); }
#endif
}
```

```cpp
#include <hip/hip_runtime.h>
#include <cstdio>
#include <cstdint>
#include <cmath>

#ifndef ONE_LAUNCH
#define ONE_LAUNCH 1
#endif

#ifndef USE_MFMA_WIN
#define USE_MFMA_WIN 1
#endif
#ifndef USE_MFMA_SWA
#define USE_MFMA_SWA 1
#endif
#ifndef USE_MFMA_SLC
#define USE_MFMA_SLC 1
#endif

#define LAS __attribute__((address_space(3)))
typedef unsigned short bf16;
typedef short bf16x8 __attribute__((ext_vector_type(8)));
typedef float f32x4 __attribute__((ext_vector_type(4)));
typedef unsigned u32x4 __attribute__((ext_vector_type(4)));

constexpr int DM = 2048, SEQ = 4096, NB = 4, MTOK = NB * SEQ, DEPTH = 2;
constexpr int INC = 3120, PP = 3200;
constexpr int C_QA = 0, C_KA = 1024, C_VA = 1152, C_QN = 1280, C_KV = 2304, C_GN = 3072;
constexpr int NCMP = 255, CMPROWS = NB * NCMP * 2;
constexpr int NE = 64, EH = 512, LCAP = MTOK;
constexpr int NLOG = 80;
constexpr float ALPHA = 1.41421356237309515f;
constexpr float LN_EPS = 1e-5f;
constexpr int NPH = 11;

constexpr size_t MiB = 1u << 20;
constexpr size_t WS_CTL = 0, CTL_BYTES = 1 * MiB;
constexpr size_t WS_PROJ = 2 * MiB;
constexpr size_t WS_O = 102 * MiB;
constexpr size_t WS_Y = 166 * MiB;
constexpr size_t WS_X1 = 294 * MiB;
constexpr size_t WS_X2 = 422 * MiB;
constexpr size_t WS_HB = 550 * MiB;
constexpr size_t WS_KVC = 554 * MiB;
constexpr size_t WS_LOG = 555 * MiB;
constexpr size_t WS_LSLOT = 561 * MiB;
constexpr size_t WS_LW = 565 * MiB;
constexpr size_t WS_H = 569 * MiB;
constexpr size_t WS_CONTRIB = 601 * MiB;
constexpr size_t WS_END = 857 * MiB;
constexpr int CW_BAR = 4096;
constexpr int CW_CNT = 16384;

constexpr int L_GEMM = 0;
constexpr int L_TAB = 24576;
constexpr int L_BARW = 28672;
constexpr int L_ATT = 32768;
constexpr int L_KV = 73728;
constexpr int L_IMPA = 110592;
constexpr int L_IMPB = 126976;
constexpr int L_SEL = 143616;
constexpr int LDS_BYTES = 147456;

__device__ __forceinline__ float bf2f(unsigned h) { return __uint_as_float(h << 16); }
__device__ __forceinline__ unsigned cvt_pk_bf16(float lo, float hi) { unsigned r; asm("v_cvt_pk_bf16_f32 %0, %1, %2" : "=v"(r) : "v"(lo), "v"(hi)); return r; }
__device__ __forceinline__ bf16 f2bf(float f) { return (bf16)(cvt_pk_bf16(f, 0.f) & 0xffffu); }
__device__ __forceinline__ float wave_sum(float v) {
#pragma unroll
    for (int o = 1; o < 64; o <<= 1) v += __shfl_xor(v, o);
    return v;
}
__device__ __forceinline__ float wave_max(float v) {
#pragma unroll
    for (int o = 1; o < 64; o <<= 1) v = fmaxf(v, __shfl_xor(v, o));
    return v;
}
__device__ __forceinline__ float gelu_tanh(float x) {
    const float u = 0.7978845608028654f * (x + 0.044715f * x * x * x);
    const float e = expf(2.f * u);
    const float th = 1.f - 2.f / (e + 1.f);
    return 0.5f * x * (1.f + th);
}
__device__ __forceinline__ float sigmoidf(float x) { return 1.f / (1.f + expf(-x)); }
__device__ __forceinline__ float rfl(float v) { return __builtin_bit_cast(float, __builtin_amdgcn_readfirstlane(__builtin_bit_cast(int, v))); }
#define WAVE_LDS_FENCE() do { asm volatile("s_waitcnt lgkmcnt(0)" ::: "memory"); __builtin_amdgcn_wave_barrier(); } while (0)

#define XB_TMO      128
#define XB_XCNT(j)  (256  + 64 * (j))
#define XB_XSUB(j)  (1280 + 64 * (j))
#define XB_XGEN(j)  (2304 + 64 * (j))
#define XB_TOP      3328
#define XB_TOPGEN   3392
#define XCD_BAR_WORDS 3456
#define XB_SPIN_CAP (1u << 24)

__device__ __forceinline__ unsigned xb_ld(unsigned* p)              { return __hip_atomic_load(p, __ATOMIC_RELAXED, __HIP_MEMORY_SCOPE_AGENT); }
__device__ __forceinline__ unsigned xb_add(unsigned* p, unsigned v) { return __hip_atomic_fetch_add(p, v, __ATOMIC_RELAXED, __HIP_MEMORY_SCOPE_AGENT); }
__device__ __forceinline__ unsigned xb_xcc_id() { return (unsigned)__builtin_amdgcn_s_getreg((3 << 11) | 20) & 0xFu; }
#define XB_SPIN(cond, bar) do { unsigned _sp = 0; while (cond) { __builtin_amdgcn_s_sleep(1); \
    if ((++_sp & 255u) == 0u) { if (xb_ld(&(bar)[XB_TMO])) break; if (_sp > XB_SPIN_CAP) { atomicAdd(&(bar)[XB_TMO], 1u); break; } } } } while (0)

struct XcdBarrier { unsigned* bar; unsigned x; volatile LAS unsigned* st; };

__device__ __forceinline__ XcdBarrier xcd_barrier_post(unsigned* bar, volatile LAS unsigned* st) {
    XcdBarrier b; b.bar = bar; b.x = xb_xcc_id(); b.st = st;
    if (threadIdx.x == 0) (void)xb_add(&bar[XB_XCNT(b.x)], 1u);
    return b;
}
__device__ __forceinline__ void xcd_barrier_complete(unsigned* bar, unsigned x, unsigned& nloc, unsigned& nx) {
    const unsigned G = gridDim.x * gridDim.y * gridDim.z;
    unsigned sum, cnt, mine, sp = 0u;
    for (;;) {
        sum = 0u; cnt = 0u; mine = 0u;
#pragma unroll
        for (unsigned j = 0; j < 16; ++j) { const unsigned c = xb_ld(&bar[XB_XCNT(j)]); sum += c; cnt += (c > 0u) ? 1u : 0u; mine = (j == x) ? c : mine; }
        if (sum == G) break;
        __builtin_amdgcn_s_sleep(1);
        if ((++sp & 255u) == 0u) { if (xb_ld(&bar[XB_TMO])) break; if (sp > XB_SPIN_CAP) { atomicAdd(&bar[XB_TMO], 1u); break; } }
    }
    nloc = mine > 0u ? mine : 1u; nx = cnt > 0u ? cnt : 1u;
}
__device__ __forceinline__ void xcd_barrier(const XcdBarrier& b) {
    asm volatile("s_waitcnt vmcnt(0)" ::: "memory");
    __syncthreads();
    if (threadIdx.x == 0) {
        unsigned* bar = b.bar;
        __builtin_amdgcn_s_waitcnt(0);
        unsigned nloc = b.st[0], nx = b.st[1];
        if (nloc == 0u) { xcd_barrier_complete(bar, b.x, nloc, nx); b.st[0] = nloc; b.st[1] = nx; }
        const unsigned old = xb_add(&bar[XB_XSUB(b.x)], 1u);
        const unsigned gen = old / nloc;
        if (old + 1u == (gen + 1u) * nloc) {
            __builtin_amdgcn_fence(__ATOMIC_RELEASE, "agent");
            asm volatile("s_waitcnt vmcnt(0)" ::: "memory");
            const unsigned og = xb_add(&bar[XB_TOP], 1u);
            const unsigned tg = og / nx;
            if (og + 1u == (tg + 1u) * nx) xb_add(&bar[XB_TOPGEN], 1u);
            else XB_SPIN(xb_ld(&bar[XB_TOPGEN]) == tg, bar);
            __builtin_amdgcn_fence(__ATOMIC_ACQUIRE, "agent");
            xb_add(&bar[XB_XGEN(b.x)], 1u);
            asm volatile("s_waitcnt vmcnt(0)" ::: "memory");
        } else {
            XB_SPIN(xb_ld(&bar[XB_XGEN(b.x)]) == gen, bar);
            __builtin_amdgcn_fence(__ATOMIC_ACQUIRE, "agent");
            asm volatile("s_waitcnt vmcnt(0)" ::: "memory");
        }
    }
    __syncthreads();
}

template <class AL, class BL, class EP>
__device__ __forceinline__ void gemm_tile(LAS unsigned char* lds, const AL& al, const BL& bl, const EP& ep, int K) {
    const int tid = threadIdx.x, wid = tid >> 6, lane = tid & 63, wr = wid >> 2, wc = wid & 3, fr = lane & 15, fq = lane >> 4;
    LAS bf16* As = (LAS bf16*)(lds + L_GEMM);
    LAS bf16* Bs = As + 128 * 40;
    const int ar = tid >> 2, akq = (tid & 3) * 8;
    const int bn = tid & 127, bkg = (tid >> 7) * 8;
    f32x4 acc[4][2];
#pragma unroll
    for (int m = 0; m < 4; ++m)
#pragma unroll
        for (int n = 0; n < 2; ++n) acc[m][n] = (f32x4){0.f, 0.f, 0.f, 0.f};
    bf16x8 ra = al.load(akq);
    float rb0 = bl.load(bkg + 0), rb1 = bl.load(bkg + 1), rb2 = bl.load(bkg + 2), rb3 = bl.load(bkg + 3),
          rb4 = bl.load(bkg + 4), rb5 = bl.load(bkg + 5), rb6 = bl.load(bkg + 6), rb7 = bl.load(bkg + 7);
    for (int k0 = 0; k0 < K; k0 += 32) {
        *(LAS bf16x8*)(As + ar * 40 + akq) = ra;
        u32x4 pb; pb.x = cvt_pk_bf16(rb0, rb1); pb.y = cvt_pk_bf16(rb2, rb3); pb.z = cvt_pk_bf16(rb4, rb5); pb.w = cvt_pk_bf16(rb6, rb7);
        *(LAS u32x4*)(Bs + bn * 40 + bkg) = pb;
        __syncthreads();
        if (k0 + 32 < K) {
            const int kn = k0 + 32;
            ra = al.load(kn + akq);
            rb0 = bl.load(kn + bkg + 0); rb1 = bl.load(kn + bkg + 1); rb2 = bl.load(kn + bkg + 2); rb3 = bl.load(kn + bkg + 3);
            rb4 = bl.load(kn + bkg + 4); rb5 = bl.load(kn + bkg + 5); rb6 = bl.load(kn + bkg + 6); rb7 = bl.load(kn + bkg + 7);
        }
        bf16x8 af[4], bfr[2];
#pragma unroll
        for (int m = 0; m < 4; ++m) af[m] = *(const LAS bf16x8*)(As + (wr * 64 + m * 16 + fr) * 40 + fq * 8);
#pragma unroll
        for (int n = 0; n < 2; ++n) bfr[n] = *(const LAS bf16x8*)(Bs + (wc * 32 + n * 16 + fr) * 40 + fq * 8);
#pragma unroll
        for (int m = 0; m < 4; ++m)
#pragma unroll
            for (int n = 0; n < 2; ++n) acc[m][n] = __builtin_amdgcn_mfma_f32_16x16x32_bf16(af[m], bfr[n], acc[m][n], 0, 0, 0);
        __syncthreads();
    }
    ep(acc, wr, wc, fr, fq);
}

__device__ __forceinline__ bf16x8 pack8(f32x4 a, f32x4 b) {
    u32x4 p; p.x = cvt_pk_bf16(a.x, a.y); p.y = cvt_pk_bf16(a.z, a.w); p.z = cvt_pk_bf16(b.x, b.y); p.w = cvt_pk_bf16(b.z, b.w);
    return __builtin_bit_cast(bf16x8, p);
}
__device__ __forceinline__ bf16x8 zero8() { u32x4 p = {0u, 0u, 0u, 0u}; return __builtin_bit_cast(bf16x8, p); }

struct ALf32 { const float* rowp; __device__ __forceinline__ bf16x8 load(int k) const { if (!rowp) return zero8(); const f32x4 a = *(const f32x4*)(rowp + k), b = *(const f32x4*)(rowp + k + 4); return pack8(a, b); } };
struct ALbf16 { const bf16* rowp; __device__ __forceinline__ bf16x8 load(int k) const { if (!rowp) return zero8(); return *(const bf16x8*)(rowp + k); } };
struct ALcmp { const bf16* base; const float* pe; __device__ __forceinline__ bf16x8 load(int k) const {
        if (!base) return zero8();
        const int l = k >> 6, d = k & 63;
        const u32x4 v = *(const u32x4*)(base + (size_t)l * PP + d);
        const f32x4 p0 = *(const f32x4*)(pe + k), p1 = *(const f32x4*)(pe + k + 4);
        f32x4 a, b;
        a.x = bf2f(v.x & 0xffffu) + p0.x; a.y = bf2f(v.x >> 16) + p0.y; a.z = bf2f(v.y & 0xffffu) + p0.z; a.w = bf2f(v.y >> 16) + p0.w;
        b.x = bf2f(v.z & 0xffffu) + p1.x; b.y = bf2f(v.z >> 16) + p1.y; b.z = bf2f(v.w & 0xffffu) + p1.z; b.w = bf2f(v.w >> 16) + p1.w;
        return pack8(a, b); } };
struct BLf32 { const float* colp; size_t ldb; __device__ __forceinline__ float load(int k) const { return colp ? colp[(size_t)k * ldb] : 0.f; } };

struct Args { const float* in[23]; float* out; unsigned char* ws; int lo, hi; };

struct Ctx {
    LAS unsigned char* lds;
    int tid, lane, wid;
    const Args* a;
    __device__ __forceinline__ const float* x_in() const { return a->in[0]; }
    __device__ __forceinline__ const float* w_in() const { return a->in[1]; }
    __device__ __forceinline__ const float* b_in() const { return a->in[2]; }
    __device__ __forceinline__ const float* sinks() const { return a->in[3]; }
    __device__ __forceinline__ const float* pe_k() const { return a->in[4]; }
    __device__ __forceinline__ const float* w1_k() const { return a->in[5]; }
    __device__ __forceinline__ const float* w2_k() const { return a->in[6]; }
    __device__ __forceinline__ const float* pe_v() const { return a->in[7]; }
    __device__ __forceinline__ const float* w1_v() const { return a->in[8]; }
    __device__ __forceinline__ const float* w2_v() const { return a->in[9]; }
    __device__ __forceinline__ const float* w_out() const { return a->in[10]; }
    __device__ __forceinline__ const float* b_out() const { return a->in[11]; }
    __device__ __forceinline__ const float* ln1_g() const { return a->in[12]; }
    __device__ __forceinline__ const float* ln1_b() const { return a->in[13]; }
    __device__ __forceinline__ const float* w_group() const { return a->in[14]; }
    __device__ __forceinline__ const float* b_group() const { return a->in[15]; }
    __device__ __forceinline__ const float* w_expert() const { return a->in[16]; }
    __device__ __forceinline__ const float* b_expert() const { return a->in[17]; }
    __device__ __forceinline__ const float* we_gate() const { return a->in[18]; }
    __device__ __forceinline__ const float* we_up() const { return a->in[19]; }
    __device__ __forceinline__ const float* we_down() const { return a->in[20]; }
    __device__ __forceinline__ const float* ln2_g() const { return a->in[21]; }
    __device__ __forceinline__ const float* ln2_b() const { return a->in[22]; }
    __device__ __forceinline__ float* out() const { return a->out; }
    __device__ __forceinline__ bf16* proj() const { return (bf16*)(a->ws + WS_PROJ); }
    __device__ __forceinline__ bf16* o() const { return (bf16*)(a->ws + WS_O); }
    __device__ __forceinline__ bf16* kvc() const { return (bf16*)(a->ws + WS_KVC); }
    __device__ __forceinline__ bf16* H() const { return (bf16*)(a->ws + WS_H); }
    __device__ __forceinline__ float* y() const { return (float*)(a->ws + WS_Y); }
    __device__ __forceinline__ float* x1() const { return (float*)(a->ws + WS_X1); }
    __device__ __forceinline__ float* x2() const { return (float*)(a->ws + WS_X2); }
    __device__ __forceinline__ float* hb() const { return (float*)(a->ws + WS_HB); }
    __device__ __forceinline__ float* logits() const { return (float*)(a->ws + WS_LOG); }
    __device__ __forceinline__ float* lw() const { return (float*)(a->ws + WS_LW); }
    __device__ __forceinline__ float* contrib() const { return (float*)(a->ws + WS_CONTRIB); }
    __device__ __forceinline__ int* lslot() const { return (int*)(a->ws + WS_LSLOT); }
    __device__ __forceinline__ unsigned* cnt() const { return (unsigned*)(a->ws + WS_CTL) + CW_CNT; }
};

struct AttnState { float m[8], l[8], o[8]; };

__device__ __forceinline__ void load_q(LAS float* qs, const bf16* qrow, int lane) {
    const u32x4 v = *(const u32x4*)(qrow + lane * 8);
    const int h = lane >> 3, d0 = (lane & 7) * 8;
    qs[(d0 + 0) * 8 + h] = bf2f(v.x & 0xffffu) * 0.125f; qs[(d0 + 1) * 8 + h] = bf2f(v.x >> 16) * 0.125f;
    qs[(d0 + 2) * 8 + h] = bf2f(v.y & 0xffffu) * 0.125f; qs[(d0 + 3) * 8 + h] = bf2f(v.y >> 16) * 0.125f;
    qs[(d0 + 4) * 8 + h] = bf2f(v.z & 0xffffu) * 0.125f; qs[(d0 + 5) * 8 + h] = bf2f(v.z >> 16) * 0.125f;
    qs[(d0 + 6) * 8 + h] = bf2f(v.w & 0xffffu) * 0.125f; qs[(d0 + 7) * 8 + h] = bf2f(v.w >> 16) * 0.125f;
    WAVE_LDS_FENCE();
}
__device__ __forceinline__ void tile_scores(float (&s)[8], const bf16* krow, bool valid, const LAS float* qs) {
#pragma unroll
    for (int h = 0; h < 8; ++h) s[h] = 0.f;
    if (valid) {
#pragma unroll 1
        for (int i = 0; i < 8; ++i) {
            const u32x4 kv = *(const u32x4*)(krow + i * 8);
            const unsigned w[4] = {kv.x, kv.y, kv.z, kv.w};
#pragma unroll
            for (int wi = 0; wi < 4; ++wi) {
#pragma unroll
                for (int e = 0; e < 2; ++e) {
                    const float kf = e ? __uint_as_float(w[wi] & 0xffff0000u) : __uint_as_float(w[wi] << 16);
                    const int d = i * 8 + wi * 2 + e;
                    const f32x4 qa = *(const LAS f32x4*)(qs + d * 8), qb = *(const LAS f32x4*)(qs + d * 8 + 4);
                    s[0] += kf * qa.x; s[1] += kf * qa.y; s[2] += kf * qa.z; s[3] += kf * qa.w;
                    s[4] += kf * qb.x; s[5] += kf * qb.y; s[6] += kf * qb.z; s[7] += kf * qb.w;
                }
            }
        }
    }
}
__device__ __forceinline__ void tile_pv(float (&o)[8], const float (&p)[8], const bf16* vlane, long pitch, int jlo, int jhi, LAS float* ps, int lane) {
    *(LAS f32x4*)(ps + lane * 8) = (f32x4){p[0], p[1], p[2], p[3]};
    *(LAS f32x4*)(ps + lane * 8 + 4) = (f32x4){p[4], p[5], p[6], p[7]};
    WAVE_LDS_FENCE();
    for (int j = jlo; j <= jhi; ++j) {
        const float v = bf2f(vlane[(long)j * pitch]);
        const f32x4 pa = *(const LAS f32x4*)(ps + j * 8), pb = *(const LAS f32x4*)(ps + j * 8 + 4);
        o[0] += pa.x * v; o[1] += pa.y * v; o[2] += pa.z * v; o[3] += pa.w * v;
        o[4] += pb.x * v; o[5] += pb.y * v; o[6] += pb.z * v; o[7] += pb.w * v;
    }
    WAVE_LDS_FENCE();
}
__device__ __forceinline__ void tile_update(AttnState& st, const float (&s)[8], const bf16* vlane, long pitch, int jlo, int jhi, LAS float* ps, int lane) {
    float p[8];
#pragma unroll
    for (int h = 0; h < 8; ++h) {
        const float tm = wave_max(s[h]);
        const float mn = fmaxf(st.m[h], tm);
        float corr = 1.f, ph = 0.f;
        if (mn != -INFINITY) { corr = expf(st.m[h] - mn); ph = expf(s[h] - mn); }
        st.l[h] = rfl(st.l[h] * corr + wave_sum(ph));
        st.o[h] *= corr; st.m[h] = rfl(mn); p[h] = ph;
    }
    tile_pv(st.o, p, vlane, pitch, jlo, jhi, ps, lane);
}

__device__ __forceinline__ void swa_job(const Ctx& c, int L, int job, LAS float* qs, LAS float* ps) {
    const int lane = c.lane;
    const int t = job & (SEQ - 1), bg = job >> 12, g = bg & 1, b = bg >> 1;
    const size_t row = (size_t)b * SEQ + t;
    load_q(qs, c.proj() + row * PP + C_QA + g * 512, lane);
    AttnState st; float slope[8];
#pragma unroll
    for (int h = 0; h < 8; ++h) { const int a = g * 8 + h; slope[h] = rfl(exp2f(-(float)(2 * a + 1) * 0.25f)); st.m[h] = rfl(c.sinks()[L * 16 + a]); st.l[h] = 1.f; st.o[h] = 0.f; }
    for (int i = 0; i < 2; ++i) {
        const int r0 = t - 64 * (i + 1) + 1;
        if (r0 + 63 < 0) break;
        const int pos = r0 + lane; const bool valid = pos >= 0; const int jlo = r0 < 0 ? -r0 : 0;
        const bf16* krow = c.proj() + ((size_t)b * SEQ + (valid ? pos : 0)) * PP + C_KA + g * 64;
        float s[8]; tile_scores(s, krow, valid, qs);
        const float dist = (float)(t - pos);
#pragma unroll
        for (int h = 0; h < 8; ++h) s[h] = valid ? s[h] - slope[h] * dist : -INFINITY;
        const bf16* vlane = c.proj() + (long)((long)b * SEQ + r0) * PP + C_VA + g * 64 + lane;
        tile_update(st, s, vlane, PP, jlo, 63, ps, lane);
    }
#pragma unroll
    for (int h = 0; h < 8; ++h) c.o()[row * DM + (g * 8 + h) * 64 + lane] = f2bf(st.o[h] / st.l[h]);
}

__device__ __forceinline__ void nsa_job(const Ctx& c, int L, int job, LAS float* qs, LAS float* ps, LAS float* pimp) {
    const int lane = c.lane;
    const int t = job & (SEQ - 1), bg = job >> 12, g = bg & 1, b = bg >> 1;
    const size_t row = (size_t)b * SEQ + t;
    const bf16* prow = c.proj() + row * PP;
    load_q(qs, prow + C_QN + g * 512, lane);
    float slope[8];
#pragma unroll
    for (int h = 0; h < 8; ++h) slope[h] = rfl(exp2f(-(float)(g * 8 + h + 1) * 0.5f));
    float ocmp[8];
#pragma unroll
    for (int h = 0; h < 8; ++h) ocmp[h] = 0.f;
    float impv = 0.f;
    int nv = 0;
    if (t >= 31) { nv = ((t - 31) >> 4) + 1; if (nv > NCMP) nv = NCMP; }
    if (nv > 0) {
        const bf16* kc = c.kvc() + ((size_t)(b * NCMP) * 2 + g) * 64;
        const bf16* vc = c.kvc() + (size_t)2048 * 64 + ((size_t)(b * NCMP) * 2 + g) * 64;
        const int ntile = (nv + 63) >> 6;
        float cm[8], cl[8];
#pragma unroll
        for (int h = 0; h < 8; ++h) { cm[h] = -INFINITY; cl[h] = 0.f; }
#pragma unroll 1
        for (int ti = 0; ti < ntile; ++ti) {
            const int n = ti * 64 + lane; const bool valid = n < nv;
            float s[8]; tile_scores(s, kc + (size_t)(valid ? n : 0) * 128, valid, qs);
            const float dist = (float)(t - 16 * n - 31);
#pragma unroll
            for (int h = 0; h < 8; ++h) {
                const float sv = valid ? s[h] - slope[h] * dist : -INFINITY;
                const float mn = fmaxf(cm[h], wave_max(sv));
                cl[h] = rfl(cl[h] * expf(cm[h] - mn) + wave_sum(expf(sv - mn))); cm[h] = rfl(mn);
            }
        }
#pragma unroll
        for (int h = 0; h < 8; ++h) cl[h] = rfl(1.f / cl[h]);
#pragma unroll 1
        for (int ti = 0; ti < ntile; ++ti) {
            const int n = ti * 64 + lane; const bool valid = n < nv;
            float s[8]; tile_scores(s, kc + (size_t)(valid ? n : 0) * 128, valid, qs);
            const float dist = (float)(t - 16 * n - 31);
            float p[8]; float sh = 0.f;
#pragma unroll
            for (int h = 0; h < 8; ++h) { p[h] = valid ? expf(s[h] - slope[h] * dist - cm[h]) * cl[h] : 0.f; sh += p[h]; }
            pimp[n] = sh;
            int jhi = nv - 1 - ti * 64; if (jhi > 63) jhi = 63;
            tile_pv(ocmp, p, vc + (size_t)(ti * 64) * 128 + lane, 128, 0, jhi, ps, lane);
        }
        for (int n = ntile * 64 + lane; n < 256; n += 64) pimp[n] = 0.f;
        WAVE_LDS_FENCE();
        {
            const int nlo = (4 * lane - 1) < 0 ? 0 : (4 * lane - 1), nhi = (4 * lane + 3) > (NCMP - 1) ? (NCMP - 1) : (4 * lane + 3);
            for (int n = nlo; n <= nhi; ++n) impv += pimp[n];
        }
        WAVE_LDS_FENCE();
    }
    const int cur = t >> 6;
    float score;
    {
        const int j = lane; const bool forced = (j == 0) || (j == cur) || (j == cur - 1); const bool valid = j <= cur;
        score = valid ? (forced ? INFINITY : impv) : -INFINITY;
    }
    int rank = 0;
    for (int i = 0; i < 64; ++i) { const float si = __shfl(score, i); rank += ((si > score) || (si == score && i < lane)) ? 1 : 0; }
    const bool sel = (rank < 16) && (score > -INFINITY);
    unsigned long long mask = __ballot(sel);
    AttnState S;
#pragma unroll
    for (int h = 0; h < 8; ++h) { S.m[h] = -INFINITY; S.l[h] = 0.f; S.o[h] = 0.f; }
    while (mask) {
        const int j = __builtin_ctzll(mask); mask &= mask - 1;
        const int pos = 64 * j + lane; const bool valid = pos <= t; const int jhi = (j == cur) ? (t & 63) : 63;
        const bf16* krow = c.proj() + ((size_t)b * SEQ + pos) * PP + C_KV + 2 * 128 + g * 64;
        float s[8]; tile_scores(s, krow, valid, qs);
        const float dist = (float)(t - pos);
#pragma unroll
        for (int h = 0; h < 8; ++h) s[h] = valid ? s[h] - slope[h] * dist : -INFINITY;
        const bf16* vlane = c.proj() + ((size_t)b * SEQ + 64 * j) * PP + C_KV + 3 * 128 + g * 64 + lane;
        tile_update(S, s, vlane, PP, 0, jhi, ps, lane);
    }
    float oslc[8];
#pragma unroll
    for (int h = 0; h < 8; ++h) oslc[h] = S.o[h] / S.l[h];
#if !USE_MFMA_WIN
    AttnState W;
#pragma unroll
    for (int h = 0; h < 8; ++h) { W.m[h] = -INFINITY; W.l[h] = 0.f; W.o[h] = 0.f; }
    for (int i = 0; i < 8; ++i) {
        const int r0 = t - 64 * (i + 1) + 1;
        if (r0 + 63 < 0) break;
        const int pos = r0 + lane; const bool valid = pos >= 0; const int jlo = r0 < 0 ? -r0 : 0;
        const bf16* krow = c.proj() + ((size_t)b * SEQ + (valid ? pos : 0)) * PP + C_KV + 4 * 128 + g * 64;
        float s[8]; tile_scores(s, krow, valid, qs);
        const float dist = (float)(t - pos);
#pragma unroll
        for (int h = 0; h < 8; ++h) s[h] = valid ? s[h] - slope[h] * dist : -INFINITY;
        const bf16* vlane = c.proj() + (long)((long)b * SEQ + r0) * PP + C_KV + 5 * 128 + g * 64 + lane;
        tile_update(W, s, vlane, PP, jlo, 63, ps, lane);
    }
#endif
#pragma unroll
    for (int h = 0; h < 8; ++h) {
        const bf16* gp = prow + C_GN + g * 24 + h * 3;
        const float g0 = sigmoidf(bf2f(gp[0])), g1 = sigmoidf(bf2f(gp[1]));
#if USE_MFMA_WIN
        const float wv = bf2f(c.o()[row * DM + 1024 + (g * 8 + h) * 64 + lane]);
#else
        const float wv = sigmoidf(bf2f(gp[2])) * (W.o[h] / W.l[h]);
#endif
        const float on = g0 * ocmp[h] + g1 * oslc[h] + wv;
        c.o()[row * DM + 1024 + (g * 8 + h) * 64 + lane] = f2bf(on);
    }
}

constexpr int ATILE_BYTES = 64 * 64 * 2;
constexpr float C1 = 0.125f * 1.4426950408889634f;

struct AttnRegs { f32x4 O[4][4]; float m[4], l[4]; bf16x8 Q[4][2]; };
struct ColCtx { int tt0; int t0; };
struct TileD { const bf16* k; const bf16* v; int pitch; float offrel; int mtype; int j; };
struct TileGen {
    int kind;
    int j, jend; unsigned long long rem; int c, jold;
    const bf16* kb; const bf16* vb;
    __device__ __forceinline__ bool next(TileD& d) {
        int jj;
        if (kind == 1) { if (!rem) return false; jj = __builtin_ctzll(rem); rem &= rem - 1; }
        else { if (j > jend) return false; jj = j++; }
        d.j = jj;
        if (kind == 2) { d.k = kb + (size_t)jj * 64 * 128; d.v = vb + (size_t)jj * 64 * 128; d.pitch = 128; d.offrel = (float)(1024 * jj + 31 - 64 * c); d.mtype = 3; }
        else { d.k = kb + (size_t)jj * 64 * PP; d.v = vb + (size_t)jj * 64 * PP; d.pitch = PP; d.offrel = (float)(64 * (jj - c)); d.mtype = (jj == c) ? 1 : (jj == jold ? 2 : 0); }
        return true;
    }
};

__device__ __forceinline__ void attn_load_q(AttnRegs& R, const bf16* qbase, int w, int fr, int fq) {
#pragma unroll
    for (int nt = 0; nt < 4; ++nt) {
        const int tt = 8 * w + 2 * nt + (fr >> 3);
        const bf16* p = qbase + (size_t)tt * PP + (fr & 7) * 64 + fq * 8;
        R.Q[nt][0] = *(const bf16x8*)p; R.Q[nt][1] = *(const bf16x8*)(p + 32);
    }
}
__device__ __forceinline__ void attn_reset(AttnRegs& R) {
#pragma unroll
    for (int nt = 0; nt < 4; ++nt) { R.m[nt] = -INFINITY; R.l[nt] = 0.f;
#pragma unroll
        for (int md = 0; md < 4; ++md) R.O[md][nt] = (f32x4){0.f, 0.f, 0.f, 0.f}; }
}
__device__ __forceinline__ void stage_issue(const TileD& d, LAS unsigned char* kdst, LAS unsigned char* vdst, int w, int lane) {
    const int r = 8 * w + (lane >> 3), ch = (lane & 7) ^ ((lane >> 3) & 7);
    __builtin_amdgcn_global_load_lds((const unsigned*)(d.k + (size_t)r * d.pitch + ch * 8), (LAS unsigned*)(kdst + w * 1024), 16, 0, 0);
    __builtin_amdgcn_global_load_lds((const unsigned*)(d.v + (size_t)r * d.pitch + ch * 8), (LAS unsigned*)(vdst + w * 1024), 16, 0, 0);
}

template <int MODE>
__device__ __forceinline__ void attn_half(AttnRegs& R, const LAS unsigned char* Kt, const LAS unsigned char* Vt, const int hk, const float A, const float kstep, const float off,
                                          const int mtype, const int hicmp, const unsigned enbits, const ColCtx& cc, const int fr, const int fq,
                                          LAS float* impA, LAS float* impB, const int jq0) {
    bf16x8 Kf[2][2];
#pragma unroll
    for (int m = 0; m < 2; ++m)
#pragma unroll
        for (int ks = 0; ks < 2; ++ks) Kf[m][ks] = *(const LAS bf16x8*)(Kt + (hk * 32 + m * 16 + fr) * 128 + (((ks * 4 + fq) ^ (fr & 7)) * 16));
    f32x4 S[2][4];
    const float ak = A * kstep;
#pragma unroll
    for (int m = 0; m < 2; ++m) {
        const float b0 = ak * (float)(hk * 32 + m * 16 + 4 * fq);
        const f32x4 cb = {b0, b0 + ak, b0 + 2.f * ak, b0 + 3.f * ak};
#pragma unroll
        for (int nt = 0; nt < 4; ++nt) {
            S[m][nt] = __builtin_amdgcn_mfma_f32_16x16x32_bf16(Kf[m][0], R.Q[nt][0], cb, 0, 0, 0);
            S[m][nt] = __builtin_amdgcn_mfma_f32_16x16x32_bf16(Kf[m][1], R.Q[nt][1], S[m][nt], 0, 0, 0);
        }
    }
    __builtin_amdgcn_sched_barrier(0);
    bool en[4];
#pragma unroll
    for (int nt = 0; nt < 4; ++nt) en[nt] = ((enbits >> nt) & 1u) != 0u;
    if (mtype != 0) {
#pragma unroll
        for (int nt = 0; nt < 4; ++nt) {
            const int tt = cc.tt0 + 2 * nt;
            int lo = 0, hi = 63;
            if (mtype == 1) hi = tt; else if (mtype == 2) lo = tt + 1; else { const int t = cc.t0 + tt; hi = (t >= 31 ? ((t - 31) >> 4) : -1) - hicmp; }
#pragma unroll
            for (int m = 0; m < 2; ++m)
#pragma unroll
                for (int r = 0; r < 4; ++r) { const int kk = hk * 32 + m * 16 + 4 * fq + r; if (kk < lo || kk > hi) S[m][nt][r] = -INFINITY; }
        }
    }
    bf16x8 Pf[4];
#pragma unroll
    for (int nt = 0; nt < 4; ++nt) {
        float add;
        if (MODE == 2) {
            add = (en[nt] && R.m[nt] > -INFINITY) ? C1 * (off - R.m[nt]) : -INFINITY;
        } else {
            float cm = fmaxf(fmaxf(fmaxf(S[0][nt][0], S[0][nt][1]), fmaxf(S[0][nt][2], S[0][nt][3])), fmaxf(fmaxf(S[1][nt][0], S[1][nt][1]), fmaxf(S[1][nt][2], S[1][nt][3])));
            if (!en[nt]) cm = -INFINITY;
            cm = fmaxf(cm, __shfl_xor(cm, 16)); cm = fmaxf(cm, __shfl_xor(cm, 32));
            const float mn = fmaxf(R.m[nt], cm + off);
            const float corr = (mn == -INFINITY) ? 1.f : __builtin_amdgcn_exp2f(C1 * (R.m[nt] - mn));
            add = (en[nt] && mn > -INFINITY) ? C1 * (off - mn) : -INFINITY;
            R.m[nt] = mn; R.l[nt] *= corr;
            if (MODE == 0) {
#pragma unroll
                for (int md = 0; md < 4; ++md) R.O[md][nt] = R.O[md][nt] * corr;
            }
        }
        float p[2][4];
#pragma unroll
        for (int m = 0; m < 2; ++m)
#pragma unroll
            for (int r = 0; r < 4; ++r) p[m][r] = __builtin_amdgcn_exp2f(fmaf(S[m][nt][r], C1, add));
        if (MODE == 2) {
#pragma unroll
            for (int m = 0; m < 2; ++m) {
                float q4 = (p[m][0] + p[m][1]) + (p[m][2] + p[m][3]), p3 = p[m][3];
                q4 += __shfl_xor(q4, 1); p3 += __shfl_xor(p3, 1);
                q4 += __shfl_xor(q4, 2); p3 += __shfl_xor(p3, 2);
                q4 += __shfl_xor(q4, 4); p3 += __shfl_xor(p3, 4);
                if ((fr & 7) == 0) { const int jq = jq0 + hk * 8 + m * 4 + fq; impA[(cc.tt0 + 2 * nt) * 64 + jq] = q4; impB[(cc.tt0 + 2 * nt) * 65 + jq + 1] = p3; }
            }
        } else {
            R.l[nt] += ((p[0][0] + p[0][1]) + (p[0][2] + p[0][3])) + ((p[1][0] + p[1][1]) + (p[1][2] + p[1][3]));
        }
        if (MODE != 1) {
            u32x4 pk; pk.x = cvt_pk_bf16(p[0][0], p[0][1]); pk.y = cvt_pk_bf16(p[0][2], p[0][3]); pk.z = cvt_pk_bf16(p[1][0], p[1][1]); pk.w = cvt_pk_bf16(p[1][2], p[1][3]);
            Pf[nt] = __builtin_bit_cast(bf16x8, pk);
        }
        if (nt & 1) __builtin_amdgcn_sched_barrier(0);
    }
    __builtin_amdgcn_sched_barrier(0);
    if (MODE != 1) {
#pragma unroll
        for (int md = 0; md < 4; ++md) {
            typedef short s16x4 __attribute__((ext_vector_type(4)));
            const int key0 = hk * 32 + 4 * fq + (fr >> 2);
            const LAS unsigned char* vp = Vt + key0 * 128 + (((md * 2 + ((fr & 3) >> 1)) ^ (key0 & 7)) * 16) + (fr & 1) * 8;
            const s16x4 v0 = __builtin_amdgcn_ds_read_tr16_b64_v4i16((LAS s16x4*)vp), v1 = __builtin_amdgcn_ds_read_tr16_b64_v4i16((LAS s16x4*)(vp + 16 * 128));
            const bf16x8 Vf = {v0.x, v0.y, v0.z, v0.w, v1.x, v1.y, v1.z, v1.w};
#pragma unroll
            for (int nt = 0; nt < 4; ++nt) R.O[md][nt] = __builtin_amdgcn_mfma_f32_16x16x32_bf16(Vf, Pf[nt], R.O[md][nt], 0, 0, 0);
        }
    }
}

template <int MODE, bool USE_SEL>
__device__ __forceinline__ void attn_sweep(AttnRegs& R, LAS unsigned char* lds, TileGen tg, const ColCtx& cc, const float A, const float kstep,
                                           const int w, const int lane, const int fr, const int fq) {
    LAS unsigned char* Kb = lds + L_KV; LAS unsigned char* Vb = lds + L_KV + 2 * ATILE_BYTES;
    LAS float* impA = (LAS float*)(lds + L_IMPA); LAS float* impB = (LAS float*)(lds + L_IMPB);
    const LAS unsigned* selw = (const LAS unsigned*)(lds + L_SEL);
    TileD cur, nxt;
    if (!tg.next(cur)) return;
    stage_issue(cur, Kb, Vb, w, lane);
    asm volatile("s_waitcnt vmcnt(0)" ::: "memory");
    __syncthreads();
    int buf = 0;
    for (;;) {
        const bool hn = tg.next(nxt);
        if (hn) stage_issue(nxt, Kb + (buf ^ 1) * ATILE_BYTES, Vb + (buf ^ 1) * ATILE_BYTES, w, lane);
        unsigned enbits = 15u;
        if (USE_SEL) {
            enbits = 0u;
#pragma unroll
            for (int nt = 0; nt < 4; ++nt) { const int tt = cc.tt0 + 2 * nt; const unsigned sw = selw[2 * tt + (cur.j >> 5)]; enbits |= ((sw >> (cur.j & 31)) & 1u) << nt; }
        }
        if (__any(enbits != 0u)) {
            const LAS unsigned char* Kt = Kb + buf * ATILE_BYTES; const LAS unsigned char* Vt = Vb + buf * ATILE_BYTES;
            const float off = A * cur.offrel;
#pragma unroll 1
            for (int hk = 0; hk < 2; ++hk) attn_half<MODE>(R, Kt, Vt, hk, A, kstep, off, cur.mtype, 64 * cur.j, enbits, cc, fr, fq, impA, impB, cur.j * 16);
        }
        asm volatile("s_waitcnt vmcnt(0)" ::: "memory");
        __syncthreads();
        if (!hn) break;
        cur = nxt; buf ^= 1;
    }
}
__device__ __forceinline__ void attn_ltot(const AttnRegs& R, float (&lt)[4]) {
#pragma unroll
    for (int nt = 0; nt < 4; ++nt) { float l = R.l[nt]; l += __shfl_xor(l, 16); l += __shfl_xor(l, 32); lt[nt] = l; }
}
__device__ __forceinline__ void attn_store(const AttnRegs& R, const float (&sc)[4], bf16* obase, const ColCtx& cc, int fr, int fq, bool accumulate) {
    typedef unsigned u32x2 __attribute__((ext_vector_type(2)));
#pragma unroll
    for (int nt = 0; nt < 4; ++nt)
#pragma unroll
        for (int md = 0; md < 4; ++md) {
            f32x4 v = R.O[md][nt] * sc[nt];
            u32x2* p = (u32x2*)(obase + (size_t)(cc.tt0 + 2 * nt) * DM + (fr & 7) * 64 + md * 16 + 4 * fq);
            if (accumulate) { const unsigned long long ow = __hip_atomic_load((unsigned long long*)p, __ATOMIC_RELAXED, __HIP_MEMORY_SCOPE_AGENT); u32x2 old; old.x = (unsigned)ow; old.y = (unsigned)(ow >> 32); v.x += bf2f(old.x & 0xffffu); v.y += bf2f(old.x >> 16); v.z += bf2f(old.y & 0xffffu); v.w += bf2f(old.y >> 16); }
            u32x2 nw; nw.x = cvt_pk_bf16(v.x, v.y); nw.y = cvt_pk_bf16(v.z, v.w);
            *p = nw;
        }
}
__device__ __forceinline__ void attn_colctx(ColCtx& cc, int w, int fr, int t0) { cc.tt0 = 8 * w + (fr >> 3); cc.t0 = t0; }

__device__ __forceinline__ void win_unit(const Ctx& c, int L, int u) {
    const int tid = c.tid, lane = c.lane, w = c.wid, fr = lane & 15, fq = lane >> 4;
    const int cch = u & 63, g = (u >> 6) & 1, b = u >> 7, t0 = cch * 64;
    const bf16* pb = c.proj() + (size_t)b * SEQ * PP;
    AttnRegs R; attn_reset(R);
    attn_load_q(R, pb + (size_t)t0 * PP + C_QN + g * 512, w, fr, fq);
    ColCtx cc; attn_colctx(cc, w, fr, t0);
    const float A = 8.f * exp2f(-(float)(g * 8 + (fr & 7) + 1) * 0.5f);
    TileGen tg; tg.kind = 0; tg.c = cch; tg.j = cch - 8 < 0 ? 0 : cch - 8; tg.jend = cch; tg.jold = cch - 8; tg.rem = 0ull;
    tg.kb = pb + C_KV + 4 * 128 + g * 64; tg.vb = pb + C_KV + 5 * 128 + g * 64;
    attn_sweep<0, false>(R, c.lds, tg, cc, A, 1.f, w, lane, fr, fq);
    float lt[4], sc[4]; attn_ltot(R, lt);
#pragma unroll
    for (int nt = 0; nt < 4; ++nt) { const float gv = bf2f(pb[(size_t)(t0 + cc.tt0 + 2 * nt) * PP + C_GN + g * 24 + (fr & 7) * 3 + 2]); sc[nt] = sigmoidf(gv) / lt[nt]; }
    attn_store(R, sc, c.o() + ((size_t)b * SEQ + t0) * DM + 1024 + g * 512, cc, fr, fq, false);
}
__device__ __forceinline__ void swa_unit(const Ctx& c, int L, int u) {
    const int tid = c.tid, lane = c.lane, w = c.wid, fr = lane & 15, fq = lane >> 4;
    const int cch = u & 63, g = (u >> 6) & 1, b = u >> 7, t0 = cch * 64;
    const bf16* pb = c.proj() + (size_t)b * SEQ * PP;
    AttnRegs R; attn_reset(R);
    attn_load_q(R, pb + (size_t)t0 * PP + C_QA + g * 512, w, fr, fq);
    ColCtx cc; attn_colctx(cc, w, fr, t0);
    const int a = g * 8 + (fr & 7);
    const float A = 8.f * exp2f(-(float)(2 * a + 1) * 0.25f);
    const float sink8 = 8.f * c.sinks()[L * 16 + a];
#pragma unroll
    for (int nt = 0; nt < 4; ++nt) { R.m[nt] = sink8 + A * (float)(cc.tt0 + 2 * nt); R.l[nt] = fq == 0 ? 1.f : 0.f; }
    TileGen tg; tg.kind = 0; tg.c = cch; tg.j = cch - 2 < 0 ? 0 : cch - 2; tg.jend = cch; tg.jold = cch - 2; tg.rem = 0ull;
    tg.kb = pb + C_KA + g * 64; tg.vb = pb + C_VA + g * 64;
    attn_sweep<0, false>(R, c.lds, tg, cc, A, 1.f, w, lane, fr, fq);
    float lt[4], sc[4]; attn_ltot(R, lt);
#pragma unroll
    for (int nt = 0; nt < 4; ++nt) sc[nt] = 1.f / lt[nt];
    attn_store(R, sc, c.o() + ((size_t)b * SEQ + t0) * DM + g * 512, cc, fr, fq, false);
}
__device__ __forceinline__ void cmpslc_unit(const Ctx& c, int L, int u) {
    const int tid = c.tid, lane = c.lane, w = c.wid, fr = lane & 15, fq = lane >> 4;
    const int cch = u & 63, g = (u >> 6) & 1, b = u >> 7, t0 = cch * 64;
    const bf16* pb = c.proj() + (size_t)b * SEQ * PP;
    LAS float* impA = (LAS float*)(c.lds + L_IMPA); LAS float* impB = (LAS float*)(c.lds + L_IMPB);
    LAS unsigned* selw = (LAS unsigned*)(c.lds + L_SEL);
    AttnRegs R; attn_reset(R);
    attn_load_q(R, pb + (size_t)t0 * PP + C_QN + g * 512, w, fr, fq);
    ColCtx cc; attn_colctx(cc, w, fr, t0);
    const float A = 8.f * exp2f(-(float)(g * 8 + (fr & 7) + 1) * 0.5f);
    bf16* obase = c.o() + ((size_t)b * SEQ + t0) * DM + 1024 + g * 512;
    const bf16* gbase = pb + (size_t)t0 * PP + C_GN + g * 24 + (fr & 7) * 3;
    for (int i = lane; i < 8 * 64; i += 64) impA[(8 * w) * 64 + i] = 0.f;
    for (int i = lane; i < 8 * 65; i += 64) impB[(8 * w) * 65 + i] = 0.f;
    WAVE_LDS_FENCE();
    int ncl = 4 * cch + 2; if (ncl > NCMP - 1) ncl = NCMP - 1;
    TileGen tg; tg.kind = 2; tg.c = cch; tg.j = 0; tg.jend = ncl >> 6; tg.jold = -1; tg.rem = 0ull;
    tg.kb = c.kvc() + ((size_t)(b * NCMP) * 2 + g) * 64; tg.vb = c.kvc() + (size_t)2048 * 64 + ((size_t)(b * NCMP) * 2 + g) * 64;
    attn_sweep<1, false>(R, c.lds, tg, cc, A, 16.f, w, lane, fr, fq);
    { float lt[4]; attn_ltot(R, lt);
#pragma unroll
      for (int nt = 0; nt < 4; ++nt) R.m[nt] = lt[nt] > 0.f ? R.m[nt] + __builtin_amdgcn_logf(lt[nt]) * (1.f / C1) : -INFINITY; }
    attn_sweep<2, false>(R, c.lds, tg, cc, A, 16.f, w, lane, fr, fq);
    { float sc[4];
#pragma unroll
      for (int nt = 0; nt < 4; ++nt) sc[nt] = sigmoidf(bf2f(gbase[(size_t)(cc.tt0 + 2 * nt) * PP + 0]));
      attn_store(R, sc, obase, cc, fr, fq, true); }
    WAVE_LDS_FENCE();
    for (int i = 0; i < 8; ++i) {
        const int ti = 8 * w + i, j = lane;
        const float imp = impA[ti * 64 + j] + impB[ti * 65 + j];
        const bool forced = (j == 0) || (j == cch) || (j == cch - 1); const bool valid = j <= cch;
        const float score = valid ? (forced ? INFINITY : imp) : -INFINITY;
        int rank = 0;
        for (int k = 0; k < 64; ++k) { const float sk = __shfl(score, k); rank += ((sk > score) || (sk == score && k < lane)) ? 1 : 0; }
        const unsigned long long msk = __ballot((rank < 16) && (score > -INFINITY));
        if (lane == 0) { selw[2 * ti] = (unsigned)msk; selw[2 * ti + 1] = (unsigned)(msk >> 32); }
    }
    asm volatile("s_waitcnt vmcnt(0) lgkmcnt(0)" ::: "memory");
    __syncthreads();
    unsigned ulo = selw[2 * lane], uhi = selw[2 * lane + 1];
#pragma unroll
    for (int o = 1; o < 64; o <<= 1) { ulo |= __shfl_xor(ulo, o); uhi |= __shfl_xor(uhi, o); }
    const unsigned long long uni = ((unsigned long long)__builtin_amdgcn_readfirstlane(uhi) << 32) | (unsigned long long)__builtin_amdgcn_readfirstlane(ulo);
    attn_reset(R);
    tg.kind = 1; tg.rem = uni; tg.j = 0; tg.jend = -1; tg.jold = -1;
    tg.kb = pb + C_KV + 2 * 128 + g * 64; tg.vb = pb + C_KV + 3 * 128 + g * 64;
    attn_sweep<0, true>(R, c.lds, tg, cc, A, 1.f, w, lane, fr, fq);
    { float lt[4], sc[4]; attn_ltot(R, lt);
#pragma unroll
      for (int nt = 0; nt < 4; ++nt) sc[nt] = sigmoidf(bf2f(gbase[(size_t)(cc.tt0 + 2 * nt) * PP + 1])) / lt[nt];
      asm volatile("s_waitcnt vmcnt(0)" ::: "memory");
      attn_store(R, sc, obase, cc, fr, fq, true); }
    __syncthreads();
}

#define EPI_LOOP for (int m = 0; m < 4; ++m) for (int n = 0; n < 2; ++n) for (int j = 0; j < 4; ++j)
struct EpiProj { bf16* proj; const float* bias; int row0, col0;
    __device__ __forceinline__ void operator()(const f32x4 (&acc)[4][2], int wr, int wc, int fr, int fq) const {
#pragma unroll
        for (int m = 0; m < 4; ++m)
#pragma unroll
            for (int n = 0; n < 2; ++n)
#pragma unroll
                for (int j = 0; j < 4; ++j) { const int r = row0 + wr * 64 + m * 16 + fq * 4 + j, cc = col0 + wc * 32 + n * 16 + fr;
                    const float v = cc < INC ? acc[m][n][j] + bias[cc] : 0.f; proj[(size_t)r * PP + cc] = f2bf(v); } } };
struct EpiCmp1 { float* hb; int row0, col0;
    __device__ __forceinline__ void operator()(const f32x4 (&acc)[4][2], int wr, int wc, int fr, int fq) const {
#pragma unroll
        for (int m = 0; m < 4; ++m)
#pragma unroll
            for (int n = 0; n < 2; ++n)
#pragma unroll
                for (int j = 0; j < 4; ++j) { const int r = row0 + wr * 64 + m * 16 + fq * 4 + j, cc = col0 + wc * 32 + n * 16 + fr;
                    hb[(size_t)r * 256 + cc] = gelu_tanh(acc[m][n][j]); } } };
struct EpiCmp2 { bf16* kvc; int row0;
    __device__ __forceinline__ void operator()(const f32x4 (&acc)[4][2], int wr, int wc, int fr, int fq) const {
#pragma unroll
        for (int m = 0; m < 4; ++m)
#pragma unroll
            for (int n = 0; n < 2; ++n)
#pragma unroll
                for (int j = 0; j < 4; ++j) { const int r = row0 + wr * 64 + m * 16 + fq * 4 + j, cc = wc * 32 + n * 16 + fr;
                    if (cc < 64) kvc[(size_t)r * 64 + cc] = f2bf(acc[m][n][j]); } } };
struct EpiOut { float* y; const float* bias; const float* xres; int row0, col0;
    __device__ __forceinline__ void operator()(const f32x4 (&acc)[4][2], int wr, int wc, int fr, int fq) const {
#pragma unroll
        for (int m = 0; m < 4; ++m)
#pragma unroll
            for (int n = 0; n < 2; ++n)
#pragma unroll
                for (int j = 0; j < 4; ++j) { const int r = row0 + wr * 64 + m * 16 + fq * 4 + j, cc = col0 + wc * 32 + n * 16 + fr;
                    y[(size_t)r * DM + cc] = acc[m][n][j] + bias[cc] + ALPHA * xres[(size_t)r * DM + cc]; } } };
struct EpiLogit { float* lg; const float* bg; const float* be; int row0;
    __device__ __forceinline__ void operator()(const f32x4 (&acc)[4][2], int wr, int wc, int fr, int fq) const {
#pragma unroll
        for (int m = 0; m < 4; ++m)
#pragma unroll
            for (int n = 0; n < 2; ++n)
#pragma unroll
                for (int j = 0; j < 4; ++j) { const int r = row0 + wr * 64 + m * 16 + fq * 4 + j, cc = wc * 32 + n * 16 + fr;
                    if (cc < 72) lg[(size_t)r * NLOG + cc] = acc[m][n][j] + (cc < 8 ? bg[cc] : be[cc - 8]); } } };
struct EpiMoe1 { bf16* H; int rowbase, cnt, rt, ct;
    __device__ __forceinline__ void operator()(const f32x4 (&acc)[4][2], int wr, int wc, int fr, int fq) const {
#pragma unroll
        for (int m = 0; m < 4; ++m)
#pragma unroll
            for (int j = 0; j < 4; ++j) { const int pos = rt * 128 + wr * 64 + m * 16 + fq * 4 + j;
                if (pos < cnt) { const float gv = acc[m][0][j], uv = acc[m][1][j]; const float hv = gv / (1.f + expf(-gv)) * uv;
                    H[(size_t)(rowbase + pos) * EH + ct * 64 + wc * 16 + fr] = f2bf(hv); } } } };
struct EpiMoe2 { float* contrib; const int* lslot; const float* lw; int cnt, rt, col0;
    __device__ __forceinline__ void operator()(const f32x4 (&acc)[4][2], int wr, int wc, int fr, int fq) const {
#pragma unroll
        for (int m = 0; m < 4; ++m)
#pragma unroll
            for (int j = 0; j < 4; ++j) { const int pos = rt * 128 + wr * 64 + m * 16 + fq * 4 + j;
                if (pos < cnt) { const int slot = lslot[pos]; const float w = lw[pos];
#pragma unroll
                    for (int n = 0; n < 2; ++n) contrib[(size_t)slot * DM + col0 + wc * 32 + n * 16 + fr] = acc[m][n][j] * w; } } } };

__device__ __forceinline__ void ph_inproj(const Ctx& c, int L, const float* xin) {
    const float* W = c.w_in() + (size_t)L * DM * INC; const float* bias = c.b_in() + L * INC;
    const int ar = c.tid >> 2, bn = c.tid & 127;
    for (int u = blockIdx.x; u < 128 * 25; u += gridDim.x) {
        const int rt = u / 25, ct = u % 25;
        ALf32 al{xin + (size_t)(rt * 128 + ar) * DM};
        const int col = ct * 128 + bn;
        BLf32 bl{col < INC ? W + col : nullptr, (size_t)INC};
        EpiProj ep{c.proj(), bias, rt * 128, ct * 128};
        gemm_tile(c.lds, al, bl, ep, DM);
    }
}
__device__ __forceinline__ void ph_cmp1_swa(const Ctx& c, int L) {
    const int ar = c.tid >> 2, bn = c.tid & 127;
    for (int u = blockIdx.x; u < 64; u += gridDim.x) {
        const int which = u >> 5, rt = (u >> 1) & 15, ct = u & 1;
        const int r = rt * 128 + ar;
        const bf16* base = nullptr;
        if (r < CMPROWS) { const int g = r & 1, bn_ = r >> 1, n = bn_ % NCMP, b = bn_ / NCMP;
            base = c.proj() + ((size_t)b * SEQ + 16 * n) * PP + C_KV + which * 128 + g * 64; }
        ALcmp al{base, (which ? c.pe_v() : c.pe_k()) + (size_t)L * 2048};
        BLf32 bl{(which ? c.w1_v() : c.w1_k()) + (size_t)L * 2048 * 256 + ct * 128 + bn, (size_t)256};
        EpiCmp1 ep{c.hb() + (size_t)which * 2048 * 256, rt * 128, ct * 128};
        gemm_tile(c.lds, al, bl, ep, 2048);
    }
    __syncthreads();
#if USE_MFMA_WIN
    for (int u = blockIdx.x; u < NB * 2 * 64; u += gridDim.x) win_unit(c, L, u);
#endif
#if USE_MFMA_SWA
    for (int u = blockIdx.x; u < NB * 2 * 64; u += gridDim.x) swa_unit(c, L, u);
#else
    LAS float* qs = (LAS float*)(c.lds + L_ATT + c.wid * 5120); LAS float* ps = qs + 512;
    for (int job = blockIdx.x * 8 + c.wid; job < NB * 2 * SEQ; job += gridDim.x * 8) swa_job(c, L, job, qs, ps);
#endif
}
__device__ __forceinline__ void ph_cmp2(const Ctx& c, int L) {
    const int ar = c.tid >> 2, bn = c.tid & 127;
    for (int u = blockIdx.x; u < 32; u += gridDim.x) {
        const int which = u >> 4, rt = u & 15;
        ALf32 al{c.hb() + (size_t)which * 2048 * 256 + (size_t)(rt * 128 + ar) * 256};
        BLf32 bl{bn < 64 ? (which ? c.w2_v() : c.w2_k()) + (size_t)L * 256 * 64 + bn : nullptr, (size_t)64};
        EpiCmp2 ep{c.kvc() + (size_t)which * 2048 * 64, rt * 128};
        gemm_tile(c.lds, al, bl, ep, 256);
    }
}
__device__ __forceinline__ void ph_nsa(const Ctx& c, int L) {
#if USE_MFMA_SLC
    for (int i = blockIdx.x; i < NB * 2 * 64; i += gridDim.x) {
        const int r = i >> 8, q = i & 255, bg = q >> 5, ci = q & 31;
        cmpslc_unit(c, L, bg * 64 + (r ? 63 - ci : ci));
    }
#else
    LAS float* qs = (LAS float*)(c.lds + L_ATT + c.wid * 5120); LAS float* ps = qs + 512; LAS float* pimp = qs + 1024;
    for (int job = blockIdx.x * 8 + c.wid; job < NB * 2 * SEQ; job += gridDim.x * 8) nsa_job(c, L, job, qs, ps, pimp);
#endif
}
__device__ __forceinline__ void ph_outproj(const Ctx& c, int L, const float* xin) {
    const float* W = c.w_out() + (size_t)L * DM * DM; const float* bias = c.b_out() + L * DM;
    const int ar = c.tid >> 2, bn = c.tid & 127;
    for (int u = blockIdx.x; u < 128 * 16; u += gridDim.x) {
        const int rt = u / 16, ct = u % 16;
        ALbf16 al{c.o() + (size_t)(rt * 128 + ar) * DM};
        BLf32 bl{W + ct * 128 + bn, (size_t)DM};
        EpiOut ep{c.y(), bias, xin, rt * 128, ct * 128};
        gemm_tile(c.lds, al, bl, ep, DM);
    }
}
__device__ __forceinline__ void ph_ln(const Ctx& c, const float* src, float sscale, const float* add, float* dst, const float* gam, const float* bet) {
    const int lane = c.lane;
    for (int r = blockIdx.x * 8 + c.wid; r < MTOK; r += gridDim.x * 8) {
        const f32x4* sp = (const f32x4*)(src + (size_t)r * DM) + lane;
        f32x4 v[8]; float s = 0.f;
#pragma unroll
        for (int j = 0; j < 8; ++j) { v[j] = sp[64 * j] * sscale; }
        if (add) {
            const f32x4* a0 = (const f32x4*)(add + (size_t)(2 * r) * DM) + lane; const f32x4* a1 = (const f32x4*)(add + (size_t)(2 * r + 1) * DM) + lane;
#pragma unroll
            for (int j = 0; j < 8; ++j) v[j] = v[j] + (a0[64 * j] + a1[64 * j]);
        }
#pragma unroll
        for (int j = 0; j < 8; ++j) s += (v[j].x + v[j].y) + (v[j].z + v[j].w);
        const float mean = wave_sum(s) * (1.f / DM); float s2 = 0.f;
#pragma unroll
        for (int j = 0; j < 8; ++j) { v[j] = v[j] - mean; s2 += (v[j].x * v[j].x + v[j].y * v[j].y) + (v[j].z * v[j].z + v[j].w * v[j].w); }
        const float rstd = 1.f / sqrtf(wave_sum(s2) * (1.f / DM) + LN_EPS);
        f32x4* dp = (f32x4*)(dst + (size_t)r * DM) + lane; const f32x4* gp = (const f32x4*)gam + lane; const f32x4* bp = (const f32x4*)bet + lane;
#pragma unroll
        for (int j = 0; j < 8; ++j) dp[64 * j] = v[j] * rstd * gp[64 * j] + bp[64 * j];
    }
}
__device__ __forceinline__ void ph_router(const Ctx& c, int L) {
    const int ar = c.tid >> 2, bn = c.tid & 127;
    const float* colp = nullptr; size_t ldb = 8;
    if (bn < 8) { colp = c.w_group() + (size_t)L * DM * 8 + bn; ldb = 8; } else if (bn < 72) { colp = c.w_expert() + (size_t)L * DM * 64 + (bn - 8); ldb = 64; }
    for (int u = blockIdx.x; u < 128; u += gridDim.x) {
        ALf32 al{c.x1() + (size_t)(u * 128 + ar) * DM};
        BLf32 bl{colp, ldb};
        EpiLogit ep{c.logits(), c.b_group() + L * 8, c.b_expert() + L * 64, u * 128};
        gemm_tile(c.lds, al, bl, ep, DM);
    }
}
__device__ __forceinline__ void ph_route(const Ctx& c, int L) {
    unsigned* cnt = c.cnt() + L * 64;
    for (int tok = blockIdx.x * 512 + c.tid; tok < MTOK; tok += gridDim.x * 512) {
        const float* lg = c.logits() + (size_t)tok * NLOG;
        float gl[8];
#pragma unroll
        for (int i = 0; i < 8; ++i) gl[i] = lg[i];
        int gs = 0; float gm = gl[0];
#pragma unroll
        for (int i = 1; i < 8; ++i) if (gl[i] > gm) { gm = gl[i]; gs = i; }
        float gsum = 0.f;
#pragma unroll
        for (int i = 0; i < 8; ++i) gsum += expf(gl[i] - gm);
        const float gw = 1.f / gsum;
        float el[8];
#pragma unroll
        for (int i = 0; i < 8; ++i) el[i] = lg[8 + gs * 8 + i];
        int i0 = 0; float v0 = el[0];
#pragma unroll
        for (int i = 1; i < 8; ++i) if (el[i] > v0) { v0 = el[i]; i0 = i; }
        int i1 = -1; float v1 = -INFINITY;
#pragma unroll
        for (int i = 0; i < 8; ++i) if (i != i0 && el[i] > v1) { v1 = el[i]; i1 = i; }
        const float e1 = expf(v1 - v0);
        const float w0 = gw / (1.f + e1), w1 = gw * e1 / (1.f + e1);
        const int ea = gs * 8 + i0, eb = gs * 8 + i1;
        const unsigned pa = atomicAdd(&cnt[ea], 1u); c.lslot()[(size_t)ea * LCAP + pa] = tok * 2; c.lw()[(size_t)ea * LCAP + pa] = w0;
        const unsigned pb = atomicAdd(&cnt[eb], 1u); c.lslot()[(size_t)eb * LCAP + pb] = tok * 2 + 1; c.lw()[(size_t)eb * LCAP + pb] = w1;
    }
}
__device__ __forceinline__ void moe_tables(const Ctx& c, int L) {
    LAS int* tab = (LAS int*)(c.lds + L_TAB);
    __syncthreads();
    if (c.tid < 64) tab[c.tid] = (int)c.cnt()[L * 64 + c.tid];
    __syncthreads();
    if (c.tid == 0) { int rb = 0, tb = 0; for (int e = 0; e < 64; ++e) { tab[64 + e] = rb; tab[128 + e] = tb; rb += tab[e]; tb += (tab[e] + 127) >> 7; } tab[192] = tb; }
    __syncthreads();
}
__device__ __forceinline__ int moe_find(const LAS int* tab, int rtg) { int e = 0; for (int i = 1; i < 64; ++i) if (tab[128 + i] <= rtg) e = i; return e; }
__device__ __forceinline__ void ph_moe1(const Ctx& c, int L) {
    moe_tables(c, L);
    const LAS int* tab = (const LAS int*)(c.lds + L_TAB);
    const int ar = c.tid >> 2, bn = c.tid & 127;
    const int ntile = tab[192];
    for (int u = blockIdx.x; u < ntile * 8; u += gridDim.x) {
        const int rtg = u >> 3, ct = u & 7; const int e = moe_find(tab, rtg); const int rt = rtg - tab[128 + e], cnt = tab[e], rowbase = tab[64 + e];
        const int pos = rt * 128 + ar;
        const float* rowp = nullptr;
        if (pos < cnt) { const int slot = c.lslot()[(size_t)e * LCAP + pos]; rowp = c.x1() + (size_t)(slot >> 1) * DM; }
        ALf32 al{rowp};
        const int wcv = bn >> 5, nsel = (bn >> 4) & 1, cc = bn & 15; const int hcol = ct * 64 + wcv * 16 + cc;
        const float* Wsel = (nsel ? c.we_up() : c.we_gate()) + ((size_t)L * NE + e) * DM * EH;
        BLf32 bl{Wsel + hcol, (size_t)EH};
        EpiMoe1 ep{c.H(), rowbase, cnt, rt, ct};
        gemm_tile(c.lds, al, bl, ep, DM);
    }
}
__device__ __forceinline__ void ph_moe2(const Ctx& c, int L) {
    moe_tables(c, L);
    const LAS int* tab = (const LAS int*)(c.lds + L_TAB);
    const int ar = c.tid >> 2, bn = c.tid & 127;
    const int ntile = tab[192];
    for (int u = blockIdx.x; u < ntile * 16; u += gridDim.x) {
        const int rtg = u >> 4, ct = u & 15; const int e = moe_find(tab, rtg); const int rt = rtg - tab[128 + e], cnt = tab[e], rowbase = tab[64 + e];
        const int pos = rt * 128 + ar;
        ALbf16 al{pos < cnt ? c.H() + (size_t)(rowbase + pos) * EH : nullptr};
        BLf32 bl{c.we_down() + ((size_t)L * NE + e) * EH * DM + ct * 128 + bn, (size_t)DM};
        EpiMoe2 ep{c.contrib(), c.lslot() + (size_t)e * LCAP, c.lw() + (size_t)e * LCAP, cnt, rt, ct * 128};
        gemm_tile(c.lds, al, bl, ep, EH);
    }
}

__global__ void __launch_bounds__(512, 2) fwd(Args a) {
    extern __shared__ __attribute__((aligned(16))) unsigned char smem[];
    unsigned char* ws = a.ws;
    const int tid0 = threadIdx.x;
    volatile LAS unsigned* barw = (volatile LAS unsigned*)((LAS unsigned char*)smem + L_BARW);
    if (tid0 < 4) barw[tid0] = 0u;
    __syncthreads();
    const int lo = a.lo, hi = a.hi;
    XcdBarrier bar; bar.bar = (unsigned*)(ws + WS_CTL) + CW_BAR; bar.x = 0; bar.st = barw;
    if (hi - lo > 1) bar = xcd_barrier_post((unsigned*)(ws + WS_CTL) + CW_BAR, barw);
#ifndef PHMASK
#define PHMASK 0x7ff
#endif
#define IN(k) (((PHMASK >> ((k) % NPH)) & 1) && lo <= (k) && (k) < hi)
#ifndef DUPMASK
#define DUPMASK 0
#endif
#define DUP(k) ((DUPMASK >> ((k) % NPH)) & 1)
#define SEAM(k) do { if ((k) + 1 < hi) xcd_barrier(bar); } while (0)
#define PCTX() Ctx c; { int t_ = threadIdx.x; asm volatile("" : "+v"(t_)); c.tid = t_; c.lane = t_ & 63; c.wid = __builtin_amdgcn_readfirstlane(t_ >> 6); c.lds = (LAS unsigned char*)smem; c.a = &a; }
#define LAYER_BODY(L) { const int pb = (L) * NPH; \
        if (IN(pb + 0)) { PCTX(); ph_inproj(c, L, L == 0 ? c.x_in() : c.x2()); if (DUP(0)) { ph_inproj(c, L, L == 0 ? c.x_in() : c.x2()); } SEAM(pb + 0); } \
        if (IN(pb + 1)) { PCTX(); ph_cmp1_swa(c, L); if (DUP(1)) { ph_cmp1_swa(c, L); } SEAM(pb + 1); } \
        if (IN(pb + 2)) { PCTX(); ph_cmp2(c, L); if (DUP(2)) { ph_cmp2(c, L); } SEAM(pb + 2); } \
        if (IN(pb + 3)) { PCTX(); ph_nsa(c, L); if (DUP(3)) { ph_nsa(c, L); } SEAM(pb + 3); } \
        if (IN(pb + 4)) { PCTX(); ph_outproj(c, L, L == 0 ? c.x_in() : c.x2()); if (DUP(4)) { ph_outproj(c, L, L == 0 ? c.x_in() : c.x2()); } SEAM(pb + 4); } \
        if (IN(pb + 5)) { PCTX(); ph_ln(c, c.y(), 1.f, nullptr, c.x1(), c.ln1_g() + L * DM, c.ln1_b() + L * DM); if (DUP(5)) { ph_ln(c, c.y(), 1.f, nullptr, c.x1(), c.ln1_g() + L * DM, c.ln1_b() + L * DM); } SEAM(pb + 5); } \
        if (IN(pb + 6)) { PCTX(); ph_router(c, L); if (DUP(6)) { ph_router(c, L); } SEAM(pb + 6); } \
        if (IN(pb + 7)) { PCTX(); ph_route(c, L); if (DUP(7)) { ph_route(c, L); } SEAM(pb + 7); } \
        if (IN(pb + 8)) { PCTX(); ph_moe1(c, L); if (DUP(8)) { ph_moe1(c, L); } SEAM(pb + 8); } \
        if (IN(pb + 9)) { PCTX(); ph_moe2(c, L); if (DUP(9)) { ph_moe2(c, L); } SEAM(pb + 9); } \
        if (IN(pb + 10)) { PCTX(); ph_ln(c, c.x1(), ALPHA, c.contrib(), L == DEPTH - 1 ? c.out() : c.x2(), c.ln2_g() + L * DM, c.ln2_b() + L * DM); if (DUP(10)) { ph_ln(c, c.x1(), ALPHA, c.contrib(), L == DEPTH - 1 ? c.out() : c.x2(), c.ln2_g() + L * DM, c.ln2_b() + L * DM); } SEAM(pb + 10); } \
    }
    LAYER_BODY(0)
    LAYER_BODY(1)
#undef IN
#undef SEAM
}

extern "C" void kernel_launch(void* const* d_in, const int* in_sizes, int n_in, void* d_out, int out_size, void* d_ws, size_t ws_size, hipStream_t stream) {
    static int grid = 0;
    if (grid == 0) {
        if (n_in != 23 || out_size != MTOK * DM || ws_size < WS_END) { fprintf(stderr, "kernel_launch: unexpected shapes (n_in %d out %d ws %zu)\n", n_in, out_size, ws_size); grid = -1; return; }
        int dev = 0, cus = 0;
        if (hipGetDevice(&dev) != hipSuccess || hipDeviceGetAttribute(&cus, hipDeviceAttributeMultiprocessorCount, dev) != hipSuccess) { grid = -1; return; }
        if (hipFuncSetAttribute((const void*)fwd, hipFuncAttributeMaxDynamicSharedMemorySize, LDS_BYTES) != hipSuccess) { fprintf(stderr, "kernel_launch: hipFuncSetAttribute failed\n"); grid = -1; return; }
        int per_cu = 0;
        (void)hipOccupancyMaxActiveBlocksPerMultiprocessor(&per_cu, (const void*)fwd, 512, LDS_BYTES);
        (void)hipGetLastError();
        grid = cus;
    }
    if (grid < 0) return;
    (void)hipMemsetAsync((char*)d_ws + WS_CTL, 0, CTL_BYTES, stream);
    Args a{};
    for (int i = 0; i < 23; ++i) a.in[i] = (const float*)d_in[i];
    a.out = (float*)d_out; a.ws = (unsigned char*)d_ws;
#if ONE_LAUNCH
    a.lo = 0; a.hi = DEPTH * NPH;
    hipLaunchKernelGGL(fwd, dim3(grid), dim3(512), LDS_BYTES, stream, a);
#else
    for (int k = 0; k < DEPTH * NPH; ++k) { a.lo = k; a.hi = k + 1; hipLaunchKernelGGL(fwd, dim3(grid), dim3(512), LDS_BYTES, stream, a); }
#endif
}
```

```cpp
#include <hip/hip_runtime.h>
#include <cstdio>
#include <cstdint>
#include <cmath>

#ifndef ONE_LAUNCH
#define ONE_LAUNCH 1
#endif


#define LAS __attribute__((address_space(3)))
typedef unsigned short bf16;
typedef short bf16x8 __attribute__((ext_vector_type(8)));
typedef float f32x4 __attribute__((ext_vector_type(4)));
typedef unsigned u32x4 __attribute__((ext_vector_type(4)));

constexpr int DM = 2048, SEQ = 4096, NB = 4, MTOK = NB * SEQ, DEPTH = 2;
constexpr int INC = 3120, PP = 3200;
constexpr int C_QA = 0, C_KA = 1024, C_VA = 1152, C_QN = 1280, C_KV = 2304, C_GN = 3072;
constexpr int NCMP = 255, CMPROWS = NB * NCMP * 2;
constexpr int NE = 64, EH = 512, LCAP = MTOK;
constexpr int NLOG = 80;
constexpr float ALPHA = 1.41421356237309515f;
constexpr float LN_EPS = 1e-5f;
constexpr int NPH = 11;

constexpr size_t MiB = 1u << 20;
constexpr size_t WS_CTL = 0, CTL_BYTES = 1 * MiB;
constexpr size_t WS_PROJ = 2 * MiB;
constexpr size_t WS_O = 102 * MiB;
constexpr size_t WS_Y = 166 * MiB;
constexpr size_t WS_X1 = 294 * MiB;
constexpr size_t WS_X2 = 422 * MiB;
constexpr size_t WS_HB = 550 * MiB;
constexpr size_t WS_KVC = 554 * MiB;
constexpr size_t WS_LOG = 555 * MiB;
constexpr size_t WS_LSLOT = 561 * MiB;
constexpr size_t WS_LW = 565 * MiB;
constexpr size_t WS_H = 569 * MiB;
constexpr size_t WS_CONTRIB = 601 * MiB;
constexpr size_t WS_WINT = 857 * MiB;
constexpr size_t WS_WOT = 881 * MiB;
constexpr size_t WS_XB = 897 * MiB;
constexpr size_t WS_END = 961 * MiB;
constexpr int CW_BAR = 4096;
constexpr int CW_CNT = 16384;

constexpr int L_GEMM = 0;
constexpr int L_KV = 32768;
constexpr int L_IMPA = 65536;
constexpr int L_IMPB = 81920;
constexpr int L_SEL = 98560;
constexpr int L_TAB = 131072;
constexpr int L_BARW = 132096;
constexpr int LDS_BYTES = 135168;

__device__ __forceinline__ float bf2f(unsigned h) { return __uint_as_float(h << 16); }
__device__ __forceinline__ unsigned cvt_pk_bf16(float lo, float hi) { unsigned r; asm("v_cvt_pk_bf16_f32 %0, %1, %2" : "=v"(r) : "v"(lo), "v"(hi)); return r; }
__device__ __forceinline__ bf16 f2bf(float f) { return (bf16)(cvt_pk_bf16(f, 0.f) & 0xffffu); }
__device__ __forceinline__ float wave_sum(float v) {
#pragma unroll
    for (int o = 1; o < 64; o <<= 1) v += __shfl_xor(v, o);
    return v;
}
__device__ __forceinline__ float wave_max(float v) {
#pragma unroll
    for (int o = 1; o < 64; o <<= 1) v = fmaxf(v, __shfl_xor(v, o));
    return v;
}
__device__ __forceinline__ float gelu_tanh(float x) {
    const float u = 0.7978845608028654f * (x + 0.044715f * x * x * x);
    const float e = expf(2.f * u);
    const float th = 1.f - 2.f / (e + 1.f);
    return 0.5f * x * (1.f + th);
}
__device__ __forceinline__ float sigmoidf(float x) { return 1.f / (1.f + expf(-x)); }
__device__ __forceinline__ float rfl(float v) { return __builtin_bit_cast(float, __builtin_amdgcn_readfirstlane(__builtin_bit_cast(int, v))); }
#define WAVE_LDS_FENCE() do { asm volatile("s_waitcnt lgkmcnt(0)" ::: "memory"); __builtin_amdgcn_wave_barrier(); } while (0)

#define XB_TMO      128
#define XB_XCNT(j)  (256  + 64 * (j))
#define XB_XSUB(j)  (1280 + 64 * (j))
#define XB_XGEN(j)  (2304 + 64 * (j))
#define XB_TOP      3328
#define XB_TOPGEN   3392
#define XCD_BAR_WORDS 3456
#define XB_SPIN_CAP (1u << 24)

__device__ __forceinline__ unsigned xb_ld(unsigned* p)              { return __hip_atomic_load(p, __ATOMIC_RELAXED, __HIP_MEMORY_SCOPE_AGENT); }
__device__ __forceinline__ unsigned xb_add(unsigned* p, unsigned v) { return __hip_atomic_fetch_add(p, v, __ATOMIC_RELAXED, __HIP_MEMORY_SCOPE_AGENT); }
__device__ __forceinline__ unsigned xb_xcc_id() { return (unsigned)__builtin_amdgcn_s_getreg((3 << 11) | 20) & 0xFu; }
#define XB_SPIN(cond, bar) do { unsigned _sp = 0; while (cond) { __builtin_amdgcn_s_sleep(1); \
    if ((++_sp & 255u) == 0u) { if (xb_ld(&(bar)[XB_TMO])) break; if (_sp > XB_SPIN_CAP) { atomicAdd(&(bar)[XB_TMO], 1u); break; } } } } while (0)

struct XcdBarrier { unsigned* bar; unsigned x; volatile LAS unsigned* st; };

__device__ __forceinline__ XcdBarrier xcd_barrier_post(unsigned* bar, volatile LAS unsigned* st) {
    XcdBarrier b; b.bar = bar; b.x = xb_xcc_id(); b.st = st;
    if (threadIdx.x == 0) (void)xb_add(&bar[XB_XCNT(b.x)], 1u);
    return b;
}
__device__ __forceinline__ void xcd_barrier_complete(unsigned* bar, unsigned x, unsigned& nloc, unsigned& nx) {
    const unsigned G = gridDim.x * gridDim.y * gridDim.z;
    unsigned sum, cnt, mine, sp = 0u;
    for (;;) {
        sum = 0u; cnt = 0u; mine = 0u;
#pragma unroll
        for (unsigned j = 0; j < 16; ++j) { const unsigned c = xb_ld(&bar[XB_XCNT(j)]); sum += c; cnt += (c > 0u) ? 1u : 0u; mine = (j == x) ? c : mine; }
        if (sum == G) break;
        __builtin_amdgcn_s_sleep(1);
        if ((++sp & 255u) == 0u) { if (xb_ld(&bar[XB_TMO])) break; if (sp > XB_SPIN_CAP) { atomicAdd(&bar[XB_TMO], 1u); break; } }
    }
    nloc = mine > 0u ? mine : 1u; nx = cnt > 0u ? cnt : 1u;
}
__device__ __forceinline__ void xcd_barrier(const XcdBarrier& b) {
    asm volatile("s_waitcnt vmcnt(0)" ::: "memory");
    __syncthreads();
    if (threadIdx.x == 0) {
        unsigned* bar = b.bar;
        __builtin_amdgcn_s_waitcnt(0);
        unsigned nloc = b.st[0], nx = b.st[1];
        if (nloc == 0u) { xcd_barrier_complete(bar, b.x, nloc, nx); b.st[0] = nloc; b.st[1] = nx; }
        const unsigned old = xb_add(&bar[XB_XSUB(b.x)], 1u);
        const unsigned gen = old / nloc;
        if (old + 1u == (gen + 1u) * nloc) {
            __builtin_amdgcn_fence(__ATOMIC_RELEASE, "agent");
            asm volatile("s_waitcnt vmcnt(0)" ::: "memory");
            const unsigned og = xb_add(&bar[XB_TOP], 1u);
            const unsigned tg = og / nx;
            if (og + 1u == (tg + 1u) * nx) xb_add(&bar[XB_TOPGEN], 1u);
            else XB_SPIN(xb_ld(&bar[XB_TOPGEN]) == tg, bar);
            __builtin_amdgcn_fence(__ATOMIC_ACQUIRE, "agent");
            xb_add(&bar[XB_XGEN(b.x)], 1u);
            asm volatile("s_waitcnt vmcnt(0)" ::: "memory");
        } else {
            XB_SPIN(xb_ld(&bar[XB_XGEN(b.x)]) == gen, bar);
            __builtin_amdgcn_fence(__ATOMIC_ACQUIRE, "agent");
            asm volatile("s_waitcnt vmcnt(0)" ::: "memory");
        }
    }
    __syncthreads();
}

template <class AL, class BL, class EP>
__device__ __forceinline__ void gemm_tile(LAS unsigned char* lds, const AL& al, const BL& bl, const EP& ep, int K) {
    const int tid = threadIdx.x, wid = tid >> 6, lane = tid & 63, wr = wid >> 2, wc = wid & 3, fr = lane & 15, fq = lane >> 4;
    LAS bf16* As = (LAS bf16*)(lds + L_GEMM);
    LAS bf16* Bs = As + 128 * 40;
    const int ar = tid >> 2, akq = (tid & 3) * 8;
    const int bn = tid & 127, bkg = (tid >> 7) * 8;
    f32x4 acc[4][2];
#pragma unroll
    for (int m = 0; m < 4; ++m)
#pragma unroll
        for (int n = 0; n < 2; ++n) acc[m][n] = (f32x4){0.f, 0.f, 0.f, 0.f};
    bf16x8 ra = al.load(akq);
    float rb0 = bl.load(bkg + 0), rb1 = bl.load(bkg + 1), rb2 = bl.load(bkg + 2), rb3 = bl.load(bkg + 3),
          rb4 = bl.load(bkg + 4), rb5 = bl.load(bkg + 5), rb6 = bl.load(bkg + 6), rb7 = bl.load(bkg + 7);
    for (int k0 = 0; k0 < K; k0 += 32) {
        *(LAS bf16x8*)(As + ar * 40 + akq) = ra;
        u32x4 pb; pb.x = cvt_pk_bf16(rb0, rb1); pb.y = cvt_pk_bf16(rb2, rb3); pb.z = cvt_pk_bf16(rb4, rb5); pb.w = cvt_pk_bf16(rb6, rb7);
        *(LAS u32x4*)(Bs + bn * 40 + bkg) = pb;
        __syncthreads();
        if (k0 + 32 < K) {
            const int kn = k0 + 32;
            ra = al.load(kn + akq);
            rb0 = bl.load(kn + bkg + 0); rb1 = bl.load(kn + bkg + 1); rb2 = bl.load(kn + bkg + 2); rb3 = bl.load(kn + bkg + 3);
            rb4 = bl.load(kn + bkg + 4); rb5 = bl.load(kn + bkg + 5); rb6 = bl.load(kn + bkg + 6); rb7 = bl.load(kn + bkg + 7);
        }
        bf16x8 af[4], bfr[2];
#pragma unroll
        for (int m = 0; m < 4; ++m) af[m] = *(const LAS bf16x8*)(As + (wr * 64 + m * 16 + fr) * 40 + fq * 8);
#pragma unroll
        for (int n = 0; n < 2; ++n) bfr[n] = *(const LAS bf16x8*)(Bs + (wc * 32 + n * 16 + fr) * 40 + fq * 8);
#pragma unroll
        for (int m = 0; m < 4; ++m)
#pragma unroll
            for (int n = 0; n < 2; ++n) acc[m][n] = __builtin_amdgcn_mfma_f32_16x16x32_bf16(af[m], bfr[n], acc[m][n], 0, 0, 0);
        __syncthreads();
    }
    ep(acc, wr, wc, fr, fq);
}

__device__ __forceinline__ bf16x8 pack8(f32x4 a, f32x4 b) {
    u32x4 p; p.x = cvt_pk_bf16(a.x, a.y); p.y = cvt_pk_bf16(a.z, a.w); p.z = cvt_pk_bf16(b.x, b.y); p.w = cvt_pk_bf16(b.z, b.w);
    return __builtin_bit_cast(bf16x8, p);
}
__device__ __forceinline__ bf16x8 zero8() { u32x4 p = {0u, 0u, 0u, 0u}; return __builtin_bit_cast(bf16x8, p); }

struct ALf32 { const float* rowp; __device__ __forceinline__ bf16x8 load(int k) const { if (!rowp) return zero8(); const f32x4 a = *(const f32x4*)(rowp + k), b = *(const f32x4*)(rowp + k + 4); return pack8(a, b); } };
struct ALbf16 { const bf16* rowp; __device__ __forceinline__ bf16x8 load(int k) const { if (!rowp) return zero8(); return *(const bf16x8*)(rowp + k); } };
struct ALcmp { const bf16* base; const float* pe; __device__ __forceinline__ bf16x8 load(int k) const {
        if (!base) return zero8();
        const int l = k >> 6, d = k & 63;
        const u32x4 v = *(const u32x4*)(base + (size_t)l * PP + d);
        const f32x4 p0 = *(const f32x4*)(pe + k), p1 = *(const f32x4*)(pe + k + 4);
        f32x4 a, b;
        a.x = bf2f(v.x & 0xffffu) + p0.x; a.y = bf2f(v.x >> 16) + p0.y; a.z = bf2f(v.y & 0xffffu) + p0.z; a.w = bf2f(v.y >> 16) + p0.w;
        b.x = bf2f(v.z & 0xffffu) + p1.x; b.y = bf2f(v.z >> 16) + p1.y; b.z = bf2f(v.w & 0xffffu) + p1.z; b.w = bf2f(v.w >> 16) + p1.w;
        return pack8(a, b); } };
struct BLf32 { const float* colp; size_t ldb; __device__ __forceinline__ float load(int k) const { return colp ? colp[(size_t)k * ldb] : 0.f; } };

namespace pg8 {
#define PG8_LAS __attribute__((address_space(3)))
typedef unsigned short bf16_t;
typedef short bf16x8 __attribute__((ext_vector_type(8)));
typedef float f32x4 __attribute__((ext_vector_type(4)));
typedef unsigned u32x4 __attribute__((ext_vector_type(4)));
constexpr int BM = 256, BK = 64, HALF = 128, HTB = HALF * BK * 2  , STAGE_BYTES = 8 * HTB, NXCD = 8, WGM = 8;

__host__ __device__ __forceinline__ int lds_byte(int r, int c) { const int st = (r >> 4) * 2 + (c >> 5), rr = r & 15, cc = c & 31, ob = rr * 64 + cc * 2; return st * 1024 + (ob ^ (((ob >> 9) & 1) << 5)); }
__host__ __device__ __forceinline__ void stage_rc(int b, int& R, int& C) { const int st = b / 1024, sb = b % 1024, swz = sb ^ (((sb >> 9) & 1) << 5); R = (st >> 1) * 16 + swz / 64; C = (st & 1) * 32 + (swz % 64) / 2; }
__host__ __device__ __forceinline__ int perm32(int rho) { const int n = rho >> 4, i = rho & 15; return 8 * (i >> 2) + 4 * n + (i & 3); }

struct Unit { int pm, pn; };
struct Gemm { const bf16_t* A; const bf16_t* Bt; int M, N, K; };

struct StaticOrder {
    int nM, nN, nwg, G, c;
    __host__ __device__ void init(int M, int N, int G_, int c_) { nM = M / BM; nN = N / BM; nwg = nM * nN; G = G_; c = c_; }
    __host__ __device__ bool next(int i, Unit& u) const {
        const long L = (long)i * G + c; if (L >= nwg) return false;
        int wgid = (int)L; { const int q = nwg / NXCD, r = nwg % NXCD, xcd = wgid % NXCD, off = wgid / NXCD; wgid = (xcd < r ? xcd * (q + 1) : r * (q + 1) + (xcd - r) * q) + off; }
        const int nig = WGM * nN, gid = wgid / nig, fm = gid * WGM, gsz = (nM - fm) < WGM ? (nM - fm) : WGM;
        u.pm = fm + ((wgid % nig) % gsz); u.pn = (wgid % nig) / gsz; return true;
    }
    __device__ __forceinline__ void a_ready(const Unit&) const {}
    __device__ __forceinline__ void done(const Unit&) const {}
};

__device__ __forceinline__ unsigned cvt_pk_bf16(float lo, float hi) { unsigned r; asm volatile("v_cvt_pk_bf16_f32 %0, %1, %2" : "=v"(r) : "v"(lo), "v"(hi)); return r; }
typedef float f32x2 __attribute__((ext_vector_type(2)));
__device__ __forceinline__ f32x2 gelu_pk(f32x2 v) {
    const f32x2 av = __builtin_elementwise_abs(v), d = av * 0.2316418882f + 1.0f;
    f32x2 t; t.x = __builtin_amdgcn_rcpf(d.x); t.y = __builtin_amdgcn_rcpf(d.y);
    f32x2 q = t * 0.5307027145f + (-0.7265760135f); q = q * t + 0.7107068705f; q = q * t + (-0.142248368f); q = q * t + 0.127414796f; q = q * t;
    const f32x2 s = (v * v) * (-0.72134752044f);
    f32x2 e; e.x = __builtin_amdgcn_exp2f(s.x); e.y = __builtin_amdgcn_exp2f(s.y);
    const f32x2 m = v * (q * e), r = v - m;
    f32x2 o; o.x = v.x < 0.f ? m.x : r.x; o.y = v.y < 0.f ? m.y : r.y; return o;
}

template <int ACT  > struct EpiBf16 {
    static constexpr bool PERM = true, AFTER_DRAIN = false; static_assert(ACT == 0 || ACT == 1, "EpiBf16: ACT is 0 (none) or 1 (gelu_pk)");
    bf16_t* O; int ldc; const float* bias; int split_cols; size_t split_stride; float scale0;
    __device__ __forceinline__ void operator()(const f32x4 (&acc)[2][2][4][2], const Unit& u, int wr, int wc, int fr, int fq) const {
        const int row0 = u.pm * BM + wr * 64 + fr; int colt = u.pn * BM; bf16_t* base = O;
        float sc = 1.f; if (split_cols) { const int t = colt / split_cols; base += (size_t)t * split_stride; colt -= t * split_cols; if (t == 0) sc = scale0; }
        const int col0 = colt + wc * 32 + 8 * fq, bcol0 = u.pn * BM + wc * 32 + 8 * fq;
        f32x4 bv[2][2];
#pragma unroll
        for (int bj = 0; bj < 2; ++bj)
#pragma unroll
            for (int n = 0; n < 2; ++n) bv[bj][n] = bias ? *(const f32x4*)(bias + bcol0 + bj * HALF + 4 * n) : (f32x4){0.f, 0.f, 0.f, 0.f};
#pragma unroll
        for (int ai = 0; ai < 2; ++ai)
#pragma unroll
            for (int m = 0; m < 4; ++m) { bf16_t* rowp = base + (size_t)(row0 + ai * HALF + m * 16) * ldc + col0;
#pragma unroll
                for (int bj = 0; bj < 2; ++bj) { f32x4 v0 = acc[ai][bj][m][0] + bv[bj][0], v1 = acc[ai][bj][m][1] + bv[bj][1];
                    if (ACT == 1) { f32x2 a = gelu_pk((f32x2){v0[0], v0[1]}), b = gelu_pk((f32x2){v0[2], v0[3]}), c = gelu_pk((f32x2){v1[0], v1[1]}), d = gelu_pk((f32x2){v1[2], v1[3]});
                        v0 = (f32x4){a.x, a.y, b.x, b.y}; v1 = (f32x4){c.x, c.y, d.x, d.y}; }
                    v0 = v0 * sc; v1 = v1 * sc; u32x4 w; w.x = cvt_pk_bf16(v0[0], v0[1]); w.y = cvt_pk_bf16(v0[2], v0[3]); w.z = cvt_pk_bf16(v1[0], v1[1]); w.w = cvt_pk_bf16(v1[2], v1[3]);
                    *(u32x4*)(rowp + bj * HALF) = w; } }
    }
};

template <class Epi, class Sched, bool ALIGN_EPI = false, bool SP2 = false>
__device__ __forceinline__ void gemm_phase(PG8_LAS unsigned char* lds, const Gemm g, const Sched& S, const Epi& E) {
    const int tid = threadIdx.x, wid = __builtin_amdgcn_readfirstlane(tid >> 6), lane = tid & 63, wr = wid >> 2, wc = wid & 3, fr = lane & 15, fq = lane >> 4;
    const int K = g.K, nt = K / BK;
    unsigned voffA[2], voffB[2];
#pragma unroll
    for (int i = 0; i < 2; ++i) { int R, C; stage_rc(tid * 16 + i * 8192, R, C); const int Rb = Epi::PERM ? ((R & ~31) + perm32(R & 31)) : R;
        voffA[i] = (unsigned)(R * K + C) * 2u; voffB[i] = (unsigned)(Rb * K + C) * 2u; }
    const size_t kstep = (size_t)(BK * 2);
    const size_t hstep = (size_t)HALF * K * 2;
    const size_t tstep = 2 * hstep;
    const unsigned ldsw = (unsigned)wid * 1024u;
    const int aoff = lds_byte(wr * 64 + fr, fq * 8), boff = lds_byte(wc * 32 + fr, fq * 8);
#define PG8_SA(b, h) (((b) * 2 + (h)) * HTB)
#define PG8_SB(b, h) ((4 + (b) * 2 + (h)) * HTB)
#define PG8_STAGE(bufoff, gbase, voff) do { _Pragma("unroll") for (int _i = 0; _i < 2; ++_i) \
        __builtin_amdgcn_global_load_lds((const unsigned*)((const char*)(gbase) + (voff)[_i]), (PG8_LAS unsigned*)(lds + (bufoff) + ldsw + _i * 8192), 16, 0, 0); } while (0)
#define PG8_LDA(dst, b, h) do { _Pragma("unroll") for (int m = 0; m < 4; ++m) _Pragma("unroll") for (int k = 0; k < 2; ++k) dst[m][k] = *(const PG8_LAS bf16x8*)(lds + PG8_SA(b, h) + aoff + m * 2048 + k * 1024); } while (0)
#define PG8_LDB(dst, b, h) do { _Pragma("unroll") for (int n = 0; n < 2; ++n) _Pragma("unroll") for (int k = 0; k < 2; ++k) dst[n][k] = *(const PG8_LAS bf16x8*)(lds + PG8_SB(b, h) + boff + n * 2048 + k * 1024); } while (0)
#define PG8_MMA(ai, bj, At, Bt) do { __builtin_amdgcn_s_setprio(1); _Pragma("unroll") for (int m = 0; m < 4; ++m) _Pragma("unroll") for (int n = 0; n < 2; ++n) _Pragma("unroll") for (int k = 0; k < 2; ++k) \
        acc[ai][bj][m][n] = __builtin_amdgcn_mfma_f32_16x16x32_bf16(Bt[n][k], At[m][k], acc[ai][bj][m][n], 0, 0, 0); __builtin_amdgcn_s_setprio(0); } while (0)
#define PG8_WAIT_V(n) asm volatile("s_waitcnt vmcnt(" #n ")" ::: "memory")
#define PG8_WAIT_L(n) asm volatile("s_waitcnt lgkmcnt(" #n ")" ::: "memory")
#define PG8_BAR __builtin_amdgcn_s_barrier()
#define PG8_SCHED __builtin_amdgcn_sched_barrier(0)
    Unit cur, nxt; int ui = 0;
    if (!S.next(0, cur)) return;
    f32x4 acc[2][2][4][2];
#pragma unroll
    for (int a = 0; a < 2; ++a)
#pragma unroll
        for (int b = 0; b < 2; ++b)
#pragma unroll
            for (int m = 0; m < 4; ++m)
#pragma unroll
                for (int n = 0; n < 2; ++n) acc[a][b][m][n] = (f32x4){0.f, 0.f, 0.f, 0.f};
    bf16x8 At[4][2], B0[2][2], B1[2][2];
    const char* cA = (const char*)g.A + (size_t)cur.pm * tstep; const char* cB = (const char*)g.Bt + (size_t)cur.pn * tstep;
    S.a_ready(cur);
    if constexpr (SP2) {
        PG8_STAGE(PG8_SB(0, 0), cB, voffB); PG8_STAGE(PG8_SB(0, 1), cB + hstep, voffB); PG8_STAGE(PG8_SA(0, 0), cA, voffA); PG8_STAGE(PG8_SA(0, 1), cA + hstep, voffA);
        if (wr == 1) PG8_BAR;
        PG8_WAIT_V(2); PG8_BAR;
        PG8_STAGE(PG8_SB(1, 0), cB + kstep, voffB); PG8_STAGE(PG8_SA(1, 0), cA + kstep, voffA); PG8_STAGE(PG8_SB(1, 1), cB + hstep + kstep, voffB);
        PG8_WAIT_V(6); PG8_BAR;
    } else {
        PG8_STAGE(PG8_SB(0, 0), cB, voffB); PG8_STAGE(PG8_SA(0, 0), cA, voffA); PG8_STAGE(PG8_SB(0, 1), cB + hstep, voffB); PG8_STAGE(PG8_SA(0, 1), cA + hstep, voffA);
        if (wr == 1) PG8_BAR;
        PG8_WAIT_V(4); PG8_BAR;
        PG8_STAGE(PG8_SB(1, 0), cB + kstep, voffB); PG8_STAGE(PG8_SA(1, 0), cA + kstep, voffA); PG8_STAGE(PG8_SB(1, 1), cB + hstep + kstep, voffB);
        PG8_WAIT_V(6); PG8_BAR;
    }
    for (;;) {
        const bool has_next = S.next(ui + 1, nxt);
        const char* nA = has_next ? (const char*)g.A + (size_t)nxt.pm * tstep : cA; const char* nB = has_next ? (const char*)g.Bt + (size_t)nxt.pn * tstep : cB;
        for (int t = 0; t < nt; t += 2) {
            const bool last = (t == nt - 2);
            const char* a1 = cA + (size_t)(t + 1) * kstep;
            const char* a2 = last ? nA : cA + (size_t)(t + 2) * kstep; const char* b2 = last ? nB : cB + (size_t)(t + 2) * kstep;
            const char* a3 = a2 + kstep; const char* b3 = b2 + kstep;
            if (last && has_next) S.a_ready(nxt);
            if constexpr (SP2) {
            PG8_LDB(B0, 0, 0); PG8_LDB(B1, 0, 1); PG8_SCHED; PG8_LDA(At, 0, 0); PG8_STAGE(PG8_SA(1, 1), a1 + hstep, voffA);
            PG8_WAIT_V(8); PG8_WAIT_L(0); PG8_BAR; PG8_MMA(0, 0, At, B0); PG8_MMA(0, 1, At, B1); PG8_BAR; PG8_SCHED;
            PG8_LDA(At, 0, 1); PG8_STAGE(PG8_SB(0, 0), b2, voffB); PG8_STAGE(PG8_SB(0, 1), b2 + hstep, voffB); PG8_STAGE(PG8_SA(0, 0), a2, voffA);
            PG8_WAIT_V(8); PG8_WAIT_L(0); PG8_BAR; PG8_MMA(1, 0, At, B0); PG8_MMA(1, 1, At, B1); PG8_BAR; PG8_SCHED;
            PG8_LDB(B0, 1, 0); PG8_LDB(B1, 1, 1); PG8_SCHED; PG8_LDA(At, 1, 0); PG8_STAGE(PG8_SA(0, 1), a2 + hstep, voffA);
            PG8_WAIT_V(8); PG8_WAIT_L(0); PG8_BAR; PG8_MMA(0, 0, At, B0); PG8_MMA(0, 1, At, B1); PG8_BAR; PG8_SCHED;
            PG8_LDA(At, 1, 1); PG8_STAGE(PG8_SB(1, 0), b3, voffB); PG8_STAGE(PG8_SB(1, 1), b3 + hstep, voffB); PG8_STAGE(PG8_SA(1, 0), a3, voffA);
            PG8_WAIT_V(8); PG8_WAIT_L(0); PG8_BAR; PG8_MMA(1, 0, At, B0); PG8_MMA(1, 1, At, B1); PG8_BAR; PG8_SCHED;
            } else {
            PG8_LDB(B0, 0, 0); PG8_SCHED; PG8_LDA(At, 0, 0); PG8_STAGE(PG8_SA(1, 1), a1 + hstep, voffA);
            PG8_WAIT_L(8); PG8_BAR; PG8_WAIT_L(0); PG8_MMA(0, 0, At, B0); PG8_BAR; PG8_SCHED;
            PG8_LDB(B1, 0, 1); PG8_STAGE(PG8_SB(0, 0), b2, voffB);
            PG8_BAR; PG8_WAIT_L(0); PG8_MMA(0, 1, At, B1); PG8_BAR;
            PG8_LDA(At, 0, 1); PG8_STAGE(PG8_SA(0, 0), a2, voffA);
            PG8_BAR; PG8_WAIT_L(0); PG8_MMA(1, 0, At, B0); PG8_BAR; PG8_SCHED;
            PG8_STAGE(PG8_SB(0, 1), b2 + hstep, voffB);
            PG8_WAIT_V(6); PG8_BAR; PG8_MMA(1, 1, At, B1); PG8_BAR;
            PG8_LDB(B0, 1, 0); PG8_SCHED; PG8_LDA(At, 1, 0); PG8_STAGE(PG8_SA(0, 1), a2 + hstep, voffA);
            PG8_WAIT_L(8); PG8_BAR; PG8_WAIT_L(0); PG8_MMA(0, 0, At, B0); PG8_BAR; PG8_SCHED;
            PG8_LDB(B1, 1, 1); PG8_STAGE(PG8_SB(1, 0), b3, voffB);
            PG8_BAR; PG8_WAIT_L(0); PG8_MMA(0, 1, At, B1); PG8_BAR;
            PG8_LDA(At, 1, 1); PG8_STAGE(PG8_SA(1, 0), a3, voffA);
            PG8_BAR; PG8_WAIT_L(0); PG8_MMA(1, 0, At, B0); PG8_BAR; PG8_SCHED;
            PG8_STAGE(PG8_SB(1, 1), b3 + hstep, voffB);
            PG8_WAIT_V(6); PG8_BAR; PG8_MMA(1, 1, At, B1); PG8_BAR;
            }
        }
        if constexpr (ALIGN_EPI) { if (wr == 0) PG8_BAR; }
        if constexpr (!Epi::AFTER_DRAIN) { E(acc, cur, wr, wc, fr, fq); S.done(cur); }
        if (!has_next) break;
#pragma unroll
        for (int a = 0; a < 2; ++a)
#pragma unroll
            for (int b = 0; b < 2; ++b)
#pragma unroll
                for (int m = 0; m < 4; ++m)
#pragma unroll
                    for (int n = 0; n < 2; ++n) acc[a][b][m][n] = (f32x4){0.f, 0.f, 0.f, 0.f};
        cur = nxt; cA = nA; cB = nB; ++ui;
        if constexpr (ALIGN_EPI) { if (wr == 1) PG8_BAR; }
    }
    PG8_WAIT_V(0);
    if constexpr (!ALIGN_EPI) { if (wr == 0) PG8_BAR; }
    PG8_BAR;
    if constexpr (Epi::AFTER_DRAIN) { E.fused(acc, cur, wr, wc, fr, fq, lds, wid, lane); S.done(cur); }
#undef PG8_SA
#undef PG8_SB
#undef PG8_STAGE
#undef PG8_LDA
#undef PG8_LDB
#undef PG8_MMA
#undef PG8_WAIT_V
#undef PG8_WAIT_L
#undef PG8_BAR
#undef PG8_SCHED
}
}

namespace pg8 {
struct EpiF32Res {
    static constexpr bool PERM = false, AFTER_DRAIN = false;
    float* Y; const float* res; const float* bias; int ldc; float alpha;
    __device__ __forceinline__ void operator()(const f32x4 (&acc)[2][2][4][2], const Unit& u, int wr, int wc, int fr, int fq) const {
        const int row0 = u.pm * BM + wr * 64 + fr, col0 = u.pn * BM + wc * 32 + 4 * fq;
#pragma unroll
        for (int ai = 0; ai < 2; ++ai)
#pragma unroll
            for (int m = 0; m < 4; ++m) { const size_t off = (size_t)(row0 + ai * HALF + m * 16) * ldc + col0;
#pragma unroll
                for (int bj = 0; bj < 2; ++bj)
#pragma unroll
                    for (int n = 0; n < 2; ++n) { const int cofs = bj * HALF + n * 16;
                        const f32x4 bv = *(const f32x4*)(bias + col0 + cofs), rv = *(const f32x4*)(res + off + cofs);
                        *(f32x4*)(Y + off + cofs) = acc[ai][bj][m][n] + bv + rv * alpha; } }
    }
};
}

struct Args { const float* in[23]; float* out; unsigned char* ws; int lo, hi; };

struct Ctx {
    LAS unsigned char* lds;
    int tid, lane, wid;
    const Args* a;
    __device__ __forceinline__ const float* x_in() const { return a->in[0]; }
    __device__ __forceinline__ const float* w_in() const { return a->in[1]; }
    __device__ __forceinline__ const float* b_in() const { return a->in[2]; }
    __device__ __forceinline__ const float* sinks() const { return a->in[3]; }
    __device__ __forceinline__ const float* pe_k() const { return a->in[4]; }
    __device__ __forceinline__ const float* w1_k() const { return a->in[5]; }
    __device__ __forceinline__ const float* w2_k() const { return a->in[6]; }
    __device__ __forceinline__ const float* pe_v() const { return a->in[7]; }
    __device__ __forceinline__ const float* w1_v() const { return a->in[8]; }
    __device__ __forceinline__ const float* w2_v() const { return a->in[9]; }
    __device__ __forceinline__ const float* w_out() const { return a->in[10]; }
    __device__ __forceinline__ const float* b_out() const { return a->in[11]; }
    __device__ __forceinline__ const float* ln1_g() const { return a->in[12]; }
    __device__ __forceinline__ const float* ln1_b() const { return a->in[13]; }
    __device__ __forceinline__ const float* w_group() const { return a->in[14]; }
    __device__ __forceinline__ const float* b_group() const { return a->in[15]; }
    __device__ __forceinline__ const float* w_expert() const { return a->in[16]; }
    __device__ __forceinline__ const float* b_expert() const { return a->in[17]; }
    __device__ __forceinline__ const float* we_gate() const { return a->in[18]; }
    __device__ __forceinline__ const float* we_up() const { return a->in[19]; }
    __device__ __forceinline__ const float* we_down() const { return a->in[20]; }
    __device__ __forceinline__ const float* ln2_g() const { return a->in[21]; }
    __device__ __forceinline__ const float* ln2_b() const { return a->in[22]; }
    __device__ __forceinline__ float* out() const { return a->out; }
    __device__ __forceinline__ bf16* proj() const { return (bf16*)(a->ws + WS_PROJ); }
    __device__ __forceinline__ bf16* o() const { return (bf16*)(a->ws + WS_O); }
    __device__ __forceinline__ bf16* kvc() const { return (bf16*)(a->ws + WS_KVC); }
    __device__ __forceinline__ bf16* H() const { return (bf16*)(a->ws + WS_H); }
    __device__ __forceinline__ float* y() const { return (float*)(a->ws + WS_Y); }
    __device__ __forceinline__ float* x1() const { return (float*)(a->ws + WS_X1); }
    __device__ __forceinline__ float* x2() const { return (float*)(a->ws + WS_X2); }
    __device__ __forceinline__ float* hb() const { return (float*)(a->ws + WS_HB); }
    __device__ __forceinline__ float* logits() const { return (float*)(a->ws + WS_LOG); }
    __device__ __forceinline__ float* lw() const { return (float*)(a->ws + WS_LW); }
    __device__ __forceinline__ float* contrib() const { return (float*)(a->ws + WS_CONTRIB); }
    __device__ __forceinline__ int* lslot() const { return (int*)(a->ws + WS_LSLOT); }
    __device__ __forceinline__ bf16* wint() const { return (bf16*)(a->ws + WS_WINT); }
    __device__ __forceinline__ bf16* wot() const { return (bf16*)(a->ws + WS_WOT); }
    __device__ __forceinline__ bf16* xb() const { return (bf16*)(a->ws + WS_XB); }
    __device__ __forceinline__ unsigned* cnt() const { return (unsigned*)(a->ws + WS_CTL) + CW_CNT; }
};

constexpr int ATILE_BYTES = 64 * 64 * 2;
constexpr float C1 = 0.125f * 1.4426950408889634f;

struct AttnRegs { f32x4 O[4][4]; float m[4], l[4]; bf16x8 Q[4][2]; };
struct ColCtx { int tt0; int t0; };
struct TileD { const bf16* k; const bf16* v; int pitch; float offrel; int mtype; int j; };
struct TileGen {
    int kind;
    int j, jend; unsigned long long rem; int c, jold;
    const bf16* kb; const bf16* vb;
    __device__ __forceinline__ bool next(TileD& d) {
        int jj;
        if (kind == 1) { if (!rem) return false; jj = __builtin_ctzll(rem); rem &= rem - 1; }
        else { if (j > jend) return false; jj = j++; }
        d.j = jj;
        if (kind == 2) { d.k = kb + (size_t)jj * 64 * 128; d.v = vb + (size_t)jj * 64 * 128; d.pitch = 128; d.offrel = (float)(1024 * jj + 31 - 64 * c); d.mtype = 3; }
        else { d.k = kb + (size_t)jj * 64 * PP; d.v = vb + (size_t)jj * 64 * PP; d.pitch = PP; d.offrel = (float)(64 * (jj - c)); d.mtype = (jj == c) ? 1 : (jj == jold ? 2 : 0); }
        return true;
    }
};

__device__ __forceinline__ void attn_load_q(AttnRegs& R, const bf16* qbase, int w, int fr, int fq) {
#pragma unroll
    for (int nt = 0; nt < 4; ++nt) {
        const int tt = 8 * w + 2 * nt + (fr >> 3);
        const bf16* p = qbase + (size_t)tt * PP + (fr & 7) * 64 + fq * 8;
        R.Q[nt][0] = *(const bf16x8*)p; R.Q[nt][1] = *(const bf16x8*)(p + 32);
    }
}
__device__ __forceinline__ void attn_reset(AttnRegs& R) {
#pragma unroll
    for (int nt = 0; nt < 4; ++nt) { R.m[nt] = -INFINITY; R.l[nt] = 0.f;
#pragma unroll
        for (int md = 0; md < 4; ++md) R.O[md][nt] = (f32x4){0.f, 0.f, 0.f, 0.f}; }
}
__device__ __forceinline__ void stage_issue(const TileD& d, LAS unsigned char* kdst, LAS unsigned char* vdst, int w, int lane) {
    const int r = 8 * w + (lane >> 3), ch = (lane & 7) ^ ((lane >> 3) & 7);
    __builtin_amdgcn_global_load_lds((const unsigned*)(d.k + (size_t)r * d.pitch + ch * 8), (LAS unsigned*)(kdst + w * 1024), 16, 0, 0);
    __builtin_amdgcn_global_load_lds((const unsigned*)(d.v + (size_t)r * d.pitch + ch * 8), (LAS unsigned*)(vdst + w * 1024), 16, 0, 0);
}

template <int MODE>
__device__ __forceinline__ void attn_half(AttnRegs& R, const LAS unsigned char* Kt, const LAS unsigned char* Vt, const int hk, const float A, const float kstep, const float off,
                                          const int mtype, const int hicmp, const unsigned enbits, const ColCtx& cc, const int fr, const int fq,
                                          LAS float* impA, LAS float* impB, const int jq0) {
    bf16x8 Kf[2][2];
#pragma unroll
    for (int m = 0; m < 2; ++m)
#pragma unroll
        for (int ks = 0; ks < 2; ++ks) Kf[m][ks] = *(const LAS bf16x8*)(Kt + (hk * 32 + m * 16 + fr) * 128 + (((ks * 4 + fq) ^ (fr & 7)) * 16));
    f32x4 S[2][4];
    const float ak = A * kstep;
#pragma unroll
    for (int m = 0; m < 2; ++m) {
        const float b0 = ak * (float)(hk * 32 + m * 16 + 4 * fq);
        const f32x4 cb = {b0, b0 + ak, b0 + 2.f * ak, b0 + 3.f * ak};
#pragma unroll
        for (int nt = 0; nt < 4; ++nt) {
            S[m][nt] = __builtin_amdgcn_mfma_f32_16x16x32_bf16(Kf[m][0], R.Q[nt][0], cb, 0, 0, 0);
            S[m][nt] = __builtin_amdgcn_mfma_f32_16x16x32_bf16(Kf[m][1], R.Q[nt][1], S[m][nt], 0, 0, 0);
        }
    }
    __builtin_amdgcn_sched_barrier(0);
    bool en[4];
#pragma unroll
    for (int nt = 0; nt < 4; ++nt) en[nt] = ((enbits >> nt) & 1u) != 0u;
    if (mtype != 0) {
#pragma unroll
        for (int nt = 0; nt < 4; ++nt) {
            const int tt = cc.tt0 + 2 * nt;
            int lo = 0, hi = 63;
            if (mtype == 1) hi = tt; else if (mtype == 2) lo = tt + 1; else { const int t = cc.t0 + tt; hi = (t >= 31 ? ((t - 31) >> 4) : -1) - hicmp; }
#pragma unroll
            for (int m = 0; m < 2; ++m)
#pragma unroll
                for (int r = 0; r < 4; ++r) { const int kk = hk * 32 + m * 16 + 4 * fq + r; if (kk < lo || kk > hi) S[m][nt][r] = -INFINITY; }
        }
    }
    bf16x8 Pf[4];
#pragma unroll
    for (int nt = 0; nt < 4; ++nt) {
        float add;
        if (MODE == 2) {
            add = (en[nt] && R.m[nt] > -INFINITY) ? C1 * (off - R.m[nt]) : -INFINITY;
        } else {
            float cm = fmaxf(fmaxf(fmaxf(S[0][nt][0], S[0][nt][1]), fmaxf(S[0][nt][2], S[0][nt][3])), fmaxf(fmaxf(S[1][nt][0], S[1][nt][1]), fmaxf(S[1][nt][2], S[1][nt][3])));
            if (!en[nt]) cm = -INFINITY;
            cm = fmaxf(cm, __shfl_xor(cm, 16)); cm = fmaxf(cm, __shfl_xor(cm, 32));
            const float mn = fmaxf(R.m[nt], cm + off);
            const float corr = (mn == -INFINITY) ? 1.f : __builtin_amdgcn_exp2f(C1 * (R.m[nt] - mn));
            add = (en[nt] && mn > -INFINITY) ? C1 * (off - mn) : -INFINITY;
            R.m[nt] = mn; R.l[nt] *= corr;
            if (MODE == 0) {
#pragma unroll
                for (int md = 0; md < 4; ++md) R.O[md][nt] = R.O[md][nt] * corr;
            }
        }
        float p[2][4];
#pragma unroll
        for (int m = 0; m < 2; ++m)
#pragma unroll
            for (int r = 0; r < 4; ++r) p[m][r] = __builtin_amdgcn_exp2f(fmaf(S[m][nt][r], C1, add));
        if (MODE == 2) {
#pragma unroll
            for (int m = 0; m < 2; ++m) {
                float q4 = (p[m][0] + p[m][1]) + (p[m][2] + p[m][3]), p3 = p[m][3];
                q4 += __shfl_xor(q4, 1); p3 += __shfl_xor(p3, 1);
                q4 += __shfl_xor(q4, 2); p3 += __shfl_xor(p3, 2);
                q4 += __shfl_xor(q4, 4); p3 += __shfl_xor(p3, 4);
                if ((fr & 7) == 0) { const int jq = jq0 + hk * 8 + m * 4 + fq; impA[(cc.tt0 + 2 * nt) * 64 + jq] = q4; impB[(cc.tt0 + 2 * nt) * 65 + jq + 1] = p3; }
            }
        } else {
            R.l[nt] += ((p[0][0] + p[0][1]) + (p[0][2] + p[0][3])) + ((p[1][0] + p[1][1]) + (p[1][2] + p[1][3]));
        }
        if (MODE != 1) {
            u32x4 pk; pk.x = cvt_pk_bf16(p[0][0], p[0][1]); pk.y = cvt_pk_bf16(p[0][2], p[0][3]); pk.z = cvt_pk_bf16(p[1][0], p[1][1]); pk.w = cvt_pk_bf16(p[1][2], p[1][3]);
            Pf[nt] = __builtin_bit_cast(bf16x8, pk);
        }
        if (nt & 1) __builtin_amdgcn_sched_barrier(0);
    }
    __builtin_amdgcn_sched_barrier(0);
    if (MODE != 1) {
#pragma unroll
        for (int md = 0; md < 4; ++md) {
            typedef short s16x4 __attribute__((ext_vector_type(4)));
            const int key0 = hk * 32 + 4 * fq + (fr >> 2);
            const LAS unsigned char* vp = Vt + key0 * 128 + (((md * 2 + ((fr & 3) >> 1)) ^ (key0 & 7)) * 16) + (fr & 1) * 8;
            const s16x4 v0 = __builtin_amdgcn_ds_read_tr16_b64_v4i16((LAS s16x4*)vp), v1 = __builtin_amdgcn_ds_read_tr16_b64_v4i16((LAS s16x4*)(vp + 16 * 128));
            const bf16x8 Vf = {v0.x, v0.y, v0.z, v0.w, v1.x, v1.y, v1.z, v1.w};
#pragma unroll
            for (int nt = 0; nt < 4; ++nt) R.O[md][nt] = __builtin_amdgcn_mfma_f32_16x16x32_bf16(Vf, Pf[nt], R.O[md][nt], 0, 0, 0);
        }
    }
}

template <int MODE, bool USE_SEL>
__device__ __forceinline__ void attn_sweep(AttnRegs& R, LAS unsigned char* lds, TileGen tg, const ColCtx& cc, const float A, const float kstep,
                                           const int w, const int lane, const int fr, const int fq) {
    LAS unsigned char* Kb = lds + L_KV; LAS unsigned char* Vb = lds + L_KV + 2 * ATILE_BYTES;
    LAS float* impA = (LAS float*)(lds + L_IMPA); LAS float* impB = (LAS float*)(lds + L_IMPB);
    const LAS unsigned* selw = (const LAS unsigned*)(lds + L_SEL);
    TileD cur, nxt;
    if (!tg.next(cur)) return;
    stage_issue(cur, Kb, Vb, w, lane);
    asm volatile("s_waitcnt vmcnt(0)" ::: "memory");
    __syncthreads();
    int buf = 0;
    for (;;) {
        const bool hn = tg.next(nxt);
        if (hn) stage_issue(nxt, Kb + (buf ^ 1) * ATILE_BYTES, Vb + (buf ^ 1) * ATILE_BYTES, w, lane);
        unsigned enbits = 15u;
        if (USE_SEL) {
            enbits = 0u;
#pragma unroll
            for (int nt = 0; nt < 4; ++nt) { const int tt = cc.tt0 + 2 * nt; const unsigned sw = selw[2 * tt + (cur.j >> 5)]; enbits |= ((sw >> (cur.j & 31)) & 1u) << nt; }
        }
        if (__any(enbits != 0u)) {
            const LAS unsigned char* Kt = Kb + buf * ATILE_BYTES; const LAS unsigned char* Vt = Vb + buf * ATILE_BYTES;
            const float off = A * cur.offrel;
#pragma unroll 1
            for (int hk = 0; hk < 2; ++hk) attn_half<MODE>(R, Kt, Vt, hk, A, kstep, off, cur.mtype, 64 * cur.j, enbits, cc, fr, fq, impA, impB, cur.j * 16);
        }
        asm volatile("s_waitcnt vmcnt(0)" ::: "memory");
        __syncthreads();
        if (!hn) break;
        cur = nxt; buf ^= 1;
    }
}
__device__ __forceinline__ void attn_ltot(const AttnRegs& R, float (&lt)[4]) {
#pragma unroll
    for (int nt = 0; nt < 4; ++nt) { float l = R.l[nt]; l += __shfl_xor(l, 16); l += __shfl_xor(l, 32); lt[nt] = l; }
}
__device__ __forceinline__ void attn_store(const AttnRegs& R, const float (&sc)[4], bf16* obase, const ColCtx& cc, int fr, int fq, bool accumulate) {
    typedef unsigned u32x2 __attribute__((ext_vector_type(2)));
#pragma unroll
    for (int nt = 0; nt < 4; ++nt)
#pragma unroll
        for (int md = 0; md < 4; ++md) {
            f32x4 v = R.O[md][nt] * sc[nt];
            u32x2* p = (u32x2*)(obase + (size_t)(cc.tt0 + 2 * nt) * DM + (fr & 7) * 64 + md * 16 + 4 * fq);
            if (accumulate) { const unsigned long long ow = __hip_atomic_load((unsigned long long*)p, __ATOMIC_RELAXED, __HIP_MEMORY_SCOPE_AGENT); u32x2 old; old.x = (unsigned)ow; old.y = (unsigned)(ow >> 32); v.x += bf2f(old.x & 0xffffu); v.y += bf2f(old.x >> 16); v.z += bf2f(old.y & 0xffffu); v.w += bf2f(old.y >> 16); }
            u32x2 nw; nw.x = cvt_pk_bf16(v.x, v.y); nw.y = cvt_pk_bf16(v.z, v.w);
            *p = nw;
        }
}
__device__ __forceinline__ void attn_colctx(ColCtx& cc, int w, int fr, int t0) { cc.tt0 = 8 * w + (fr >> 3); cc.t0 = t0; }

__device__ __forceinline__ void win_unit(const Ctx& c, int L, int u) {
    const int tid = c.tid, lane = c.lane, w = c.wid, fr = lane & 15, fq = lane >> 4;
    const int cch = u & 63, g = (u >> 6) & 1, b = u >> 7, t0 = cch * 64;
    const bf16* pb = c.proj() + (size_t)b * SEQ * PP;
    AttnRegs R; attn_reset(R);
    attn_load_q(R, pb + (size_t)t0 * PP + C_QN + g * 512, w, fr, fq);
    ColCtx cc; attn_colctx(cc, w, fr, t0);
    const float A = 8.f * exp2f(-(float)(g * 8 + (fr & 7) + 1) * 0.5f);
    TileGen tg; tg.kind = 0; tg.c = cch; tg.j = cch - 8 < 0 ? 0 : cch - 8; tg.jend = cch; tg.jold = cch - 8; tg.rem = 0ull;
    tg.kb = pb + C_KV + 4 * 128 + g * 64; tg.vb = pb + C_KV + 5 * 128 + g * 64;
    attn_sweep<0, false>(R, c.lds, tg, cc, A, 1.f, w, lane, fr, fq);
    float lt[4], sc[4]; attn_ltot(R, lt);
#pragma unroll
    for (int nt = 0; nt < 4; ++nt) { const float gv = bf2f(pb[(size_t)(t0 + cc.tt0 + 2 * nt) * PP + C_GN + g * 24 + (fr & 7) * 3 + 2]); sc[nt] = sigmoidf(gv) / lt[nt]; }
    attn_store(R, sc, c.o() + ((size_t)b * SEQ + t0) * DM + 1024 + g * 512, cc, fr, fq, false);
}
__device__ __forceinline__ void swa_unit(const Ctx& c, int L, int u) {
    const int tid = c.tid, lane = c.lane, w = c.wid, fr = lane & 15, fq = lane >> 4;
    const int cch = u & 63, g = (u >> 6) & 1, b = u >> 7, t0 = cch * 64;
    const bf16* pb = c.proj() + (size_t)b * SEQ * PP;
    AttnRegs R; attn_reset(R);
    attn_load_q(R, pb + (size_t)t0 * PP + C_QA + g * 512, w, fr, fq);
    ColCtx cc; attn_colctx(cc, w, fr, t0);
    const int a = g * 8 + (fr & 7);
    const float A = 8.f * exp2f(-(float)(2 * a + 1) * 0.25f);
    const float sink8 = 8.f * c.sinks()[L * 16 + a];
#pragma unroll
    for (int nt = 0; nt < 4; ++nt) { R.m[nt] = sink8 + A * (float)(cc.tt0 + 2 * nt); R.l[nt] = fq == 0 ? 1.f : 0.f; }
    TileGen tg; tg.kind = 0; tg.c = cch; tg.j = cch - 2 < 0 ? 0 : cch - 2; tg.jend = cch; tg.jold = cch - 2; tg.rem = 0ull;
    tg.kb = pb + C_KA + g * 64; tg.vb = pb + C_VA + g * 64;
    attn_sweep<0, false>(R, c.lds, tg, cc, A, 1.f, w, lane, fr, fq);
    float lt[4], sc[4]; attn_ltot(R, lt);
#pragma unroll
    for (int nt = 0; nt < 4; ++nt) sc[nt] = 1.f / lt[nt];
    attn_store(R, sc, c.o() + ((size_t)b * SEQ + t0) * DM + g * 512, cc, fr, fq, false);
}
__device__ __forceinline__ void cmpslc_unit(const Ctx& c, int L, int u) {
    const int tid = c.tid, lane = c.lane, w = c.wid, fr = lane & 15, fq = lane >> 4;
    const int cch = u & 63, g = (u >> 6) & 1, b = u >> 7, t0 = cch * 64;
    const bf16* pb = c.proj() + (size_t)b * SEQ * PP;
    LAS float* impA = (LAS float*)(c.lds + L_IMPA); LAS float* impB = (LAS float*)(c.lds + L_IMPB);
    LAS unsigned* selw = (LAS unsigned*)(c.lds + L_SEL);
    AttnRegs R; attn_reset(R);
    attn_load_q(R, pb + (size_t)t0 * PP + C_QN + g * 512, w, fr, fq);
    ColCtx cc; attn_colctx(cc, w, fr, t0);
    const float A = 8.f * exp2f(-(float)(g * 8 + (fr & 7) + 1) * 0.5f);
    bf16* obase = c.o() + ((size_t)b * SEQ + t0) * DM + 1024 + g * 512;
    const bf16* gbase = pb + (size_t)t0 * PP + C_GN + g * 24 + (fr & 7) * 3;
    for (int i = lane; i < 8 * 64; i += 64) impA[(8 * w) * 64 + i] = 0.f;
    for (int i = lane; i < 8 * 65; i += 64) impB[(8 * w) * 65 + i] = 0.f;
    WAVE_LDS_FENCE();
    int ncl = 4 * cch + 2; if (ncl > NCMP - 1) ncl = NCMP - 1;
    TileGen tg; tg.kind = 2; tg.c = cch; tg.j = 0; tg.jend = ncl >> 6; tg.jold = -1; tg.rem = 0ull;
    tg.kb = c.kvc() + ((size_t)(b * NCMP) * 2 + g) * 64; tg.vb = c.kvc() + (size_t)2048 * 64 + ((size_t)(b * NCMP) * 2 + g) * 64;
    attn_sweep<1, false>(R, c.lds, tg, cc, A, 16.f, w, lane, fr, fq);
    { float lt[4]; attn_ltot(R, lt);
#pragma unroll
      for (int nt = 0; nt < 4; ++nt) R.m[nt] = lt[nt] > 0.f ? R.m[nt] + __builtin_amdgcn_logf(lt[nt]) * (1.f / C1) : -INFINITY; }
    attn_sweep<2, false>(R, c.lds, tg, cc, A, 16.f, w, lane, fr, fq);
    { float sc[4];
#pragma unroll
      for (int nt = 0; nt < 4; ++nt) sc[nt] = sigmoidf(bf2f(gbase[(size_t)(cc.tt0 + 2 * nt) * PP + 0]));
      attn_store(R, sc, obase, cc, fr, fq, true); }
    WAVE_LDS_FENCE();
    for (int i = 0; i < 8; ++i) {
        const int ti = 8 * w + i, j = lane;
        const float imp = impA[ti * 64 + j] + impB[ti * 65 + j];
        const bool forced = (j == 0) || (j == cch) || (j == cch - 1); const bool valid = j <= cch;
        const float score = valid ? (forced ? INFINITY : imp) : -INFINITY;
        int rank = 0;
        for (int k = 0; k < 64; ++k) { const float sk = __shfl(score, k); rank += ((sk > score) || (sk == score && k < lane)) ? 1 : 0; }
        const unsigned long long msk = __ballot((rank < 16) && (score > -INFINITY));
        if (lane == 0) { selw[2 * ti] = (unsigned)msk; selw[2 * ti + 1] = (unsigned)(msk >> 32); }
    }
    asm volatile("s_waitcnt vmcnt(0) lgkmcnt(0)" ::: "memory");
    __syncthreads();
    unsigned ulo = selw[2 * lane], uhi = selw[2 * lane + 1];
#pragma unroll
    for (int o = 1; o < 64; o <<= 1) { ulo |= __shfl_xor(ulo, o); uhi |= __shfl_xor(uhi, o); }
    const unsigned long long uni = ((unsigned long long)__builtin_amdgcn_readfirstlane(uhi) << 32) | (unsigned long long)__builtin_amdgcn_readfirstlane(ulo);
    attn_reset(R);
    tg.kind = 1; tg.rem = uni; tg.j = 0; tg.jend = -1; tg.jold = -1;
    tg.kb = pb + C_KV + 2 * 128 + g * 64; tg.vb = pb + C_KV + 3 * 128 + g * 64;
    attn_sweep<0, true>(R, c.lds, tg, cc, A, 1.f, w, lane, fr, fq);
    { float lt[4], sc[4]; attn_ltot(R, lt);
#pragma unroll
      for (int nt = 0; nt < 4; ++nt) sc[nt] = sigmoidf(bf2f(gbase[(size_t)(cc.tt0 + 2 * nt) * PP + 1])) / lt[nt];
      asm volatile("s_waitcnt vmcnt(0)" ::: "memory");
      attn_store(R, sc, obase, cc, fr, fq, true); }
    __syncthreads();
}

#define EPI_LOOP for (int m = 0; m < 4; ++m) for (int n = 0; n < 2; ++n) for (int j = 0; j < 4; ++j)
struct EpiProj { bf16* proj; const float* bias; int row0, col0;
    __device__ __forceinline__ void operator()(const f32x4 (&acc)[4][2], int wr, int wc, int fr, int fq) const {
#pragma unroll
        for (int m = 0; m < 4; ++m)
#pragma unroll
            for (int n = 0; n < 2; ++n)
#pragma unroll
                for (int j = 0; j < 4; ++j) { const int r = row0 + wr * 64 + m * 16 + fq * 4 + j, cc = col0 + wc * 32 + n * 16 + fr;
                    const float v = cc < INC ? acc[m][n][j] + bias[cc] : 0.f; proj[(size_t)r * PP + cc] = f2bf(v); } } };
struct EpiCmp1 { float* hb; int row0, col0;
    __device__ __forceinline__ void operator()(const f32x4 (&acc)[4][2], int wr, int wc, int fr, int fq) const {
#pragma unroll
        for (int m = 0; m < 4; ++m)
#pragma unroll
            for (int n = 0; n < 2; ++n)
#pragma unroll
                for (int j = 0; j < 4; ++j) { const int r = row0 + wr * 64 + m * 16 + fq * 4 + j, cc = col0 + wc * 32 + n * 16 + fr;
                    hb[(size_t)r * 256 + cc] = gelu_tanh(acc[m][n][j]); } } };
struct EpiCmp2 { bf16* kvc; int row0;
    __device__ __forceinline__ void operator()(const f32x4 (&acc)[4][2], int wr, int wc, int fr, int fq) const {
#pragma unroll
        for (int m = 0; m < 4; ++m)
#pragma unroll
            for (int n = 0; n < 2; ++n)
#pragma unroll
                for (int j = 0; j < 4; ++j) { const int r = row0 + wr * 64 + m * 16 + fq * 4 + j, cc = wc * 32 + n * 16 + fr;
                    if (cc < 64) kvc[(size_t)r * 64 + cc] = f2bf(acc[m][n][j]); } } };
struct EpiOut { float* y; const float* bias; const float* xres; int row0, col0;
    __device__ __forceinline__ void operator()(const f32x4 (&acc)[4][2], int wr, int wc, int fr, int fq) const {
#pragma unroll
        for (int m = 0; m < 4; ++m)
#pragma unroll
            for (int n = 0; n < 2; ++n)
#pragma unroll
                for (int j = 0; j < 4; ++j) { const int r = row0 + wr * 64 + m * 16 + fq * 4 + j, cc = col0 + wc * 32 + n * 16 + fr;
                    y[(size_t)r * DM + cc] = acc[m][n][j] + bias[cc] + ALPHA * xres[(size_t)r * DM + cc]; } } };
struct EpiLogit { float* lg; const float* bg; const float* be; int row0;
    __device__ __forceinline__ void operator()(const f32x4 (&acc)[4][2], int wr, int wc, int fr, int fq) const {
#pragma unroll
        for (int m = 0; m < 4; ++m)
#pragma unroll
            for (int n = 0; n < 2; ++n)
#pragma unroll
                for (int j = 0; j < 4; ++j) { const int r = row0 + wr * 64 + m * 16 + fq * 4 + j, cc = wc * 32 + n * 16 + fr;
                    if (cc < 72) lg[(size_t)r * NLOG + cc] = acc[m][n][j] + (cc < 8 ? bg[cc] : be[cc - 8]); } } };
struct EpiMoe1 { bf16* H; int rowbase, cnt, rt, ct;
    __device__ __forceinline__ void operator()(const f32x4 (&acc)[4][2], int wr, int wc, int fr, int fq) const {
#pragma unroll
        for (int m = 0; m < 4; ++m)
#pragma unroll
            for (int j = 0; j < 4; ++j) { const int pos = rt * 128 + wr * 64 + m * 16 + fq * 4 + j;
                if (pos < cnt) { const float gv = acc[m][0][j], uv = acc[m][1][j]; const float hv = gv / (1.f + expf(-gv)) * uv;
                    H[(size_t)(rowbase + pos) * EH + ct * 64 + wc * 16 + fr] = f2bf(hv); } } } };
struct EpiMoe2 { float* contrib; const int* lslot; const float* lw; int cnt, rt, col0;
    __device__ __forceinline__ void operator()(const f32x4 (&acc)[4][2], int wr, int wc, int fr, int fq) const {
#pragma unroll
        for (int m = 0; m < 4; ++m)
#pragma unroll
            for (int j = 0; j < 4; ++j) { const int pos = rt * 128 + wr * 64 + m * 16 + fq * 4 + j;
                if (pos < cnt) { const int slot = lslot[pos]; const float w = lw[pos];
#pragma unroll
                    for (int n = 0; n < 2; ++n) contrib[(size_t)slot * DM + col0 + wc * 32 + n * 16 + fr] = acc[m][n][j] * w; } } } };

__device__ __forceinline__ void p0_transpose_item(const float* W, int K, int ldw, int N, bf16* WT, LAS float* scr, int item, int lane) {
    const int nblk = N / 32, kb = item / nblk, nb = item % nblk, k0 = 64 * kb, n0 = 32 * nb;
#pragma unroll 8
    for (int i = 0; i < 32; ++i) { const int kk = 2 * i + (lane >> 5); scr[kk * 33 + (lane & 31)] = W[(size_t)(k0 + kk) * ldw + n0 + (lane & 31)]; }
    WAVE_LDS_FENCE();
    const int ch = lane & 7;
#pragma unroll
    for (int j = 0; j < 4; ++j) { const int n = (lane >> 3) + 8 * j; const LAS float* s = scr + (8 * ch) * 33 + n;
        u32x4 o; o.x = cvt_pk_bf16(s[0 * 33], s[1 * 33]); o.y = cvt_pk_bf16(s[2 * 33], s[3 * 33]); o.z = cvt_pk_bf16(s[4 * 33], s[5 * 33]); o.w = cvt_pk_bf16(s[6 * 33], s[7 * 33]);
        *(u32x4*)(WT + (size_t)(n0 + n) * K + k0 + 8 * ch) = o; }
    WAVE_LDS_FENCE();
}
__device__ __forceinline__ void ph_prologue(const Ctx& c) {
    LAS float* scr = (LAS float*)(c.lds + c.wid * 16384);
    const int gw = blockIdx.x * 8 + c.wid, NGW = gridDim.x * 8;
    constexpr int I_IN = (DM / 64) * (3072 / 32), I_OUT = (DM / 64) * (DM / 32);
    for (int it = gw; it < DEPTH * (I_IN + I_OUT); it += NGW) {
        int r = it; const int L = r / (I_IN + I_OUT); r -= L * (I_IN + I_OUT);
        if (r < I_IN) p0_transpose_item(c.w_in() + (size_t)L * DM * INC, DM, INC, 3072, c.wint() + (size_t)L * 3072 * DM, scr, r, c.lane);
        else p0_transpose_item(c.w_out() + (size_t)L * DM * DM, DM, DM, DM, c.wot() + (size_t)L * DM * DM, scr, r - I_IN, c.lane);
    }
    for (int m = gw; m < MTOK; m += NGW) {
        const f32x4* xr = (const f32x4*)(c.x_in() + (size_t)m * DM) + c.lane; unsigned long long* o8 = (unsigned long long*)(c.xb() + (size_t)m * DM) + c.lane;
#pragma unroll
        for (int j = 0; j < 8; ++j) { const f32x4 v = xr[64 * j]; o8[64 * j] = (unsigned long long)cvt_pk_bf16(v.x, v.y) | ((unsigned long long)cvt_pk_bf16(v.z, v.w) << 32); }
    }
}
__device__ __forceinline__ void ph_inproj(const Ctx& c, int L, const float* xin) {
    {
        pg8::Gemm g{c.xb(), c.wint() + (size_t)L * 3072 * DM, MTOK, 3072, DM}; pg8::StaticOrder S; S.init(MTOK, 3072, (int)gridDim.x, (int)blockIdx.x);
        pg8::EpiBf16<0> E{c.proj(), PP, c.b_in() + L * INC, 0, 0, 1.f};
        pg8::gemm_phase<pg8::EpiBf16<0>, pg8::StaticOrder, true, true>(c.lds, g, S, E);
    }
    const float* W = c.w_in() + (size_t)L * DM * INC; const float* bias = c.b_in() + L * INC;
    const int ar = c.tid >> 2, bn = c.tid & 127;
    for (int u = blockIdx.x; u < 128; u += gridDim.x) {
        ALf32 al{xin + (size_t)(u * 128 + ar) * DM};
        const int col = 3072 + bn;
        BLf32 bl{col < INC ? W + col : nullptr, (size_t)INC};
        EpiProj ep{c.proj(), bias, u * 128, 3072};
        gemm_tile(c.lds, al, bl, ep, DM);
    }
}
__device__ __forceinline__ void ph_cmp1_swa(const Ctx& c, int L) {
    const int ar = c.tid >> 2, bn = c.tid & 127;
    for (int u = blockIdx.x; u < 64; u += gridDim.x) {
        const int which = u >> 5, rt = (u >> 1) & 15, ct = u & 1;
        const int r = rt * 128 + ar;
        const bf16* base = nullptr;
        if (r < CMPROWS) { const int g = r & 1, bn_ = r >> 1, n = bn_ % NCMP, b = bn_ / NCMP;
            base = c.proj() + ((size_t)b * SEQ + 16 * n) * PP + C_KV + which * 128 + g * 64; }
        ALcmp al{base, (which ? c.pe_v() : c.pe_k()) + (size_t)L * 2048};
        BLf32 bl{(which ? c.w1_v() : c.w1_k()) + (size_t)L * 2048 * 256 + ct * 128 + bn, (size_t)256};
        EpiCmp1 ep{c.hb() + (size_t)which * 2048 * 256, rt * 128, ct * 128};
        gemm_tile(c.lds, al, bl, ep, 2048);
    }
    __syncthreads();
    for (int u = blockIdx.x; u < NB * 2 * 64; u += gridDim.x) win_unit(c, L, u);
    for (int u = blockIdx.x; u < NB * 2 * 64; u += gridDim.x) swa_unit(c, L, u);
}
__device__ __forceinline__ void ph_cmp2(const Ctx& c, int L) {
    const int ar = c.tid >> 2, bn = c.tid & 127;
    for (int u = blockIdx.x; u < 32; u += gridDim.x) {
        const int which = u >> 4, rt = u & 15;
        ALf32 al{c.hb() + (size_t)which * 2048 * 256 + (size_t)(rt * 128 + ar) * 256};
        BLf32 bl{bn < 64 ? (which ? c.w2_v() : c.w2_k()) + (size_t)L * 256 * 64 + bn : nullptr, (size_t)64};
        EpiCmp2 ep{c.kvc() + (size_t)which * 2048 * 64, rt * 128};
        gemm_tile(c.lds, al, bl, ep, 256);
    }
}
__device__ __forceinline__ void ph_nsa(const Ctx& c, int L) {
    for (int i = blockIdx.x; i < NB * 2 * 64; i += gridDim.x) {
        const int r = i >> 8, q = i & 255, bg = q >> 5, ci = q & 31;
        cmpslc_unit(c, L, bg * 64 + (r ? 63 - ci : ci));
    }
}
__device__ __forceinline__ void ph_outproj(const Ctx& c, int L, const float* xin) {
    pg8::Gemm g{c.o(), c.wot() + (size_t)L * DM * DM, MTOK, DM, DM}; pg8::StaticOrder S; S.init(MTOK, DM, (int)gridDim.x, (int)blockIdx.x);
    pg8::EpiF32Res E{c.y(), xin, c.b_out() + L * DM, DM, ALPHA};
    pg8::gemm_phase<pg8::EpiF32Res, pg8::StaticOrder, true, true>(c.lds, g, S, E);
}
__device__ __forceinline__ void ph_ln(const Ctx& c, const float* src, float sscale, const float* add, float* dst, const float* gam, const float* bet, bf16* dstb) {
    const int lane = c.lane;
    for (int r = blockIdx.x * 8 + c.wid; r < MTOK; r += gridDim.x * 8) {
        const f32x4* sp = (const f32x4*)(src + (size_t)r * DM) + lane;
        f32x4 v[8]; float s = 0.f;
#pragma unroll
        for (int j = 0; j < 8; ++j) { v[j] = sp[64 * j] * sscale; }
        if (add) {
            const f32x4* a0 = (const f32x4*)(add + (size_t)(2 * r) * DM) + lane; const f32x4* a1 = (const f32x4*)(add + (size_t)(2 * r + 1) * DM) + lane;
#pragma unroll
            for (int j = 0; j < 8; ++j) v[j] = v[j] + (a0[64 * j] + a1[64 * j]);
        }
#pragma unroll
        for (int j = 0; j < 8; ++j) s += (v[j].x + v[j].y) + (v[j].z + v[j].w);
        const float mean = wave_sum(s) * (1.f / DM); float s2 = 0.f;
#pragma unroll
        for (int j = 0; j < 8; ++j) { v[j] = v[j] - mean; s2 += (v[j].x * v[j].x + v[j].y * v[j].y) + (v[j].z * v[j].z + v[j].w * v[j].w); }
        const float rstd = 1.f / sqrtf(wave_sum(s2) * (1.f / DM) + LN_EPS);
        f32x4* dp = (f32x4*)(dst + (size_t)r * DM) + lane; const f32x4* gp = (const f32x4*)gam + lane; const f32x4* bp = (const f32x4*)bet + lane;
#pragma unroll
        for (int j = 0; j < 8; ++j) { v[j] = v[j] * rstd * gp[64 * j] + bp[64 * j]; dp[64 * j] = v[j]; }
        if (dstb) { unsigned long long* o8 = (unsigned long long*)(dstb + (size_t)r * DM) + lane;
#pragma unroll
            for (int j = 0; j < 8; ++j) o8[64 * j] = (unsigned long long)cvt_pk_bf16(v[j].x, v[j].y) | ((unsigned long long)cvt_pk_bf16(v[j].z, v[j].w) << 32); }
    }
}
__device__ __forceinline__ void ph_router(const Ctx& c, int L) {
    const int ar = c.tid >> 2, bn = c.tid & 127;
    const float* colp = nullptr; size_t ldb = 8;
    if (bn < 8) { colp = c.w_group() + (size_t)L * DM * 8 + bn; ldb = 8; } else if (bn < 72) { colp = c.w_expert() + (size_t)L * DM * 64 + (bn - 8); ldb = 64; }
    for (int u = blockIdx.x; u < 128; u += gridDim.x) {
        ALf32 al{c.x1() + (size_t)(u * 128 + ar) * DM};
        BLf32 bl{colp, ldb};
        EpiLogit ep{c.logits(), c.b_group() + L * 8, c.b_expert() + L * 64, u * 128};
        gemm_tile(c.lds, al, bl, ep, DM);
    }
}
__device__ __forceinline__ void ph_route(const Ctx& c, int L) {
    unsigned* cnt = c.cnt() + L * 64;
    for (int tok = blockIdx.x * 512 + c.tid; tok < MTOK; tok += gridDim.x * 512) {
        const float* lg = c.logits() + (size_t)tok * NLOG;
        float gl[8];
#pragma unroll
        for (int i = 0; i < 8; ++i) gl[i] = lg[i];
        int gs = 0; float gm = gl[0];
#pragma unroll
        for (int i = 1; i < 8; ++i) if (gl[i] > gm) { gm = gl[i]; gs = i; }
        float gsum = 0.f;
#pragma unroll
        for (int i = 0; i < 8; ++i) gsum += expf(gl[i] - gm);
        const float gw = 1.f / gsum;
        float el[8];
#pragma unroll
        for (int i = 0; i < 8; ++i) el[i] = lg[8 + gs * 8 + i];
        int i0 = 0; float v0 = el[0];
#pragma unroll
        for (int i = 1; i < 8; ++i) if (el[i] > v0) { v0 = el[i]; i0 = i; }
        int i1 = -1; float v1 = -INFINITY;
#pragma unroll
        for (int i = 0; i < 8; ++i) if (i != i0 && el[i] > v1) { v1 = el[i]; i1 = i; }
        const float e1 = expf(v1 - v0);
        const float w0 = gw / (1.f + e1), w1 = gw * e1 / (1.f + e1);
        const int ea = gs * 8 + i0, eb = gs * 8 + i1;
        const unsigned pa = atomicAdd(&cnt[ea], 1u); c.lslot()[(size_t)ea * LCAP + pa] = tok * 2; c.lw()[(size_t)ea * LCAP + pa] = w0;
        const unsigned pb = atomicAdd(&cnt[eb], 1u); c.lslot()[(size_t)eb * LCAP + pb] = tok * 2 + 1; c.lw()[(size_t)eb * LCAP + pb] = w1;
    }
}
__device__ __forceinline__ void moe_tables(const Ctx& c, int L) {
    LAS int* tab = (LAS int*)(c.lds + L_TAB);
    __syncthreads();
    if (c.tid < 64) tab[c.tid] = (int)c.cnt()[L * 64 + c.tid];
    __syncthreads();
    if (c.tid == 0) { int rb = 0, tb = 0; for (int e = 0; e < 64; ++e) { tab[64 + e] = rb; tab[128 + e] = tb; rb += tab[e]; tb += (tab[e] + 127) >> 7; } tab[192] = tb; }
    __syncthreads();
}
__device__ __forceinline__ int moe_find(const LAS int* tab, int rtg) { int e = 0; for (int i = 1; i < 64; ++i) if (tab[128 + i] <= rtg) e = i; return e; }
__device__ __forceinline__ void ph_moe1(const Ctx& c, int L) {
    moe_tables(c, L);
    const LAS int* tab = (const LAS int*)(c.lds + L_TAB);
    const int ar = c.tid >> 2, bn = c.tid & 127;
    const int ntile = tab[192];
    for (int u = blockIdx.x; u < ntile * 8; u += gridDim.x) {
        const int rtg = u >> 3, ct = u & 7; const int e = moe_find(tab, rtg); const int rt = rtg - tab[128 + e], cnt = tab[e], rowbase = tab[64 + e];
        const int pos = rt * 128 + ar;
        const float* rowp = nullptr;
        if (pos < cnt) { const int slot = c.lslot()[(size_t)e * LCAP + pos]; rowp = c.x1() + (size_t)(slot >> 1) * DM; }
        ALf32 al{rowp};
        const int wcv = bn >> 5, nsel = (bn >> 4) & 1, cc = bn & 15; const int hcol = ct * 64 + wcv * 16 + cc;
        const float* Wsel = (nsel ? c.we_up() : c.we_gate()) + ((size_t)L * NE + e) * DM * EH;
        BLf32 bl{Wsel + hcol, (size_t)EH};
        EpiMoe1 ep{c.H(), rowbase, cnt, rt, ct};
        gemm_tile(c.lds, al, bl, ep, DM);
    }
}
__device__ __forceinline__ void ph_moe2(const Ctx& c, int L) {
    moe_tables(c, L);
    const LAS int* tab = (const LAS int*)(c.lds + L_TAB);
    const int ar = c.tid >> 2, bn = c.tid & 127;
    const int ntile = tab[192];
    for (int u = blockIdx.x; u < ntile * 16; u += gridDim.x) {
        const int rtg = u >> 4, ct = u & 15; const int e = moe_find(tab, rtg); const int rt = rtg - tab[128 + e], cnt = tab[e], rowbase = tab[64 + e];
        const int pos = rt * 128 + ar;
        ALbf16 al{pos < cnt ? c.H() + (size_t)(rowbase + pos) * EH : nullptr};
        BLf32 bl{c.we_down() + ((size_t)L * NE + e) * EH * DM + ct * 128 + bn, (size_t)DM};
        EpiMoe2 ep{c.contrib(), c.lslot() + (size_t)e * LCAP, c.lw() + (size_t)e * LCAP, cnt, rt, ct * 128};
        gemm_tile(c.lds, al, bl, ep, EH);
    }
}

__global__ void __launch_bounds__(512, 2) fwd(Args a) {
    extern __shared__ __attribute__((aligned(16))) unsigned char smem[];
    unsigned char* ws = a.ws;
    const int tid0 = threadIdx.x;
    volatile LAS unsigned* barw = (volatile LAS unsigned*)((LAS unsigned char*)smem + L_BARW);
    if (tid0 < 4) barw[tid0] = 0u;
    __syncthreads();
    const int lo = a.lo, hi = a.hi;
    XcdBarrier bar; bar.bar = (unsigned*)(ws + WS_CTL) + CW_BAR; bar.x = 0; bar.st = barw;
    if (hi - lo > 1) bar = xcd_barrier_post((unsigned*)(ws + WS_CTL) + CW_BAR, barw);
#ifndef PHMASK
#define PHMASK 0x7ff
#endif
#define IN(k) (((PHMASK >> ((k) % NPH)) & 1) && lo <= (k) && (k) < hi)
#ifndef DUPMASK
#define DUPMASK 0
#endif
#define DUP(k) ((DUPMASK >> ((k) % NPH)) & 1)
#define SEAM(k) do { if ((k) + 1 < hi) xcd_barrier(bar); } while (0)
#define PCTX() Ctx c; { int t_ = threadIdx.x; asm volatile("" : "+v"(t_)); c.tid = t_; c.lane = t_ & 63; c.wid = __builtin_amdgcn_readfirstlane(t_ >> 6); c.lds = (LAS unsigned char*)smem; c.a = &a; }
#define LAYER_BODY(L) { const int pb = (L) * NPH; \
        if (IN(pb + 0)) { PCTX(); ph_inproj(c, L, L == 0 ? c.x_in() : c.x2()); if (DUP(0)) { ph_inproj(c, L, L == 0 ? c.x_in() : c.x2()); } SEAM(pb + 0); } \
        if (IN(pb + 1)) { PCTX(); ph_cmp1_swa(c, L); if (DUP(1)) { ph_cmp1_swa(c, L); } SEAM(pb + 1); } \
        if (IN(pb + 2)) { PCTX(); ph_cmp2(c, L); if (DUP(2)) { ph_cmp2(c, L); } SEAM(pb + 2); } \
        if (IN(pb + 3)) { PCTX(); ph_nsa(c, L); if (DUP(3)) { ph_nsa(c, L); } SEAM(pb + 3); } \
        if (IN(pb + 4)) { PCTX(); ph_outproj(c, L, L == 0 ? c.x_in() : c.x2()); if (DUP(4)) { ph_outproj(c, L, L == 0 ? c.x_in() : c.x2()); } SEAM(pb + 4); } \
        if (IN(pb + 5)) { PCTX(); ph_ln(c, c.y(), 1.f, nullptr, c.x1(), c.ln1_g() + L * DM, c.ln1_b() + L * DM, nullptr); if (DUP(5)) { ph_ln(c, c.y(), 1.f, nullptr, c.x1(), c.ln1_g() + L * DM, c.ln1_b() + L * DM, nullptr); } SEAM(pb + 5); } \
        if (IN(pb + 6)) { PCTX(); ph_router(c, L); if (DUP(6)) { ph_router(c, L); } SEAM(pb + 6); } \
        if (IN(pb + 7)) { PCTX(); ph_route(c, L); if (DUP(7)) { ph_route(c, L); } SEAM(pb + 7); } \
        if (IN(pb + 8)) { PCTX(); ph_moe1(c, L); if (DUP(8)) { ph_moe1(c, L); } SEAM(pb + 8); } \
        if (IN(pb + 9)) { PCTX(); ph_moe2(c, L); if (DUP(9)) { ph_moe2(c, L); } SEAM(pb + 9); } \
        if (IN(pb + 10)) { PCTX(); ph_ln(c, c.x1(), ALPHA, c.contrib(), L == DEPTH - 1 ? c.out() : c.x2(), c.ln2_g() + L * DM, c.ln2_b() + L * DM, L == DEPTH - 1 ? nullptr : c.xb()); if (DUP(10)) { ph_ln(c, c.x1(), ALPHA, c.contrib(), L == DEPTH - 1 ? c.out() : c.x2(), c.ln2_g() + L * DM, c.ln2_b() + L * DM, L == DEPTH - 1 ? nullptr : c.xb()); } SEAM(pb + 10); } \
    }
    if (lo <= 0) { PCTX(); ph_prologue(c); if (hi > 0) xcd_barrier(bar); }
    LAYER_BODY(0)
    LAYER_BODY(1)
#undef IN
#undef SEAM
}

extern "C" void kernel_launch(void* const* d_in, const int* in_sizes, int n_in, void* d_out, int out_size, void* d_ws, size_t ws_size, hipStream_t stream) {
    static int grid = 0;
    if (grid == 0) {
        if (n_in != 23 || out_size != MTOK * DM || ws_size < WS_END) { fprintf(stderr, "kernel_launch: unexpected shapes (n_in %d out %d ws %zu)\n", n_in, out_size, ws_size); grid = -1; return; }
        int dev = 0, cus = 0;
        if (hipGetDevice(&dev) != hipSuccess || hipDeviceGetAttribute(&cus, hipDeviceAttributeMultiprocessorCount, dev) != hipSuccess) { grid = -1; return; }
        if (hipFuncSetAttribute((const void*)fwd, hipFuncAttributeMaxDynamicSharedMemorySize, LDS_BYTES) != hipSuccess) { fprintf(stderr, "kernel_launch: hipFuncSetAttribute failed\n"); grid = -1; return; }
        int per_cu = 0;
        (void)hipOccupancyMaxActiveBlocksPerMultiprocessor(&per_cu, (const void*)fwd, 512, LDS_BYTES);
        (void)hipGetLastError();
        grid = cus;
    }
    if (grid < 0) return;
    (void)hipMemsetAsync((char*)d_ws + WS_CTL, 0, CTL_BYTES, stream);
    Args a{};
    for (int i = 0; i < 23; ++i) a.in[i] = (const float*)d_in[i];
    a.out = (float*)d_out; a.ws = (unsigned char*)d_ws;
#if ONE_LAUNCH
    a.lo = 0; a.hi = DEPTH * NPH;
    hipLaunchKernelGGL(fwd, dim3(grid), dim3(512), LDS_BYTES, stream, a);
#else
    for (int k = 0; k < DEPTH * NPH; ++k) { a.lo = k; a.hi = k + 1; hipLaunchKernelGGL(fwd, dim3(grid), dim3(512), LDS_BYTES, stream, a); }
#endif
}
```

```cpp
#include <hip/hip_runtime.h>
#include <cstdio>
#include <cstdint>
#include <cmath>

#ifndef ONE_LAUNCH
#define ONE_LAUNCH 1
#endif


#define LAS __attribute__((address_space(3)))
typedef unsigned short bf16;
typedef short bf16x8 __attribute__((ext_vector_type(8)));
typedef float f32x4 __attribute__((ext_vector_type(4)));
typedef unsigned u32x4 __attribute__((ext_vector_type(4)));

constexpr int DM = 2048, SEQ = 4096, NB = 4, MTOK = NB * SEQ, DEPTH = 2;
constexpr int INC = 3120, PP = 3200;
constexpr int C_QA = 0, C_KA = 1024, C_VA = 1152, C_QN = 1280, C_KV = 2304, C_GN = 3072;
constexpr int NCMP = 255, CMPROWS = NB * NCMP * 2;
constexpr int NE = 64, EH = 512, LCAP = MTOK;
constexpr int NLOG = 80;
constexpr float ALPHA = 1.41421356237309515f;
constexpr float LN_EPS = 1e-5f;
constexpr int NPH = 11;

constexpr size_t MiB = 1u << 20;
constexpr size_t WS_CTL = 0, CTL_BYTES = 1 * MiB;
constexpr size_t WS_PROJ = 2 * MiB;
constexpr size_t WS_O = 102 * MiB;
constexpr size_t WS_Y = 166 * MiB;
constexpr size_t WS_X1 = 294 * MiB;
constexpr size_t WS_X2 = 422 * MiB;
constexpr size_t WS_HB = 550 * MiB;
constexpr size_t WS_KVC = 554 * MiB;
constexpr size_t WS_LOG = 555 * MiB;
constexpr size_t WS_LSLOT = 561 * MiB;
constexpr size_t WS_LW = 565 * MiB;
constexpr size_t WS_H = 569 * MiB;
constexpr size_t WS_CONTRIB = 601 * MiB;
constexpr size_t WS_WINT = 857 * MiB;
constexpr size_t WS_WOT = 881 * MiB;
constexpr size_t WS_XB = 897 * MiB;
constexpr size_t WS_X1B = 961 * MiB;
constexpr size_t WS_END = 1025 * MiB;
constexpr int CW_BAR = 4096;
constexpr int CW_CNT = 16384;

constexpr int L_GEMM = 0;
constexpr int L_KV = 32768;
constexpr int L_IMPA = 65536;
constexpr int L_IMPB = 81920;
constexpr int L_SEL = 98560;
constexpr int L_TAB = 131072;
constexpr int L_BARW = 132096;
constexpr int LDS_BYTES = 135168;

__device__ __forceinline__ float bf2f(unsigned h) { return __uint_as_float(h << 16); }
__device__ __forceinline__ unsigned cvt_pk_bf16(float lo, float hi) { unsigned r; asm("v_cvt_pk_bf16_f32 %0, %1, %2" : "=v"(r) : "v"(lo), "v"(hi)); return r; }
__device__ __forceinline__ bf16 f2bf(float f) { return (bf16)(cvt_pk_bf16(f, 0.f) & 0xffffu); }
__device__ __forceinline__ float wave_sum(float v) {
#pragma unroll
    for (int o = 1; o < 64; o <<= 1) v += __shfl_xor(v, o);
    return v;
}
__device__ __forceinline__ float wave_max(float v) {
#pragma unroll
    for (int o = 1; o < 64; o <<= 1) v = fmaxf(v, __shfl_xor(v, o));
    return v;
}
__device__ __forceinline__ float gelu_tanh(float x) {
    const float u = 0.7978845608028654f * (x + 0.044715f * x * x * x);
    const float e = expf(2.f * u);
    const float th = 1.f - 2.f / (e + 1.f);
    return 0.5f * x * (1.f + th);
}
__device__ __forceinline__ float sigmoidf(float x) { return 1.f / (1.f + expf(-x)); }
__device__ __forceinline__ float rfl(float v) { return __builtin_bit_cast(float, __builtin_amdgcn_readfirstlane(__builtin_bit_cast(int, v))); }
#define WAVE_LDS_FENCE() do { asm volatile("s_waitcnt lgkmcnt(0)" ::: "memory"); __builtin_amdgcn_wave_barrier(); } while (0)

#define XB_TMO      128
#define XB_XCNT(j)  (256  + 64 * (j))
#define XB_XSUB(j)  (1280 + 64 * (j))
#define XB_XGEN(j)  (2304 + 64 * (j))
#define XB_TOP      3328
#define XB_TOPGEN   3392
#define XCD_BAR_WORDS 3456
#define XB_SPIN_CAP (1u << 24)

__device__ __forceinline__ unsigned xb_ld(unsigned* p)              { return __hip_atomic_load(p, __ATOMIC_RELAXED, __HIP_MEMORY_SCOPE_AGENT); }
__device__ __forceinline__ unsigned xb_add(unsigned* p, unsigned v) { return __hip_atomic_fetch_add(p, v, __ATOMIC_RELAXED, __HIP_MEMORY_SCOPE_AGENT); }
__device__ __forceinline__ unsigned xb_xcc_id() { return (unsigned)__builtin_amdgcn_s_getreg((3 << 11) | 20) & 0xFu; }
#define XB_SPIN(cond, bar) do { unsigned _sp = 0; while (cond) { __builtin_amdgcn_s_sleep(1); \
    if ((++_sp & 255u) == 0u) { if (xb_ld(&(bar)[XB_TMO])) break; if (_sp > XB_SPIN_CAP) { atomicAdd(&(bar)[XB_TMO], 1u); break; } } } } while (0)

struct XcdBarrier { unsigned* bar; unsigned x; volatile LAS unsigned* st; };

__device__ __forceinline__ XcdBarrier xcd_barrier_post(unsigned* bar, volatile LAS unsigned* st) {
    XcdBarrier b; b.bar = bar; b.x = xb_xcc_id(); b.st = st;
    if (threadIdx.x == 0) (void)xb_add(&bar[XB_XCNT(b.x)], 1u);
    return b;
}
__device__ __forceinline__ void xcd_barrier_complete(unsigned* bar, unsigned x, unsigned& nloc, unsigned& nx) {
    const unsigned G = gridDim.x * gridDim.y * gridDim.z;
    unsigned sum, cnt, mine, sp = 0u;
    for (;;) {
        sum = 0u; cnt = 0u; mine = 0u;
#pragma unroll
        for (unsigned j = 0; j < 16; ++j) { const unsigned c = xb_ld(&bar[XB_XCNT(j)]); sum += c; cnt += (c > 0u) ? 1u : 0u; mine = (j == x) ? c : mine; }
        if (sum == G) break;
        __builtin_amdgcn_s_sleep(1);
        if ((++sp & 255u) == 0u) { if (xb_ld(&bar[XB_TMO])) break; if (sp > XB_SPIN_CAP) { atomicAdd(&bar[XB_TMO], 1u); break; } }
    }
    nloc = mine > 0u ? mine : 1u; nx = cnt > 0u ? cnt : 1u;
}
__device__ __forceinline__ void xcd_barrier(const XcdBarrier& b) {
    asm volatile("s_waitcnt vmcnt(0)" ::: "memory");
    __syncthreads();
    if (threadIdx.x == 0) {
        unsigned* bar = b.bar;
        __builtin_amdgcn_s_waitcnt(0);
        unsigned nloc = b.st[0], nx = b.st[1];
        if (nloc == 0u) { xcd_barrier_complete(bar, b.x, nloc, nx); b.st[0] = nloc; b.st[1] = nx; }
        const unsigned old = xb_add(&bar[XB_XSUB(b.x)], 1u);
        const unsigned gen = old / nloc;
        if (old + 1u == (gen + 1u) * nloc) {
            __builtin_amdgcn_fence(__ATOMIC_RELEASE, "agent");
            asm volatile("s_waitcnt vmcnt(0)" ::: "memory");
            const unsigned og = xb_add(&bar[XB_TOP], 1u);
            const unsigned tg = og / nx;
            if (og + 1u == (tg + 1u) * nx) xb_add(&bar[XB_TOPGEN], 1u);
            else XB_SPIN(xb_ld(&bar[XB_TOPGEN]) == tg, bar);
            __builtin_amdgcn_fence(__ATOMIC_ACQUIRE, "agent");
            xb_add(&bar[XB_XGEN(b.x)], 1u);
            asm volatile("s_waitcnt vmcnt(0)" ::: "memory");
        } else {
            XB_SPIN(xb_ld(&bar[XB_XGEN(b.x)]) == gen, bar);
            __builtin_amdgcn_fence(__ATOMIC_ACQUIRE, "agent");
            asm volatile("s_waitcnt vmcnt(0)" ::: "memory");
        }
    }
    __syncthreads();
}

template <class AL, class BL, class EP>
__device__ __forceinline__ void gemm_tile(LAS unsigned char* lds, const AL& al, const BL& bl, const EP& ep, int K) {
    const int tid = threadIdx.x, wid = tid >> 6, lane = tid & 63, wr = wid >> 2, wc = wid & 3, fr = lane & 15, fq = lane >> 4;
    LAS bf16* As = (LAS bf16*)(lds + L_GEMM);
    LAS bf16* Bs = As + 128 * 40;
    const int ar = tid >> 2, akq = (tid & 3) * 8;
    const int bn = tid & 127, bkg = (tid >> 7) * 8;
    f32x4 acc[4][2];
#pragma unroll
    for (int m = 0; m < 4; ++m)
#pragma unroll
        for (int n = 0; n < 2; ++n) acc[m][n] = (f32x4){0.f, 0.f, 0.f, 0.f};
    bf16x8 ra = al.load(akq);
    float rb0 = bl.load(bkg + 0), rb1 = bl.load(bkg + 1), rb2 = bl.load(bkg + 2), rb3 = bl.load(bkg + 3),
          rb4 = bl.load(bkg + 4), rb5 = bl.load(bkg + 5), rb6 = bl.load(bkg + 6), rb7 = bl.load(bkg + 7);
    for (int k0 = 0; k0 < K; k0 += 32) {
        *(LAS bf16x8*)(As + ar * 40 + akq) = ra;
        u32x4 pb; pb.x = cvt_pk_bf16(rb0, rb1); pb.y = cvt_pk_bf16(rb2, rb3); pb.z = cvt_pk_bf16(rb4, rb5); pb.w = cvt_pk_bf16(rb6, rb7);
        *(LAS u32x4*)(Bs + bn * 40 + bkg) = pb;
        __syncthreads();
        if (k0 + 32 < K) {
            const int kn = k0 + 32;
            ra = al.load(kn + akq);
            rb0 = bl.load(kn + bkg + 0); rb1 = bl.load(kn + bkg + 1); rb2 = bl.load(kn + bkg + 2); rb3 = bl.load(kn + bkg + 3);
            rb4 = bl.load(kn + bkg + 4); rb5 = bl.load(kn + bkg + 5); rb6 = bl.load(kn + bkg + 6); rb7 = bl.load(kn + bkg + 7);
        }
        bf16x8 af[4], bfr[2];
#pragma unroll
        for (int m = 0; m < 4; ++m) af[m] = *(const LAS bf16x8*)(As + (wr * 64 + m * 16 + fr) * 40 + fq * 8);
#pragma unroll
        for (int n = 0; n < 2; ++n) bfr[n] = *(const LAS bf16x8*)(Bs + (wc * 32 + n * 16 + fr) * 40 + fq * 8);
#pragma unroll
        for (int m = 0; m < 4; ++m)
#pragma unroll
            for (int n = 0; n < 2; ++n) acc[m][n] = __builtin_amdgcn_mfma_f32_16x16x32_bf16(af[m], bfr[n], acc[m][n], 0, 0, 0);
        __syncthreads();
    }
    ep(acc, wr, wc, fr, fq);
}

__device__ __forceinline__ bf16x8 pack8(f32x4 a, f32x4 b) {
    u32x4 p; p.x = cvt_pk_bf16(a.x, a.y); p.y = cvt_pk_bf16(a.z, a.w); p.z = cvt_pk_bf16(b.x, b.y); p.w = cvt_pk_bf16(b.z, b.w);
    return __builtin_bit_cast(bf16x8, p);
}
__device__ __forceinline__ bf16x8 zero8() { u32x4 p = {0u, 0u, 0u, 0u}; return __builtin_bit_cast(bf16x8, p); }

struct ALf32 { const float* rowp; __device__ __forceinline__ bf16x8 load(int k) const { if (!rowp) return zero8(); const f32x4 a = *(const f32x4*)(rowp + k), b = *(const f32x4*)(rowp + k + 4); return pack8(a, b); } };
struct ALbf16 { const bf16* rowp; __device__ __forceinline__ bf16x8 load(int k) const { if (!rowp) return zero8(); return *(const bf16x8*)(rowp + k); } };
struct ALcmp { const bf16* base; const float* pe; __device__ __forceinline__ bf16x8 load(int k) const {
        if (!base) return zero8();
        const int l = k >> 6, d = k & 63;
        const u32x4 v = *(const u32x4*)(base + (size_t)l * PP + d);
        const f32x4 p0 = *(const f32x4*)(pe + k), p1 = *(const f32x4*)(pe + k + 4);
        f32x4 a, b;
        a.x = bf2f(v.x & 0xffffu) + p0.x; a.y = bf2f(v.x >> 16) + p0.y; a.z = bf2f(v.y & 0xffffu) + p0.z; a.w = bf2f(v.y >> 16) + p0.w;
        b.x = bf2f(v.z & 0xffffu) + p1.x; b.y = bf2f(v.z >> 16) + p1.y; b.z = bf2f(v.w & 0xffffu) + p1.z; b.w = bf2f(v.w >> 16) + p1.w;
        return pack8(a, b); } };
struct BLf32 { const float* colp; size_t ldb; __device__ __forceinline__ float load(int k) const { return colp ? colp[(size_t)k * ldb] : 0.f; } };

namespace pg8 {
#define PG8_LAS __attribute__((address_space(3)))
typedef unsigned short bf16_t;
typedef short bf16x8 __attribute__((ext_vector_type(8)));
typedef float f32x4 __attribute__((ext_vector_type(4)));
typedef unsigned u32x4 __attribute__((ext_vector_type(4)));
constexpr int BM = 256, BK = 64, HALF = 128, HTB = HALF * BK * 2  , STAGE_BYTES = 8 * HTB, NXCD = 8, WGM = 8;

__host__ __device__ __forceinline__ int lds_byte(int r, int c) { const int st = (r >> 4) * 2 + (c >> 5), rr = r & 15, cc = c & 31, ob = rr * 64 + cc * 2; return st * 1024 + (ob ^ (((ob >> 9) & 1) << 5)); }
__host__ __device__ __forceinline__ void stage_rc(int b, int& R, int& C) { const int st = b / 1024, sb = b % 1024, swz = sb ^ (((sb >> 9) & 1) << 5); R = (st >> 1) * 16 + swz / 64; C = (st & 1) * 32 + (swz % 64) / 2; }
__host__ __device__ __forceinline__ int perm32(int rho) { const int n = rho >> 4, i = rho & 15; return 8 * (i >> 2) + 4 * n + (i & 3); }

struct Unit { int pm, pn; };
struct Gemm { const bf16_t* A; const bf16_t* Bt; int M, N, K; };

struct StaticOrder {
    int nM, nN, nwg, G, c;
    __host__ __device__ void init(int M, int N, int G_, int c_) { nM = M / BM; nN = N / BM; nwg = nM * nN; G = G_; c = c_; }
    __host__ __device__ bool next(int i, Unit& u) const {
        const long L = (long)i * G + c; if (L >= nwg) return false;
        int wgid = (int)L; { const int q = nwg / NXCD, r = nwg % NXCD, xcd = wgid % NXCD, off = wgid / NXCD; wgid = (xcd < r ? xcd * (q + 1) : r * (q + 1) + (xcd - r) * q) + off; }
        const int nig = WGM * nN, gid = wgid / nig, fm = gid * WGM, gsz = (nM - fm) < WGM ? (nM - fm) : WGM;
        u.pm = fm + ((wgid % nig) % gsz); u.pn = (wgid % nig) / gsz; return true;
    }
    __device__ __forceinline__ void a_ready(const Unit&) const {}
    __device__ __forceinline__ void done(const Unit&) const {}
};

__device__ __forceinline__ unsigned cvt_pk_bf16(float lo, float hi) { unsigned r; asm volatile("v_cvt_pk_bf16_f32 %0, %1, %2" : "=v"(r) : "v"(lo), "v"(hi)); return r; }
typedef float f32x2 __attribute__((ext_vector_type(2)));
__device__ __forceinline__ f32x2 gelu_pk(f32x2 v) {
    const f32x2 av = __builtin_elementwise_abs(v), d = av * 0.2316418882f + 1.0f;
    f32x2 t; t.x = __builtin_amdgcn_rcpf(d.x); t.y = __builtin_amdgcn_rcpf(d.y);
    f32x2 q = t * 0.5307027145f + (-0.7265760135f); q = q * t + 0.7107068705f; q = q * t + (-0.142248368f); q = q * t + 0.127414796f; q = q * t;
    const f32x2 s = (v * v) * (-0.72134752044f);
    f32x2 e; e.x = __builtin_amdgcn_exp2f(s.x); e.y = __builtin_amdgcn_exp2f(s.y);
    const f32x2 m = v * (q * e), r = v - m;
    f32x2 o; o.x = v.x < 0.f ? m.x : r.x; o.y = v.y < 0.f ? m.y : r.y; return o;
}

template <int ACT  > struct EpiBf16 {
    static constexpr bool PERM = true, AFTER_DRAIN = false; static_assert(ACT == 0 || ACT == 1, "EpiBf16: ACT is 0 (none) or 1 (gelu_pk)");
    bf16_t* O; int ldc; const float* bias; int split_cols; size_t split_stride; float scale0;
    __device__ __forceinline__ void operator()(const f32x4 (&acc)[2][2][4][2], const Unit& u, int wr, int wc, int fr, int fq) const {
        const int row0 = u.pm * BM + wr * 64 + fr; int colt = u.pn * BM; bf16_t* base = O;
        float sc = 1.f; if (split_cols) { const int t = colt / split_cols; base += (size_t)t * split_stride; colt -= t * split_cols; if (t == 0) sc = scale0; }
        const int col0 = colt + wc * 32 + 8 * fq, bcol0 = u.pn * BM + wc * 32 + 8 * fq;
        f32x4 bv[2][2];
#pragma unroll
        for (int bj = 0; bj < 2; ++bj)
#pragma unroll
            for (int n = 0; n < 2; ++n) bv[bj][n] = bias ? *(const f32x4*)(bias + bcol0 + bj * HALF + 4 * n) : (f32x4){0.f, 0.f, 0.f, 0.f};
#pragma unroll
        for (int ai = 0; ai < 2; ++ai)
#pragma unroll
            for (int m = 0; m < 4; ++m) { bf16_t* rowp = base + (size_t)(row0 + ai * HALF + m * 16) * ldc + col0;
#pragma unroll
                for (int bj = 0; bj < 2; ++bj) { f32x4 v0 = acc[ai][bj][m][0] + bv[bj][0], v1 = acc[ai][bj][m][1] + bv[bj][1];
                    if (ACT == 1) { f32x2 a = gelu_pk((f32x2){v0[0], v0[1]}), b = gelu_pk((f32x2){v0[2], v0[3]}), c = gelu_pk((f32x2){v1[0], v1[1]}), d = gelu_pk((f32x2){v1[2], v1[3]});
                        v0 = (f32x4){a.x, a.y, b.x, b.y}; v1 = (f32x4){c.x, c.y, d.x, d.y}; }
                    v0 = v0 * sc; v1 = v1 * sc; u32x4 w; w.x = cvt_pk_bf16(v0[0], v0[1]); w.y = cvt_pk_bf16(v0[2], v0[3]); w.z = cvt_pk_bf16(v1[0], v1[1]); w.w = cvt_pk_bf16(v1[2], v1[3]);
                    *(u32x4*)(rowp + bj * HALF) = w; } }
    }
};

template <class Epi, class Sched, bool ALIGN_EPI = false, bool SP2 = false>
__device__ __forceinline__ void gemm_phase(PG8_LAS unsigned char* lds, const Gemm g, const Sched& S, const Epi& E) {
    const int tid = threadIdx.x, wid = __builtin_amdgcn_readfirstlane(tid >> 6), lane = tid & 63, wr = wid >> 2, wc = wid & 3, fr = lane & 15, fq = lane >> 4;
    const int K = g.K, nt = K / BK;
    unsigned voffA[2], voffB[2];
#pragma unroll
    for (int i = 0; i < 2; ++i) { int R, C; stage_rc(tid * 16 + i * 8192, R, C); const int Rb = Epi::PERM ? ((R & ~31) + perm32(R & 31)) : R;
        voffA[i] = (unsigned)(R * K + C) * 2u; voffB[i] = (unsigned)(Rb * K + C) * 2u; }
    const size_t kstep = (size_t)(BK * 2);
    const size_t hstep = (size_t)HALF * K * 2;
    const size_t tstep = 2 * hstep;
    const unsigned ldsw = (unsigned)wid * 1024u;
    const int aoff = lds_byte(wr * 64 + fr, fq * 8), boff = lds_byte(wc * 32 + fr, fq * 8);
#define PG8_SA(b, h) (((b) * 2 + (h)) * HTB)
#define PG8_SB(b, h) ((4 + (b) * 2 + (h)) * HTB)
#define PG8_STAGE(bufoff, gbase, voff) do { _Pragma("unroll") for (int _i = 0; _i < 2; ++_i) \
        __builtin_amdgcn_global_load_lds((const unsigned*)((const char*)(gbase) + (voff)[_i]), (PG8_LAS unsigned*)(lds + (bufoff) + ldsw + _i * 8192), 16, 0, 0); } while (0)
#define PG8_LDA(dst, b, h) do { _Pragma("unroll") for (int m = 0; m < 4; ++m) _Pragma("unroll") for (int k = 0; k < 2; ++k) dst[m][k] = *(const PG8_LAS bf16x8*)(lds + PG8_SA(b, h) + aoff + m * 2048 + k * 1024); } while (0)
#define PG8_LDB(dst, b, h) do { _Pragma("unroll") for (int n = 0; n < 2; ++n) _Pragma("unroll") for (int k = 0; k < 2; ++k) dst[n][k] = *(const PG8_LAS bf16x8*)(lds + PG8_SB(b, h) + boff + n * 2048 + k * 1024); } while (0)
#define PG8_MMA(ai, bj, At, Bt) do { __builtin_amdgcn_s_setprio(1); _Pragma("unroll") for (int m = 0; m < 4; ++m) _Pragma("unroll") for (int n = 0; n < 2; ++n) _Pragma("unroll") for (int k = 0; k < 2; ++k) \
        acc[ai][bj][m][n] = __builtin_amdgcn_mfma_f32_16x16x32_bf16(Bt[n][k], At[m][k], acc[ai][bj][m][n], 0, 0, 0); __builtin_amdgcn_s_setprio(0); } while (0)
#define PG8_WAIT_V(n) asm volatile("s_waitcnt vmcnt(" #n ")" ::: "memory")
#define PG8_WAIT_L(n) asm volatile("s_waitcnt lgkmcnt(" #n ")" ::: "memory")
#define PG8_BAR __builtin_amdgcn_s_barrier()
#define PG8_SCHED __builtin_amdgcn_sched_barrier(0)
    Unit cur, nxt; int ui = 0;
    if (!S.next(0, cur)) return;
    f32x4 acc[2][2][4][2];
#pragma unroll
    for (int a = 0; a < 2; ++a)
#pragma unroll
        for (int b = 0; b < 2; ++b)
#pragma unroll
            for (int m = 0; m < 4; ++m)
#pragma unroll
                for (int n = 0; n < 2; ++n) acc[a][b][m][n] = (f32x4){0.f, 0.f, 0.f, 0.f};
    bf16x8 At[4][2], B0[2][2], B1[2][2];
    const char* cA = (const char*)g.A + (size_t)cur.pm * tstep; const char* cB = (const char*)g.Bt + (size_t)cur.pn * tstep;
    S.a_ready(cur);
    if constexpr (SP2) {
        PG8_STAGE(PG8_SB(0, 0), cB, voffB); PG8_STAGE(PG8_SB(0, 1), cB + hstep, voffB); PG8_STAGE(PG8_SA(0, 0), cA, voffA); PG8_STAGE(PG8_SA(0, 1), cA + hstep, voffA);
        if (wr == 1) PG8_BAR;
        PG8_WAIT_V(2); PG8_BAR;
        PG8_STAGE(PG8_SB(1, 0), cB + kstep, voffB); PG8_STAGE(PG8_SA(1, 0), cA + kstep, voffA); PG8_STAGE(PG8_SB(1, 1), cB + hstep + kstep, voffB);
        PG8_WAIT_V(6); PG8_BAR;
    } else {
        PG8_STAGE(PG8_SB(0, 0), cB, voffB); PG8_STAGE(PG8_SA(0, 0), cA, voffA); PG8_STAGE(PG8_SB(0, 1), cB + hstep, voffB); PG8_STAGE(PG8_SA(0, 1), cA + hstep, voffA);
        if (wr == 1) PG8_BAR;
        PG8_WAIT_V(4); PG8_BAR;
        PG8_STAGE(PG8_SB(1, 0), cB + kstep, voffB); PG8_STAGE(PG8_SA(1, 0), cA + kstep, voffA); PG8_STAGE(PG8_SB(1, 1), cB + hstep + kstep, voffB);
        PG8_WAIT_V(6); PG8_BAR;
    }
    for (;;) {
        const bool has_next = S.next(ui + 1, nxt);
        const char* nA = has_next ? (const char*)g.A + (size_t)nxt.pm * tstep : cA; const char* nB = has_next ? (const char*)g.Bt + (size_t)nxt.pn * tstep : cB;
        for (int t = 0; t < nt; t += 2) {
            const bool last = (t == nt - 2);
            const char* a1 = cA + (size_t)(t + 1) * kstep;
            const char* a2 = last ? nA : cA + (size_t)(t + 2) * kstep; const char* b2 = last ? nB : cB + (size_t)(t + 2) * kstep;
            const char* a3 = a2 + kstep; const char* b3 = b2 + kstep;
            if (last && has_next) S.a_ready(nxt);
            if constexpr (SP2) {
            PG8_LDB(B0, 0, 0); PG8_LDB(B1, 0, 1); PG8_SCHED; PG8_LDA(At, 0, 0); PG8_STAGE(PG8_SA(1, 1), a1 + hstep, voffA);
            PG8_WAIT_V(8); PG8_WAIT_L(0); PG8_BAR; PG8_MMA(0, 0, At, B0); PG8_MMA(0, 1, At, B1); PG8_BAR; PG8_SCHED;
            PG8_LDA(At, 0, 1); PG8_STAGE(PG8_SB(0, 0), b2, voffB); PG8_STAGE(PG8_SB(0, 1), b2 + hstep, voffB); PG8_STAGE(PG8_SA(0, 0), a2, voffA);
            PG8_WAIT_V(8); PG8_WAIT_L(0); PG8_BAR; PG8_MMA(1, 0, At, B0); PG8_MMA(1, 1, At, B1); PG8_BAR; PG8_SCHED;
            PG8_LDB(B0, 1, 0); PG8_LDB(B1, 1, 1); PG8_SCHED; PG8_LDA(At, 1, 0); PG8_STAGE(PG8_SA(0, 1), a2 + hstep, voffA);
            PG8_WAIT_V(8); PG8_WAIT_L(0); PG8_BAR; PG8_MMA(0, 0, At, B0); PG8_MMA(0, 1, At, B1); PG8_BAR; PG8_SCHED;
            PG8_LDA(At, 1, 1); PG8_STAGE(PG8_SB(1, 0), b3, voffB); PG8_STAGE(PG8_SB(1, 1), b3 + hstep, voffB); PG8_STAGE(PG8_SA(1, 0), a3, voffA);
            PG8_WAIT_V(8); PG8_WAIT_L(0); PG8_BAR; PG8_MMA(1, 0, At, B0); PG8_MMA(1, 1, At, B1); PG8_BAR; PG8_SCHED;
            } else {
            PG8_LDB(B0, 0, 0); PG8_SCHED; PG8_LDA(At, 0, 0); PG8_STAGE(PG8_SA(1, 1), a1 + hstep, voffA);
            PG8_WAIT_L(8); PG8_BAR; PG8_WAIT_L(0); PG8_MMA(0, 0, At, B0); PG8_BAR; PG8_SCHED;
            PG8_LDB(B1, 0, 1); PG8_STAGE(PG8_SB(0, 0), b2, voffB);
            PG8_BAR; PG8_WAIT_L(0); PG8_MMA(0, 1, At, B1); PG8_BAR;
            PG8_LDA(At, 0, 1); PG8_STAGE(PG8_SA(0, 0), a2, voffA);
            PG8_BAR; PG8_WAIT_L(0); PG8_MMA(1, 0, At, B0); PG8_BAR; PG8_SCHED;
            PG8_STAGE(PG8_SB(0, 1), b2 + hstep, voffB);
            PG8_WAIT_V(6); PG8_BAR; PG8_MMA(1, 1, At, B1); PG8_BAR;
            PG8_LDB(B0, 1, 0); PG8_SCHED; PG8_LDA(At, 1, 0); PG8_STAGE(PG8_SA(0, 1), a2 + hstep, voffA);
            PG8_WAIT_L(8); PG8_BAR; PG8_WAIT_L(0); PG8_MMA(0, 0, At, B0); PG8_BAR; PG8_SCHED;
            PG8_LDB(B1, 1, 1); PG8_STAGE(PG8_SB(1, 0), b3, voffB);
            PG8_BAR; PG8_WAIT_L(0); PG8_MMA(0, 1, At, B1); PG8_BAR;
            PG8_LDA(At, 1, 1); PG8_STAGE(PG8_SA(1, 0), a3, voffA);
            PG8_BAR; PG8_WAIT_L(0); PG8_MMA(1, 0, At, B0); PG8_BAR; PG8_SCHED;
            PG8_STAGE(PG8_SB(1, 1), b3 + hstep, voffB);
            PG8_WAIT_V(6); PG8_BAR; PG8_MMA(1, 1, At, B1); PG8_BAR;
            }
        }
        if constexpr (ALIGN_EPI) { if (wr == 0) PG8_BAR; }
        if constexpr (!Epi::AFTER_DRAIN) { E(acc, cur, wr, wc, fr, fq); S.done(cur); }
        if (!has_next) break;
#pragma unroll
        for (int a = 0; a < 2; ++a)
#pragma unroll
            for (int b = 0; b < 2; ++b)
#pragma unroll
                for (int m = 0; m < 4; ++m)
#pragma unroll
                    for (int n = 0; n < 2; ++n) acc[a][b][m][n] = (f32x4){0.f, 0.f, 0.f, 0.f};
        cur = nxt; cA = nA; cB = nB; ++ui;
        if constexpr (ALIGN_EPI) { if (wr == 1) PG8_BAR; }
    }
    PG8_WAIT_V(0);
    if constexpr (!ALIGN_EPI) { if (wr == 0) PG8_BAR; }
    PG8_BAR;
    if constexpr (Epi::AFTER_DRAIN) { E.fused(acc, cur, wr, wc, fr, fq, lds, wid, lane); S.done(cur); }
#undef PG8_SA
#undef PG8_SB
#undef PG8_STAGE
#undef PG8_LDA
#undef PG8_LDB
#undef PG8_MMA
#undef PG8_WAIT_V
#undef PG8_WAIT_L
#undef PG8_BAR
#undef PG8_SCHED
}
}

namespace pg8 {
struct EpiF32Res {
    static constexpr bool PERM = false, AFTER_DRAIN = false;
    float* Y; const float* res; const float* bias; int ldc; float alpha;
    __device__ __forceinline__ void operator()(const f32x4 (&acc)[2][2][4][2], const Unit& u, int wr, int wc, int fr, int fq) const {
        const int row0 = u.pm * BM + wr * 64 + fr, col0 = u.pn * BM + wc * 32 + 4 * fq;
#pragma unroll
        for (int ai = 0; ai < 2; ++ai)
#pragma unroll
            for (int m = 0; m < 4; ++m) { const size_t off = (size_t)(row0 + ai * HALF + m * 16) * ldc + col0;
#pragma unroll
                for (int bj = 0; bj < 2; ++bj)
#pragma unroll
                    for (int n = 0; n < 2; ++n) { const int cofs = bj * HALF + n * 16;
                        const f32x4 bv = *(const f32x4*)(bias + col0 + cofs), rv = *(const f32x4*)(res + off + cofs);
                        *(f32x4*)(Y + off + cofs) = acc[ai][bj][m][n] + bv + rv * alpha; } }
    }
};
}

namespace mg {
constexpr int A_STAGE = 256 * 64 * 2, B_STAGE = 64 * 256 * 2;
typedef short s16x4 __attribute__((ext_vector_type(4)));
#define MG_OPAQUE(x) asm volatile("" : "+v"(x))
template <class EP>
__device__ __forceinline__ void tile(LAS unsigned char* lds, const bf16* a0, const bf16* a1, const bf16* a2, const bf16* a3, const float* bcol, const size_t ldb,
                                     const int K, const int mvalid, const EP& ep) {
    const int tid = threadIdx.x, w = __builtin_amdgcn_readfirstlane(tid >> 6), lane = tid & 63, wr = w >> 2, wc = w & 3, fr = lane & 15, fq = lane >> 4;
    const int achunk = ((tid & 7) ^ ((tid >> 4) & 7)) * 8;
    a0 += achunk; a1 += achunk; a2 += achunk; a3 += achunk;
    unsigned ard0 = (unsigned)(size_t)lds + (wr * 128 + fr) * 128 + ((fq ^ ((fr >> 1) & 7)) * 16);
    unsigned ard1 = (unsigned)(size_t)lds + (wr * 128 + fr) * 128 + (((4 + fq) ^ ((fr >> 1) & 7)) * 16);
    const int q = fr >> 2, p = fr & 3, rkey = q + 4 * (fq & 1);
    unsigned brd[4];
#pragma unroll
    for (int nn = 0; nn < 4; ++nn) brd[nn] = (unsigned)(size_t)lds + 2 * A_STAGE + (8 * fq + q) * 512 + (((wc * 4 + nn) ^ rkey) << 5) + p * 8;
    unsigned bwr[4];
#pragma unroll
    for (int j = 0; j < 4; ++j) bwr[j] = (unsigned)(size_t)lds + 2 * A_STAGE + (8 * w + j) * 512 + ((((lane >> 2) ^ (j + 4 * (w & 1)))) << 5) + (lane & 3) * 8;
    MG_OPAQUE(ard0); MG_OPAQUE(ard1);
#pragma unroll
    for (int j = 0; j < 4; ++j) { MG_OPAQUE(brd[j]); MG_OPAQUE(bwr[j]); }
    int mlim = (mvalid - wr * 128 + 15) >> 4; mlim = mlim < 0 ? 0 : (mlim > 8 ? 8 : mlim);
    const float* bp = bcol + (size_t)(8 * w) * ldb;
    f32x4 acc[8][4];
#pragma unroll
    for (int m = 0; m < 8; ++m)
#pragma unroll
        for (int nn = 0; nn < 4; ++nn) acc[m][nn] = (f32x4){0.f, 0.f, 0.f, 0.f};
    f32x4 rb[8];
    LAS unsigned char* const Aw = lds + w * 1024;
#define MG_DMA(BUF, k0) do { \
        __builtin_amdgcn_global_load_lds((const unsigned*)(a0 + (k0)), (LAS unsigned*)(Aw + (BUF) * A_STAGE), 16, 0, 0); \
        __builtin_amdgcn_global_load_lds((const unsigned*)(a1 + (k0)), (LAS unsigned*)(Aw + (BUF) * A_STAGE + 8192), 16, 0, 0); \
        __builtin_amdgcn_global_load_lds((const unsigned*)(a2 + (k0)), (LAS unsigned*)(Aw + (BUF) * A_STAGE + 16384), 16, 0, 0); \
        __builtin_amdgcn_global_load_lds((const unsigned*)(a3 + (k0)), (LAS unsigned*)(Aw + (BUF) * A_STAGE + 24576), 16, 0, 0); } while (0)
#define MG_BLOAD(k0) do { const float* p_ = bp + (size_t)(k0) * ldb; \
        _Pragma("unroll") for (int i = 0; i < 8; ++i) rb[i] = *(const f32x4*)(p_ + (size_t)i * ldb); } while (0)
#define MG_BWRITE(BUF) do { \
        _Pragma("unroll") for (int i = 0; i < 8; ++i) { typedef unsigned u32x2 __attribute__((ext_vector_type(2))); u32x2 pk; pk.x = cvt_pk_bf16(rb[i].x, rb[i].y); pk.y = cvt_pk_bf16(rb[i].z, rb[i].w); \
            *(LAS u32x2*)(size_t)(bwr[i & 3] + (BUF) * B_STAGE + (i >> 2) * 2048) = pk; } } while (0)
#define MG_COMPUTE(BUF) do { \
        _Pragma("unroll") for (int ks = 0; ks < 2; ++ks) { \
            bf16x8 Bf[4]; \
            _Pragma("unroll") for (int nn = 0; nn < 4; ++nn) { \
                const s16x4 v0 = __builtin_amdgcn_ds_read_tr16_b64_v4i16((LAS s16x4*)(size_t)(brd[nn] + (BUF) * B_STAGE + ks * 16384)), \
                            v1 = __builtin_amdgcn_ds_read_tr16_b64_v4i16((LAS s16x4*)(size_t)(brd[nn] + (BUF) * B_STAGE + ks * 16384 + 2048)); \
                Bf[nn] = (bf16x8){v0.x, v0.y, v0.z, v0.w, v1.x, v1.y, v1.z, v1.w}; } \
            _Pragma("unroll") for (int mh = 0; mh < 2; ++mh) { \
                bf16x8 Af[4]; \
                _Pragma("unroll") for (int mi = 0; mi < 4; ++mi) Af[mi] = *(const LAS bf16x8*)(size_t)((ks ? ard1 : ard0) + (BUF) * A_STAGE + (mh * 4 + mi) * 2048); \
                _Pragma("unroll") for (int mi = 0; mi < 4; ++mi) { if (mh * 4 + mi < mlim) { \
                    _Pragma("unroll") for (int nn = 0; nn < 4; ++nn) acc[mh * 4 + mi][nn] = __builtin_amdgcn_mfma_f32_16x16x32_bf16(Bf[nn], Af[mi], acc[mh * 4 + mi][nn], 0, 0, 0); } } \
                __builtin_amdgcn_sched_barrier(0); } } } while (0)
#define MG_SYNC() do { asm volatile("s_waitcnt vmcnt(0) lgkmcnt(0)" ::: "memory"); __syncthreads(); } while (0)
    MG_DMA(0, 0); MG_BLOAD(0); MG_BWRITE(0);
    MG_SYNC();
    const int T = K >> 6;
    for (int t = 0; t < T; t += 2) {
        MG_DMA(1, (t + 1) * 64); MG_BLOAD((t + 1) * 64);
        __builtin_amdgcn_sched_barrier(0);
        MG_COMPUTE(0);
        MG_BWRITE(1);
        MG_SYNC();
        const bool hn = t + 2 < T;
        if (hn) { MG_DMA(0, (t + 2) * 64); MG_BLOAD((t + 2) * 64); }
        __builtin_amdgcn_sched_barrier(0);
        MG_COMPUTE(1);
        if (hn) MG_BWRITE(0);
        MG_SYNC();
    }
#undef MG_DMA
#undef MG_BLOAD
#undef MG_BWRITE
#undef MG_COMPUTE
#undef MG_SYNC
    ep(acc, wr, wc, fr, fq);
}
struct EpiGU { bf16* H; int rowbase, mvalid, h0;
    __device__ __forceinline__ void operator()(const f32x4 (&acc)[8][4], int wr, int wc, int fr, int fq) const {
        typedef unsigned u32x2 __attribute__((ext_vector_type(2)));
#pragma unroll
        for (int m = 0; m < 8; ++m) { const int row = wr * 128 + m * 16 + fr;
            if (row < mvalid) {
#pragma unroll
                for (int hn = 0; hn < 2; ++hn) { const f32x4 g = acc[m][hn], u = acc[m][hn + 2]; f32x4 h;
                    h.x = g.x / (1.f + __expf(-g.x)) * u.x; h.y = g.y / (1.f + __expf(-g.y)) * u.y; h.z = g.z / (1.f + __expf(-g.z)) * u.z; h.w = g.w / (1.f + __expf(-g.w)) * u.w;
                    u32x2 pk; pk.x = cvt_pk_bf16(h.x, h.y); pk.y = cvt_pk_bf16(h.z, h.w);
                    *(u32x2*)(H + (size_t)(rowbase + row) * EH + h0 + wc * 32 + hn * 16 + 4 * fq) = pk; } } } } };
struct EpiDown { bf16* contrib; const int* lslot; const float* lw; int mvalid, n0;
    __device__ __forceinline__ void operator()(const f32x4 (&acc)[8][4], int wr, int wc, int fr, int fq) const {
        typedef unsigned u32x2 __attribute__((ext_vector_type(2)));
#pragma unroll
        for (int m = 0; m < 8; ++m) { const int row = wr * 128 + m * 16 + fr;
            if (row < mvalid) { const int slot = lslot[row]; const float wgt = lw[row];
#pragma unroll
                for (int nn = 0; nn < 4; ++nn) { const f32x4 v = acc[m][nn] * wgt; u32x2 pk; pk.x = cvt_pk_bf16(v.x, v.y); pk.y = cvt_pk_bf16(v.z, v.w);
                    *(u32x2*)(contrib + (size_t)slot * DM + n0 + wc * 64 + nn * 16 + 4 * fq) = pk; } } } } };
}

struct Args { const float* in[23]; float* out; unsigned char* ws; int lo, hi; };

struct Ctx {
    LAS unsigned char* lds;
    int tid, lane, wid;
    const Args* a;
    __device__ __forceinline__ const float* x_in() const { return a->in[0]; }
    __device__ __forceinline__ const float* w_in() const { return a->in[1]; }
    __device__ __forceinline__ const float* b_in() const { return a->in[2]; }
    __device__ __forceinline__ const float* sinks() const { return a->in[3]; }
    __device__ __forceinline__ const float* pe_k() const { return a->in[4]; }
    __device__ __forceinline__ const float* w1_k() const { return a->in[5]; }
    __device__ __forceinline__ const float* w2_k() const { return a->in[6]; }
    __device__ __forceinline__ const float* pe_v() const { return a->in[7]; }
    __device__ __forceinline__ const float* w1_v() const { return a->in[8]; }
    __device__ __forceinline__ const float* w2_v() const { return a->in[9]; }
    __device__ __forceinline__ const float* w_out() const { return a->in[10]; }
    __device__ __forceinline__ const float* b_out() const { return a->in[11]; }
    __device__ __forceinline__ const float* ln1_g() const { return a->in[12]; }
    __device__ __forceinline__ const float* ln1_b() const { return a->in[13]; }
    __device__ __forceinline__ const float* w_group() const { return a->in[14]; }
    __device__ __forceinline__ const float* b_group() const { return a->in[15]; }
    __device__ __forceinline__ const float* w_expert() const { return a->in[16]; }
    __device__ __forceinline__ const float* b_expert() const { return a->in[17]; }
    __device__ __forceinline__ const float* we_gate() const { return a->in[18]; }
    __device__ __forceinline__ const float* we_up() const { return a->in[19]; }
    __device__ __forceinline__ const float* we_down() const { return a->in[20]; }
    __device__ __forceinline__ const float* ln2_g() const { return a->in[21]; }
    __device__ __forceinline__ const float* ln2_b() const { return a->in[22]; }
    __device__ __forceinline__ float* out() const { return a->out; }
    __device__ __forceinline__ bf16* proj() const { return (bf16*)(a->ws + WS_PROJ); }
    __device__ __forceinline__ bf16* o() const { return (bf16*)(a->ws + WS_O); }
    __device__ __forceinline__ bf16* kvc() const { return (bf16*)(a->ws + WS_KVC); }
    __device__ __forceinline__ bf16* H() const { return (bf16*)(a->ws + WS_H); }
    __device__ __forceinline__ float* y() const { return (float*)(a->ws + WS_Y); }
    __device__ __forceinline__ float* x1() const { return (float*)(a->ws + WS_X1); }
    __device__ __forceinline__ float* x2() const { return (float*)(a->ws + WS_X2); }
    __device__ __forceinline__ float* hb() const { return (float*)(a->ws + WS_HB); }
    __device__ __forceinline__ float* logits() const { return (float*)(a->ws + WS_LOG); }
    __device__ __forceinline__ float* lw() const { return (float*)(a->ws + WS_LW); }
    __device__ __forceinline__ float* contrib() const { return (float*)(a->ws + WS_CONTRIB); }
    __device__ __forceinline__ int* lslot() const { return (int*)(a->ws + WS_LSLOT); }
    __device__ __forceinline__ bf16* wint() const { return (bf16*)(a->ws + WS_WINT); }
    __device__ __forceinline__ bf16* wot() const { return (bf16*)(a->ws + WS_WOT); }
    __device__ __forceinline__ bf16* xb() const { return (bf16*)(a->ws + WS_XB); }
    __device__ __forceinline__ bf16* x1b() const { return (bf16*)(a->ws + WS_X1B); }
    __device__ __forceinline__ bf16* contribb() const { return (bf16*)(a->ws + WS_CONTRIB); }
    __device__ __forceinline__ unsigned* cnt() const { return (unsigned*)(a->ws + WS_CTL) + CW_CNT; }
};

constexpr int ATILE_BYTES = 64 * 64 * 2;
constexpr float C1 = 0.125f * 1.4426950408889634f;

struct AttnRegs { f32x4 O[4][4]; float m[4], l[4]; bf16x8 Q[4][2]; };
struct ColCtx { int tt0; int t0; };
struct TileD { const bf16* k; const bf16* v; int pitch; float offrel; int mtype; int j; };
struct TileGen {
    int kind;
    int j, jend; unsigned long long rem; int c, jold;
    const bf16* kb; const bf16* vb;
    __device__ __forceinline__ bool next(TileD& d) {
        int jj;
        if (kind == 1) { if (!rem) return false; jj = __builtin_ctzll(rem); rem &= rem - 1; }
        else { if (j > jend) return false; jj = j++; }
        d.j = jj;
        if (kind == 2) { d.k = kb + (size_t)jj * 64 * 128; d.v = vb + (size_t)jj * 64 * 128; d.pitch = 128; d.offrel = (float)(1024 * jj + 31 - 64 * c); d.mtype = 3; }
        else { d.k = kb + (size_t)jj * 64 * PP; d.v = vb + (size_t)jj * 64 * PP; d.pitch = PP; d.offrel = (float)(64 * (jj - c)); d.mtype = (jj == c) ? 1 : (jj == jold ? 2 : 0); }
        return true;
    }
};

__device__ __forceinline__ void attn_load_q(AttnRegs& R, const bf16* qbase, int w, int fr, int fq) {
#pragma unroll
    for (int nt = 0; nt < 4; ++nt) {
        const int tt = 8 * w + 2 * nt + (fr >> 3);
        const bf16* p = qbase + (size_t)tt * PP + (fr & 7) * 64 + fq * 8;
        R.Q[nt][0] = *(const bf16x8*)p; R.Q[nt][1] = *(const bf16x8*)(p + 32);
    }
}
__device__ __forceinline__ void attn_reset(AttnRegs& R) {
#pragma unroll
    for (int nt = 0; nt < 4; ++nt) { R.m[nt] = -INFINITY; R.l[nt] = 0.f;
#pragma unroll
        for (int md = 0; md < 4; ++md) R.O[md][nt] = (f32x4){0.f, 0.f, 0.f, 0.f}; }
}
__device__ __forceinline__ void stage_issue(const TileD& d, LAS unsigned char* kdst, LAS unsigned char* vdst, int w, int lane) {
    const int r = 8 * w + (lane >> 3), ch = (lane & 7) ^ ((lane >> 3) & 7);
    __builtin_amdgcn_global_load_lds((const unsigned*)(d.k + (size_t)r * d.pitch + ch * 8), (LAS unsigned*)(kdst + w * 1024), 16, 0, 0);
    __builtin_amdgcn_global_load_lds((const unsigned*)(d.v + (size_t)r * d.pitch + ch * 8), (LAS unsigned*)(vdst + w * 1024), 16, 0, 0);
}

template <int MODE>
__device__ __forceinline__ void attn_half(AttnRegs& R, const LAS unsigned char* Kt, const LAS unsigned char* Vt, const int hk, const float A, const float kstep, const float off,
                                          const int mtype, const int hicmp, const unsigned enbits, const ColCtx& cc, const int fr, const int fq,
                                          LAS float* impA, LAS float* impB, const int jq0) {
    bf16x8 Kf[2][2];
#pragma unroll
    for (int m = 0; m < 2; ++m)
#pragma unroll
        for (int ks = 0; ks < 2; ++ks) Kf[m][ks] = *(const LAS bf16x8*)(Kt + (hk * 32 + m * 16 + fr) * 128 + (((ks * 4 + fq) ^ (fr & 7)) * 16));
    f32x4 S[2][4];
    const float ak = A * kstep;
#pragma unroll
    for (int m = 0; m < 2; ++m) {
        const float b0 = ak * (float)(hk * 32 + m * 16 + 4 * fq);
        const f32x4 cb = {b0, b0 + ak, b0 + 2.f * ak, b0 + 3.f * ak};
#pragma unroll
        for (int nt = 0; nt < 4; ++nt) {
            S[m][nt] = __builtin_amdgcn_mfma_f32_16x16x32_bf16(Kf[m][0], R.Q[nt][0], cb, 0, 0, 0);
            S[m][nt] = __builtin_amdgcn_mfma_f32_16x16x32_bf16(Kf[m][1], R.Q[nt][1], S[m][nt], 0, 0, 0);
        }
    }
    __builtin_amdgcn_sched_barrier(0);
    bool en[4];
#pragma unroll
    for (int nt = 0; nt < 4; ++nt) en[nt] = ((enbits >> nt) & 1u) != 0u;
    if (mtype != 0) {
#pragma unroll
        for (int nt = 0; nt < 4; ++nt) {
            const int tt = cc.tt0 + 2 * nt;
            int lo = 0, hi = 63;
            if (mtype == 1) hi = tt; else if (mtype == 2) lo = tt + 1; else { const int t = cc.t0 + tt; hi = (t >= 31 ? ((t - 31) >> 4) : -1) - hicmp; }
#pragma unroll
            for (int m = 0; m < 2; ++m)
#pragma unroll
                for (int r = 0; r < 4; ++r) { const int kk = hk * 32 + m * 16 + 4 * fq + r; if (kk < lo || kk > hi) S[m][nt][r] = -INFINITY; }
        }
    }
    bf16x8 Pf[4];
#pragma unroll
    for (int nt = 0; nt < 4; ++nt) {
        float add;
        if (MODE == 2) {
            add = (en[nt] && R.m[nt] > -INFINITY) ? C1 * (off - R.m[nt]) : -INFINITY;
        } else {
            float cm = fmaxf(fmaxf(fmaxf(S[0][nt][0], S[0][nt][1]), fmaxf(S[0][nt][2], S[0][nt][3])), fmaxf(fmaxf(S[1][nt][0], S[1][nt][1]), fmaxf(S[1][nt][2], S[1][nt][3])));
            if (!en[nt]) cm = -INFINITY;
            cm = fmaxf(cm, __shfl_xor(cm, 16)); cm = fmaxf(cm, __shfl_xor(cm, 32));
            const float mn = fmaxf(R.m[nt], cm + off);
            const float corr = (mn == -INFINITY) ? 1.f : __builtin_amdgcn_exp2f(C1 * (R.m[nt] - mn));
            add = (en[nt] && mn > -INFINITY) ? C1 * (off - mn) : -INFINITY;
            R.m[nt] = mn; R.l[nt] *= corr;
            if (MODE == 0) {
#pragma unroll
                for (int md = 0; md < 4; ++md) R.O[md][nt] = R.O[md][nt] * corr;
            }
        }
        float p[2][4];
#pragma unroll
        for (int m = 0; m < 2; ++m)
#pragma unroll
            for (int r = 0; r < 4; ++r) p[m][r] = __builtin_amdgcn_exp2f(fmaf(S[m][nt][r], C1, add));
        if (MODE == 2) {
#pragma unroll
            for (int m = 0; m < 2; ++m) {
                float q4 = (p[m][0] + p[m][1]) + (p[m][2] + p[m][3]), p3 = p[m][3];
                q4 += __shfl_xor(q4, 1); p3 += __shfl_xor(p3, 1);
                q4 += __shfl_xor(q4, 2); p3 += __shfl_xor(p3, 2);
                q4 += __shfl_xor(q4, 4); p3 += __shfl_xor(p3, 4);
                if ((fr & 7) == 0) { const int jq = jq0 + hk * 8 + m * 4 + fq; impA[(cc.tt0 + 2 * nt) * 64 + jq] = q4; impB[(cc.tt0 + 2 * nt) * 65 + jq + 1] = p3; }
            }
        } else {
            R.l[nt] += ((p[0][0] + p[0][1]) + (p[0][2] + p[0][3])) + ((p[1][0] + p[1][1]) + (p[1][2] + p[1][3]));
        }
        if (MODE != 1) {
            u32x4 pk; pk.x = cvt_pk_bf16(p[0][0], p[0][1]); pk.y = cvt_pk_bf16(p[0][2], p[0][3]); pk.z = cvt_pk_bf16(p[1][0], p[1][1]); pk.w = cvt_pk_bf16(p[1][2], p[1][3]);
            Pf[nt] = __builtin_bit_cast(bf16x8, pk);
        }
        if (nt & 1) __builtin_amdgcn_sched_barrier(0);
    }
    __builtin_amdgcn_sched_barrier(0);
    if (MODE != 1) {
#pragma unroll
        for (int md = 0; md < 4; ++md) {
            typedef short s16x4 __attribute__((ext_vector_type(4)));
            const int key0 = hk * 32 + 4 * fq + (fr >> 2);
            const LAS unsigned char* vp = Vt + key0 * 128 + (((md * 2 + ((fr & 3) >> 1)) ^ (key0 & 7)) * 16) + (fr & 1) * 8;
            const s16x4 v0 = __builtin_amdgcn_ds_read_tr16_b64_v4i16((LAS s16x4*)vp), v1 = __builtin_amdgcn_ds_read_tr16_b64_v4i16((LAS s16x4*)(vp + 16 * 128));
            const bf16x8 Vf = {v0.x, v0.y, v0.z, v0.w, v1.x, v1.y, v1.z, v1.w};
#pragma unroll
            for (int nt = 0; nt < 4; ++nt) R.O[md][nt] = __builtin_amdgcn_mfma_f32_16x16x32_bf16(Vf, Pf[nt], R.O[md][nt], 0, 0, 0);
        }
    }
}

template <int MODE, bool USE_SEL>
__device__ __forceinline__ void attn_sweep(AttnRegs& R, LAS unsigned char* lds, TileGen tg, const ColCtx& cc, const float A, const float kstep,
                                           const int w, const int lane, const int fr, const int fq) {
    LAS unsigned char* Kb = lds + L_KV; LAS unsigned char* Vb = lds + L_KV + 2 * ATILE_BYTES;
    LAS float* impA = (LAS float*)(lds + L_IMPA); LAS float* impB = (LAS float*)(lds + L_IMPB);
    const LAS unsigned* selw = (const LAS unsigned*)(lds + L_SEL);
    TileD cur, nxt;
    if (!tg.next(cur)) return;
    stage_issue(cur, Kb, Vb, w, lane);
    asm volatile("s_waitcnt vmcnt(0)" ::: "memory");
    __syncthreads();
    int buf = 0;
    for (;;) {
        const bool hn = tg.next(nxt);
        if (hn) stage_issue(nxt, Kb + (buf ^ 1) * ATILE_BYTES, Vb + (buf ^ 1) * ATILE_BYTES, w, lane);
        unsigned enbits = 15u;
        if (USE_SEL) {
            enbits = 0u;
#pragma unroll
            for (int nt = 0; nt < 4; ++nt) { const int tt = cc.tt0 + 2 * nt; const unsigned sw = selw[2 * tt + (cur.j >> 5)]; enbits |= ((sw >> (cur.j & 31)) & 1u) << nt; }
        }
        if (__any(enbits != 0u)) {
            const LAS unsigned char* Kt = Kb + buf * ATILE_BYTES; const LAS unsigned char* Vt = Vb + buf * ATILE_BYTES;
            const float off = A * cur.offrel;
#pragma unroll 1
            for (int hk = 0; hk < 2; ++hk) attn_half<MODE>(R, Kt, Vt, hk, A, kstep, off, cur.mtype, 64 * cur.j, enbits, cc, fr, fq, impA, impB, cur.j * 16);
        }
        asm volatile("s_waitcnt vmcnt(0)" ::: "memory");
        __syncthreads();
        if (!hn) break;
        cur = nxt; buf ^= 1;
    }
}
__device__ __forceinline__ void attn_ltot(const AttnRegs& R, float (&lt)[4]) {
#pragma unroll
    for (int nt = 0; nt < 4; ++nt) { float l = R.l[nt]; l += __shfl_xor(l, 16); l += __shfl_xor(l, 32); lt[nt] = l; }
}
__device__ __forceinline__ void attn_store(const AttnRegs& R, const float (&sc)[4], bf16* obase, const ColCtx& cc, int fr, int fq, bool accumulate) {
    typedef unsigned u32x2 __attribute__((ext_vector_type(2)));
#pragma unroll
    for (int nt = 0; nt < 4; ++nt)
#pragma unroll
        for (int md = 0; md < 4; ++md) {
            f32x4 v = R.O[md][nt] * sc[nt];
            u32x2* p = (u32x2*)(obase + (size_t)(cc.tt0 + 2 * nt) * DM + (fr & 7) * 64 + md * 16 + 4 * fq);
            if (accumulate) { const unsigned long long ow = __hip_atomic_load((unsigned long long*)p, __ATOMIC_RELAXED, __HIP_MEMORY_SCOPE_AGENT); u32x2 old; old.x = (unsigned)ow; old.y = (unsigned)(ow >> 32); v.x += bf2f(old.x & 0xffffu); v.y += bf2f(old.x >> 16); v.z += bf2f(old.y & 0xffffu); v.w += bf2f(old.y >> 16); }
            u32x2 nw; nw.x = cvt_pk_bf16(v.x, v.y); nw.y = cvt_pk_bf16(v.z, v.w);
            *p = nw;
        }
}
__device__ __forceinline__ void attn_colctx(ColCtx& cc, int w, int fr, int t0) { cc.tt0 = 8 * w + (fr >> 3); cc.t0 = t0; }

__device__ __forceinline__ void win_unit(const Ctx& c, int L, int u) {
    const int tid = c.tid, lane = c.lane, w = c.wid, fr = lane & 15, fq = lane >> 4;
    const int cch = u & 63, g = (u >> 6) & 1, b = u >> 7, t0 = cch * 64;
    const bf16* pb = c.proj() + (size_t)b * SEQ * PP;
    AttnRegs R; attn_reset(R);
    attn_load_q(R, pb + (size_t)t0 * PP + C_QN + g * 512, w, fr, fq);
    ColCtx cc; attn_colctx(cc, w, fr, t0);
    const float A = 8.f * exp2f(-(float)(g * 8 + (fr & 7) + 1) * 0.5f);
    TileGen tg; tg.kind = 0; tg.c = cch; tg.j = cch - 8 < 0 ? 0 : cch - 8; tg.jend = cch; tg.jold = cch - 8; tg.rem = 0ull;
    tg.kb = pb + C_KV + 4 * 128 + g * 64; tg.vb = pb + C_KV + 5 * 128 + g * 64;
    attn_sweep<0, false>(R, c.lds, tg, cc, A, 1.f, w, lane, fr, fq);
    float lt[4], sc[4]; attn_ltot(R, lt);
#pragma unroll
    for (int nt = 0; nt < 4; ++nt) { const float gv = bf2f(pb[(size_t)(t0 + cc.tt0 + 2 * nt) * PP + C_GN + g * 24 + (fr & 7) * 3 + 2]); sc[nt] = sigmoidf(gv) / lt[nt]; }
    attn_store(R, sc, c.o() + ((size_t)b * SEQ + t0) * DM + 1024 + g * 512, cc, fr, fq, false);
}
__device__ __forceinline__ void swa_unit(const Ctx& c, int L, int u) {
    const int tid = c.tid, lane = c.lane, w = c.wid, fr = lane & 15, fq = lane >> 4;
    const int cch = u & 63, g = (u >> 6) & 1, b = u >> 7, t0 = cch * 64;
    const bf16* pb = c.proj() + (size_t)b * SEQ * PP;
    AttnRegs R; attn_reset(R);
    attn_load_q(R, pb + (size_t)t0 * PP + C_QA + g * 512, w, fr, fq);
    ColCtx cc; attn_colctx(cc, w, fr, t0);
    const int a = g * 8 + (fr & 7);
    const float A = 8.f * exp2f(-(float)(2 * a + 1) * 0.25f);
    const float sink8 = 8.f * c.sinks()[L * 16 + a];
#pragma unroll
    for (int nt = 0; nt < 4; ++nt) { R.m[nt] = sink8 + A * (float)(cc.tt0 + 2 * nt); R.l[nt] = fq == 0 ? 1.f : 0.f; }
    TileGen tg; tg.kind = 0; tg.c = cch; tg.j = cch - 2 < 0 ? 0 : cch - 2; tg.jend = cch; tg.jold = cch - 2; tg.rem = 0ull;
    tg.kb = pb + C_KA + g * 64; tg.vb = pb + C_VA + g * 64;
    attn_sweep<0, false>(R, c.lds, tg, cc, A, 1.f, w, lane, fr, fq);
    float lt[4], sc[4]; attn_ltot(R, lt);
#pragma unroll
    for (int nt = 0; nt < 4; ++nt) sc[nt] = 1.f / lt[nt];
    attn_store(R, sc, c.o() + ((size_t)b * SEQ + t0) * DM + g * 512, cc, fr, fq, false);
}
__device__ __forceinline__ void cmpslc_unit(const Ctx& c, int L, int u) {
    const int tid = c.tid, lane = c.lane, w = c.wid, fr = lane & 15, fq = lane >> 4;
    const int cch = u & 63, g = (u >> 6) & 1, b = u >> 7, t0 = cch * 64;
    const bf16* pb = c.proj() + (size_t)b * SEQ * PP;
    LAS float* impA = (LAS float*)(c.lds + L_IMPA); LAS float* impB = (LAS float*)(c.lds + L_IMPB);
    LAS unsigned* selw = (LAS unsigned*)(c.lds + L_SEL);
    AttnRegs R; attn_reset(R);
    attn_load_q(R, pb + (size_t)t0 * PP + C_QN + g * 512, w, fr, fq);
    ColCtx cc; attn_colctx(cc, w, fr, t0);
    const float A = 8.f * exp2f(-(float)(g * 8 + (fr & 7) + 1) * 0.5f);
    bf16* obase = c.o() + ((size_t)b * SEQ + t0) * DM + 1024 + g * 512;
    const bf16* gbase = pb + (size_t)t0 * PP + C_GN + g * 24 + (fr & 7) * 3;
    for (int i = lane; i < 8 * 64; i += 64) impA[(8 * w) * 64 + i] = 0.f;
    for (int i = lane; i < 8 * 65; i += 64) impB[(8 * w) * 65 + i] = 0.f;
    WAVE_LDS_FENCE();
    int ncl = 4 * cch + 2; if (ncl > NCMP - 1) ncl = NCMP - 1;
    TileGen tg; tg.kind = 2; tg.c = cch; tg.j = 0; tg.jend = ncl >> 6; tg.jold = -1; tg.rem = 0ull;
    tg.kb = c.kvc() + ((size_t)(b * NCMP) * 2 + g) * 64; tg.vb = c.kvc() + (size_t)2048 * 64 + ((size_t)(b * NCMP) * 2 + g) * 64;
    attn_sweep<1, false>(R, c.lds, tg, cc, A, 16.f, w, lane, fr, fq);
    { float lt[4]; attn_ltot(R, lt);
#pragma unroll
      for (int nt = 0; nt < 4; ++nt) R.m[nt] = lt[nt] > 0.f ? R.m[nt] + __builtin_amdgcn_logf(lt[nt]) * (1.f / C1) : -INFINITY; }
    attn_sweep<2, false>(R, c.lds, tg, cc, A, 16.f, w, lane, fr, fq);
    { float sc[4];
#pragma unroll
      for (int nt = 0; nt < 4; ++nt) sc[nt] = sigmoidf(bf2f(gbase[(size_t)(cc.tt0 + 2 * nt) * PP + 0]));
      attn_store(R, sc, obase, cc, fr, fq, true); }
    WAVE_LDS_FENCE();
    for (int i = 0; i < 8; ++i) {
        const int ti = 8 * w + i, j = lane;
        const float imp = impA[ti * 64 + j] + impB[ti * 65 + j];
        const bool forced = (j == 0) || (j == cch) || (j == cch - 1); const bool valid = j <= cch;
        const float score = valid ? (forced ? INFINITY : imp) : -INFINITY;
        int rank = 0;
        for (int k = 0; k < 64; ++k) { const float sk = __shfl(score, k); rank += ((sk > score) || (sk == score && k < lane)) ? 1 : 0; }
        const unsigned long long msk = __ballot((rank < 16) && (score > -INFINITY));
        if (lane == 0) { selw[2 * ti] = (unsigned)msk; selw[2 * ti + 1] = (unsigned)(msk >> 32); }
    }
    asm volatile("s_waitcnt vmcnt(0) lgkmcnt(0)" ::: "memory");
    __syncthreads();
    unsigned ulo = selw[2 * lane], uhi = selw[2 * lane + 1];
#pragma unroll
    for (int o = 1; o < 64; o <<= 1) { ulo |= __shfl_xor(ulo, o); uhi |= __shfl_xor(uhi, o); }
    const unsigned long long uni = ((unsigned long long)__builtin_amdgcn_readfirstlane(uhi) << 32) | (unsigned long long)__builtin_amdgcn_readfirstlane(ulo);
    attn_reset(R);
    tg.kind = 1; tg.rem = uni; tg.j = 0; tg.jend = -1; tg.jold = -1;
    tg.kb = pb + C_KV + 2 * 128 + g * 64; tg.vb = pb + C_KV + 3 * 128 + g * 64;
    attn_sweep<0, true>(R, c.lds, tg, cc, A, 1.f, w, lane, fr, fq);
    { float lt[4], sc[4]; attn_ltot(R, lt);
#pragma unroll
      for (int nt = 0; nt < 4; ++nt) sc[nt] = sigmoidf(bf2f(gbase[(size_t)(cc.tt0 + 2 * nt) * PP + 1])) / lt[nt];
      asm volatile("s_waitcnt vmcnt(0)" ::: "memory");
      attn_store(R, sc, obase, cc, fr, fq, true); }
    __syncthreads();
}

#define EPI_LOOP for (int m = 0; m < 4; ++m) for (int n = 0; n < 2; ++n) for (int j = 0; j < 4; ++j)
struct EpiProj { bf16* proj; const float* bias; int row0, col0;
    __device__ __forceinline__ void operator()(const f32x4 (&acc)[4][2], int wr, int wc, int fr, int fq) const {
#pragma unroll
        for (int m = 0; m < 4; ++m)
#pragma unroll
            for (int n = 0; n < 2; ++n)
#pragma unroll
                for (int j = 0; j < 4; ++j) { const int r = row0 + wr * 64 + m * 16 + fq * 4 + j, cc = col0 + wc * 32 + n * 16 + fr;
                    const float v = cc < INC ? acc[m][n][j] + bias[cc] : 0.f; proj[(size_t)r * PP + cc] = f2bf(v); } } };
struct EpiCmp1 { float* hb; int row0, col0;
    __device__ __forceinline__ void operator()(const f32x4 (&acc)[4][2], int wr, int wc, int fr, int fq) const {
#pragma unroll
        for (int m = 0; m < 4; ++m)
#pragma unroll
            for (int n = 0; n < 2; ++n)
#pragma unroll
                for (int j = 0; j < 4; ++j) { const int r = row0 + wr * 64 + m * 16 + fq * 4 + j, cc = col0 + wc * 32 + n * 16 + fr;
                    hb[(size_t)r * 256 + cc] = gelu_tanh(acc[m][n][j]); } } };
struct EpiCmp2 { bf16* kvc; int row0;
    __device__ __forceinline__ void operator()(const f32x4 (&acc)[4][2], int wr, int wc, int fr, int fq) const {
#pragma unroll
        for (int m = 0; m < 4; ++m)
#pragma unroll
            for (int n = 0; n < 2; ++n)
#pragma unroll
                for (int j = 0; j < 4; ++j) { const int r = row0 + wr * 64 + m * 16 + fq * 4 + j, cc = wc * 32 + n * 16 + fr;
                    if (cc < 64) kvc[(size_t)r * 64 + cc] = f2bf(acc[m][n][j]); } } };
struct EpiOut { float* y; const float* bias; const float* xres; int row0, col0;
    __device__ __forceinline__ void operator()(const f32x4 (&acc)[4][2], int wr, int wc, int fr, int fq) const {
#pragma unroll
        for (int m = 0; m < 4; ++m)
#pragma unroll
            for (int n = 0; n < 2; ++n)
#pragma unroll
                for (int j = 0; j < 4; ++j) { const int r = row0 + wr * 64 + m * 16 + fq * 4 + j, cc = col0 + wc * 32 + n * 16 + fr;
                    y[(size_t)r * DM + cc] = acc[m][n][j] + bias[cc] + ALPHA * xres[(size_t)r * DM + cc]; } } };
struct EpiLogit { float* lg; const float* bg; const float* be; int row0;
    __device__ __forceinline__ void operator()(const f32x4 (&acc)[4][2], int wr, int wc, int fr, int fq) const {
#pragma unroll
        for (int m = 0; m < 4; ++m)
#pragma unroll
            for (int n = 0; n < 2; ++n)
#pragma unroll
                for (int j = 0; j < 4; ++j) { const int r = row0 + wr * 64 + m * 16 + fq * 4 + j, cc = wc * 32 + n * 16 + fr;
                    if (cc < 72) lg[(size_t)r * NLOG + cc] = acc[m][n][j] + (cc < 8 ? bg[cc] : be[cc - 8]); } } };
struct EpiMoe1 { bf16* H; int rowbase, cnt, rt, ct;
    __device__ __forceinline__ void operator()(const f32x4 (&acc)[4][2], int wr, int wc, int fr, int fq) const {
#pragma unroll
        for (int m = 0; m < 4; ++m)
#pragma unroll
            for (int j = 0; j < 4; ++j) { const int pos = rt * 128 + wr * 64 + m * 16 + fq * 4 + j;
                if (pos < cnt) { const float gv = acc[m][0][j], uv = acc[m][1][j]; const float hv = gv / (1.f + expf(-gv)) * uv;
                    H[(size_t)(rowbase + pos) * EH + ct * 64 + wc * 16 + fr] = f2bf(hv); } } } };
struct EpiMoe2 { float* contrib; const int* lslot; const float* lw; int cnt, rt, col0;
    __device__ __forceinline__ void operator()(const f32x4 (&acc)[4][2], int wr, int wc, int fr, int fq) const {
#pragma unroll
        for (int m = 0; m < 4; ++m)
#pragma unroll
            for (int j = 0; j < 4; ++j) { const int pos = rt * 128 + wr * 64 + m * 16 + fq * 4 + j;
                if (pos < cnt) { const int slot = lslot[pos]; const float w = lw[pos];
#pragma unroll
                    for (int n = 0; n < 2; ++n) contrib[(size_t)slot * DM + col0 + wc * 32 + n * 16 + fr] = acc[m][n][j] * w; } } } };

__device__ __forceinline__ void p0_transpose_item(const float* W, int K, int ldw, int N, bf16* WT, LAS float* scr, int item, int lane) {
    const int nblk = N / 32, kb = item / nblk, nb = item % nblk, k0 = 64 * kb, n0 = 32 * nb;
#pragma unroll 8
    for (int i = 0; i < 32; ++i) { const int kk = 2 * i + (lane >> 5); scr[kk * 33 + (lane & 31)] = W[(size_t)(k0 + kk) * ldw + n0 + (lane & 31)]; }
    WAVE_LDS_FENCE();
    const int ch = lane & 7;
#pragma unroll
    for (int j = 0; j < 4; ++j) { const int n = (lane >> 3) + 8 * j; const LAS float* s = scr + (8 * ch) * 33 + n;
        u32x4 o; o.x = cvt_pk_bf16(s[0 * 33], s[1 * 33]); o.y = cvt_pk_bf16(s[2 * 33], s[3 * 33]); o.z = cvt_pk_bf16(s[4 * 33], s[5 * 33]); o.w = cvt_pk_bf16(s[6 * 33], s[7 * 33]);
        *(u32x4*)(WT + (size_t)(n0 + n) * K + k0 + 8 * ch) = o; }
    WAVE_LDS_FENCE();
}
__device__ __forceinline__ void ph_prologue(const Ctx& c) {
    LAS float* scr = (LAS float*)(c.lds + c.wid * 16384);
    const int gw = blockIdx.x * 8 + c.wid, NGW = gridDim.x * 8;
    constexpr int I_IN = (DM / 64) * (3072 / 32), I_OUT = (DM / 64) * (DM / 32);
    for (int it = gw; it < DEPTH * (I_IN + I_OUT); it += NGW) {
        int r = it; const int L = r / (I_IN + I_OUT); r -= L * (I_IN + I_OUT);
        if (r < I_IN) p0_transpose_item(c.w_in() + (size_t)L * DM * INC, DM, INC, 3072, c.wint() + (size_t)L * 3072 * DM, scr, r, c.lane);
        else p0_transpose_item(c.w_out() + (size_t)L * DM * DM, DM, DM, DM, c.wot() + (size_t)L * DM * DM, scr, r - I_IN, c.lane);
    }
    for (int m = gw; m < MTOK; m += NGW) {
        const f32x4* xr = (const f32x4*)(c.x_in() + (size_t)m * DM) + c.lane; unsigned long long* o8 = (unsigned long long*)(c.xb() + (size_t)m * DM) + c.lane;
#pragma unroll
        for (int j = 0; j < 8; ++j) { const f32x4 v = xr[64 * j]; o8[64 * j] = (unsigned long long)cvt_pk_bf16(v.x, v.y) | ((unsigned long long)cvt_pk_bf16(v.z, v.w) << 32); }
    }
}
__device__ __forceinline__ void ph_inproj(const Ctx& c, int L, const float* xin) {
    {
        pg8::Gemm g{c.xb(), c.wint() + (size_t)L * 3072 * DM, MTOK, 3072, DM}; pg8::StaticOrder S; S.init(MTOK, 3072, (int)gridDim.x, (int)blockIdx.x);
        pg8::EpiBf16<0> E{c.proj(), PP, c.b_in() + L * INC, 0, 0, 1.f};
        pg8::gemm_phase<pg8::EpiBf16<0>, pg8::StaticOrder, true, true>(c.lds, g, S, E);
    }
    const float* W = c.w_in() + (size_t)L * DM * INC; const float* bias = c.b_in() + L * INC;
    const int ar = c.tid >> 2, bn = c.tid & 127;
    for (int u = blockIdx.x; u < 128; u += gridDim.x) {
        ALf32 al{xin + (size_t)(u * 128 + ar) * DM};
        const int col = 3072 + bn;
        BLf32 bl{col < INC ? W + col : nullptr, (size_t)INC};
        EpiProj ep{c.proj(), bias, u * 128, 3072};
        gemm_tile(c.lds, al, bl, ep, DM);
    }
}
__device__ __forceinline__ void ph_cmp1_swa(const Ctx& c, int L) {
    const int ar = c.tid >> 2, bn = c.tid & 127;
    for (int u = blockIdx.x; u < 64; u += gridDim.x) {
        const int which = u >> 5, rt = (u >> 1) & 15, ct = u & 1;
        const int r = rt * 128 + ar;
        const bf16* base = nullptr;
        if (r < CMPROWS) { const int g = r & 1, bn_ = r >> 1, n = bn_ % NCMP, b = bn_ / NCMP;
            base = c.proj() + ((size_t)b * SEQ + 16 * n) * PP + C_KV + which * 128 + g * 64; }
        ALcmp al{base, (which ? c.pe_v() : c.pe_k()) + (size_t)L * 2048};
        BLf32 bl{(which ? c.w1_v() : c.w1_k()) + (size_t)L * 2048 * 256 + ct * 128 + bn, (size_t)256};
        EpiCmp1 ep{c.hb() + (size_t)which * 2048 * 256, rt * 128, ct * 128};
        gemm_tile(c.lds, al, bl, ep, 2048);
    }
    __syncthreads();
    for (int u = blockIdx.x; u < NB * 2 * 64; u += gridDim.x) win_unit(c, L, u);
    for (int u = blockIdx.x; u < NB * 2 * 64; u += gridDim.x) swa_unit(c, L, u);
}
__device__ __forceinline__ void ph_cmp2(const Ctx& c, int L) {
    const int ar = c.tid >> 2, bn = c.tid & 127;
    for (int u = blockIdx.x; u < 32; u += gridDim.x) {
        const int which = u >> 4, rt = u & 15;
        ALf32 al{c.hb() + (size_t)which * 2048 * 256 + (size_t)(rt * 128 + ar) * 256};
        BLf32 bl{bn < 64 ? (which ? c.w2_v() : c.w2_k()) + (size_t)L * 256 * 64 + bn : nullptr, (size_t)64};
        EpiCmp2 ep{c.kvc() + (size_t)which * 2048 * 64, rt * 128};
        gemm_tile(c.lds, al, bl, ep, 256);
    }
}
__device__ __forceinline__ void ph_nsa(const Ctx& c, int L) {
    for (int i = blockIdx.x; i < NB * 2 * 64; i += gridDim.x) {
        const int r = i >> 8, q = i & 255, bg = q >> 5, ci = q & 31;
        cmpslc_unit(c, L, bg * 64 + (r ? 63 - ci : ci));
    }
}
__device__ __forceinline__ void ph_outproj(const Ctx& c, int L, const float* xin) {
    pg8::Gemm g{c.o(), c.wot() + (size_t)L * DM * DM, MTOK, DM, DM}; pg8::StaticOrder S; S.init(MTOK, DM, (int)gridDim.x, (int)blockIdx.x);
    pg8::EpiF32Res E{c.y(), xin, c.b_out() + L * DM, DM, ALPHA};
    pg8::gemm_phase<pg8::EpiF32Res, pg8::StaticOrder, true, true>(c.lds, g, S, E);
}
__device__ __forceinline__ void ph_ln(const Ctx& c, const float* src, float sscale, const bf16* add, float* dst, const float* gam, const float* bet, bf16* dstb) {
    const int lane = c.lane;
    for (int r = blockIdx.x * 8 + c.wid; r < MTOK; r += gridDim.x * 8) {
        const f32x4* sp = (const f32x4*)(src + (size_t)r * DM) + lane;
        f32x4 v[8]; float s = 0.f;
#pragma unroll
        for (int j = 0; j < 8; ++j) { v[j] = sp[64 * j] * sscale; }
        if (add) {
            typedef unsigned u32x2 __attribute__((ext_vector_type(2)));
            const u32x2* a0 = (const u32x2*)(add + (size_t)(2 * r) * DM) + lane; const u32x2* a1 = (const u32x2*)(add + (size_t)(2 * r + 1) * DM) + lane;
#pragma unroll
            for (int j = 0; j < 8; ++j) { const u32x2 p0 = a0[64 * j], p1 = a1[64 * j];
                v[j].x += bf2f(p0.x & 0xffffu) + bf2f(p1.x & 0xffffu); v[j].y += bf2f(p0.x >> 16) + bf2f(p1.x >> 16);
                v[j].z += bf2f(p0.y & 0xffffu) + bf2f(p1.y & 0xffffu); v[j].w += bf2f(p0.y >> 16) + bf2f(p1.y >> 16); }
        }
#pragma unroll
        for (int j = 0; j < 8; ++j) s += (v[j].x + v[j].y) + (v[j].z + v[j].w);
        const float mean = wave_sum(s) * (1.f / DM); float s2 = 0.f;
#pragma unroll
        for (int j = 0; j < 8; ++j) { v[j] = v[j] - mean; s2 += (v[j].x * v[j].x + v[j].y * v[j].y) + (v[j].z * v[j].z + v[j].w * v[j].w); }
        const float rstd = 1.f / sqrtf(wave_sum(s2) * (1.f / DM) + LN_EPS);
        f32x4* dp = (f32x4*)(dst + (size_t)r * DM) + lane; const f32x4* gp = (const f32x4*)gam + lane; const f32x4* bp = (const f32x4*)bet + lane;
#pragma unroll
        for (int j = 0; j < 8; ++j) { v[j] = v[j] * rstd * gp[64 * j] + bp[64 * j]; dp[64 * j] = v[j]; }
        if (dstb) { unsigned long long* o8 = (unsigned long long*)(dstb + (size_t)r * DM) + lane;
#pragma unroll
            for (int j = 0; j < 8; ++j) o8[64 * j] = (unsigned long long)cvt_pk_bf16(v[j].x, v[j].y) | ((unsigned long long)cvt_pk_bf16(v[j].z, v[j].w) << 32); }
    }
}
__device__ __forceinline__ void ph_router(const Ctx& c, int L) {
    const int ar = c.tid >> 2, bn = c.tid & 127;
    const float* colp = nullptr; size_t ldb = 8;
    if (bn < 8) { colp = c.w_group() + (size_t)L * DM * 8 + bn; ldb = 8; } else if (bn < 72) { colp = c.w_expert() + (size_t)L * DM * 64 + (bn - 8); ldb = 64; }
    for (int u = blockIdx.x; u < 128; u += gridDim.x) {
        ALf32 al{c.x1() + (size_t)(u * 128 + ar) * DM};
        BLf32 bl{colp, ldb};
        EpiLogit ep{c.logits(), c.b_group() + L * 8, c.b_expert() + L * 64, u * 128};
        gemm_tile(c.lds, al, bl, ep, DM);
    }
}
__device__ __forceinline__ void ph_route(const Ctx& c, int L) {
    unsigned* cnt = c.cnt() + L * 64;
    for (int tok = blockIdx.x * 512 + c.tid; tok < MTOK; tok += gridDim.x * 512) {
        const float* lg = c.logits() + (size_t)tok * NLOG;
        float gl[8];
#pragma unroll
        for (int i = 0; i < 8; ++i) gl[i] = lg[i];
        int gs = 0; float gm = gl[0];
#pragma unroll
        for (int i = 1; i < 8; ++i) if (gl[i] > gm) { gm = gl[i]; gs = i; }
        float gsum = 0.f;
#pragma unroll
        for (int i = 0; i < 8; ++i) gsum += expf(gl[i] - gm);
        const float gw = 1.f / gsum;
        float el[8];
#pragma unroll
        for (int i = 0; i < 8; ++i) el[i] = lg[8 + gs * 8 + i];
        int i0 = 0; float v0 = el[0];
#pragma unroll
        for (int i = 1; i < 8; ++i) if (el[i] > v0) { v0 = el[i]; i0 = i; }
        int i1 = -1; float v1 = -INFINITY;
#pragma unroll
        for (int i = 0; i < 8; ++i) if (i != i0 && el[i] > v1) { v1 = el[i]; i1 = i; }
        const float e1 = expf(v1 - v0);
        const float w0 = gw / (1.f + e1), w1 = gw * e1 / (1.f + e1);
        const int ea = gs * 8 + i0, eb = gs * 8 + i1;
        const unsigned pa = atomicAdd(&cnt[ea], 1u); c.lslot()[(size_t)ea * LCAP + pa] = tok * 2; c.lw()[(size_t)ea * LCAP + pa] = w0;
        const unsigned pb = atomicAdd(&cnt[eb], 1u); c.lslot()[(size_t)eb * LCAP + pb] = tok * 2 + 1; c.lw()[(size_t)eb * LCAP + pb] = w1;
    }
}
__device__ __forceinline__ void moe_tables(const Ctx& c, int L) {
    LAS int* tab = (LAS int*)(c.lds + L_TAB);
    __syncthreads();
    if (c.tid < 64) tab[c.tid] = (int)c.cnt()[L * 64 + c.tid];
    __syncthreads();
    if (c.tid == 0) { int rb = 0, tb = 0; for (int e = 0; e < 64; ++e) { tab[64 + e] = rb; tab[128 + e] = tb; rb += tab[e]; tb += (tab[e] + 255) >> 8; } tab[192] = tb; }
    __syncthreads();
}
__device__ __forceinline__ int moe_find(const LAS int* tab, int rtg) { const int lane = threadIdx.x & 63; const unsigned long long m = __ballot(tab[128 + lane] <= rtg); return (int)__builtin_popcountll(m) - 1; }
__device__ __forceinline__ int vcu_id() { const int G = gridDim.x, bx = blockIdx.x; return (G % 8 == 0) ? (bx % 8) * (G / 8) + bx / 8 : bx; }
__device__ __forceinline__ void ph_moe1(const Ctx& c, int L) {
    moe_tables(c, L);
    const LAS int* tab = (const LAS int*)(c.lds + L_TAB);
    const int ntile = tab[192], lane = c.lane, tid = c.tid;
    for (int u = vcu_id(); u < ntile * 4; u += gridDim.x) {
        const int ct = u / ntile, rtg = u - ct * ntile; const int e = moe_find(tab, rtg); const int rt = rtg - tab[128 + e], cnt = tab[e], rowbase = tab[64 + e];
        int mvalid = cnt - rt * 256; if (mvalid > 256) mvalid = 256;
        const int* ls = c.lslot() + (size_t)e * LCAP + rt * 256;
        const bf16* ap[4];
#pragma unroll
        for (int i = 0; i < 4; ++i) { const int row = (tid >> 3) + 64 * i; const int slot = ls[row < mvalid ? row : 0]; ap[i] = c.x1b() + (size_t)(slot >> 1) * DM; }
        const int h0 = ct * 128;
        const int wcv = lane >> 4, nnv = (lane >> 2) & 3, within = 4 * (lane & 3);
        const float* Wsel = ((nnv >> 1) ? c.we_up() : c.we_gate()) + ((size_t)L * NE + e) * DM * EH;
        const float* bcol = Wsel + h0 + wcv * 32 + (nnv & 1) * 16 + within;
        mg::EpiGU ep{c.H(), rowbase + rt * 256, mvalid, h0};
        mg::tile(c.lds, ap[0], ap[1], ap[2], ap[3], bcol, (size_t)EH, DM, mvalid, ep);
    }
}
__device__ __forceinline__ void ph_moe2(const Ctx& c, int L) {
    moe_tables(c, L);
    const LAS int* tab = (const LAS int*)(c.lds + L_TAB);
    const int ntile = tab[192], lane = c.lane, tid = c.tid;
    for (int u = vcu_id(); u < ntile * 8; u += gridDim.x) {
        const int ct = u / ntile, rtg = u - ct * ntile; const int e = moe_find(tab, rtg); const int rt = rtg - tab[128 + e], cnt = tab[e], rowbase = tab[64 + e];
        int mvalid = cnt - rt * 256; if (mvalid > 256) mvalid = 256;
        const bf16* ap[4];
#pragma unroll
        for (int i = 0; i < 4; ++i) { const int row = (tid >> 3) + 64 * i; ap[i] = c.H() + (size_t)(rowbase + rt * 256 + (row < mvalid ? row : 0)) * EH; }
        const float* bcol = c.we_down() + ((size_t)L * NE + e) * EH * DM + ct * 256 + 4 * lane;
        mg::EpiDown ep{c.contribb(), c.lslot() + (size_t)e * LCAP + rt * 256, c.lw() + (size_t)e * LCAP + rt * 256, mvalid, ct * 256};
        mg::tile(c.lds, ap[0], ap[1], ap[2], ap[3], bcol, (size_t)DM, EH, mvalid, ep);
    }
}

__global__ void __launch_bounds__(512, 2) fwd(Args a) {
    extern __shared__ __attribute__((aligned(16))) unsigned char smem[];
    unsigned char* ws = a.ws;
    const int tid0 = threadIdx.x;
    volatile LAS unsigned* barw = (volatile LAS unsigned*)((LAS unsigned char*)smem + L_BARW);
    if (tid0 < 4) barw[tid0] = 0u;
    __syncthreads();
    const int lo = a.lo, hi = a.hi;
    XcdBarrier bar; bar.bar = (unsigned*)(ws + WS_CTL) + CW_BAR; bar.x = 0; bar.st = barw;
    if (hi - lo > 1) bar = xcd_barrier_post((unsigned*)(ws + WS_CTL) + CW_BAR, barw);
#ifndef PHMASK
#define PHMASK 0x7ff
#endif
#define IN(k) (((PHMASK >> ((k) % NPH)) & 1) && lo <= (k) && (k) < hi)
#ifndef DUPMASK
#define DUPMASK 0
#endif
#define DUP(k) ((DUPMASK >> ((k) % NPH)) & 1)
#define SEAM(k) do { if ((k) + 1 < hi) xcd_barrier(bar); } while (0)
#define PCTX() Ctx c; { int t_ = threadIdx.x; asm volatile("" : "+v"(t_)); c.tid = t_; c.lane = t_ & 63; c.wid = __builtin_amdgcn_readfirstlane(t_ >> 6); c.lds = (LAS unsigned char*)smem; c.a = &a; }
#define LAYER_BODY(L) { const int pb = (L) * NPH; \
        if (IN(pb + 0)) { PCTX(); ph_inproj(c, L, L == 0 ? c.x_in() : c.x2()); if (DUP(0)) { ph_inproj(c, L, L == 0 ? c.x_in() : c.x2()); } SEAM(pb + 0); } \
        if (IN(pb + 1)) { PCTX(); ph_cmp1_swa(c, L); if (DUP(1)) { ph_cmp1_swa(c, L); } SEAM(pb + 1); } \
        if (IN(pb + 2)) { PCTX(); ph_cmp2(c, L); if (DUP(2)) { ph_cmp2(c, L); } SEAM(pb + 2); } \
        if (IN(pb + 3)) { PCTX(); ph_nsa(c, L); if (DUP(3)) { ph_nsa(c, L); } SEAM(pb + 3); } \
        if (IN(pb + 4)) { PCTX(); ph_outproj(c, L, L == 0 ? c.x_in() : c.x2()); if (DUP(4)) { ph_outproj(c, L, L == 0 ? c.x_in() : c.x2()); } SEAM(pb + 4); } \
        if (IN(pb + 5)) { PCTX(); ph_ln(c, c.y(), 1.f, nullptr, c.x1(), c.ln1_g() + L * DM, c.ln1_b() + L * DM, c.x1b()); if (DUP(5)) { ph_ln(c, c.y(), 1.f, nullptr, c.x1(), c.ln1_g() + L * DM, c.ln1_b() + L * DM, c.x1b()); } SEAM(pb + 5); } \
        if (IN(pb + 6)) { PCTX(); ph_router(c, L); if (DUP(6)) { ph_router(c, L); } SEAM(pb + 6); } \
        if (IN(pb + 7)) { PCTX(); ph_route(c, L); if (DUP(7)) { ph_route(c, L); } SEAM(pb + 7); } \
        if (IN(pb + 8)) { PCTX(); ph_moe1(c, L); if (DUP(8)) { ph_moe1(c, L); } SEAM(pb + 8); } \
        if (IN(pb + 9)) { PCTX(); ph_moe2(c, L); if (DUP(9)) { ph_moe2(c, L); } SEAM(pb + 9); } \
        if (IN(pb + 10)) { PCTX(); ph_ln(c, c.x1(), ALPHA, c.contribb(), L == DEPTH - 1 ? c.out() : c.x2(), c.ln2_g() + L * DM, c.ln2_b() + L * DM, L == DEPTH - 1 ? nullptr : c.xb()); if (DUP(10)) { ph_ln(c, c.x1(), ALPHA, c.contribb(), L == DEPTH - 1 ? c.out() : c.x2(), c.ln2_g() + L * DM, c.ln2_b() + L * DM, L == DEPTH - 1 ? nullptr : c.xb()); } SEAM(pb + 10); } \
    }
    if (lo <= 0) { PCTX(); ph_prologue(c); if (hi > 0) xcd_barrier(bar); }
    LAYER_BODY(0)
    LAYER_BODY(1)
#undef IN
#undef SEAM
}

extern "C" void kernel_launch(void* const* d_in, const int* in_sizes, int n_in, void* d_out, int out_size, void* d_ws, size_t ws_size, hipStream_t stream) {
    static int grid = 0;
    if (grid == 0) {
        if (n_in != 23 || out_size != MTOK * DM || ws_size < WS_END) { fprintf(stderr, "kernel_launch: unexpected shapes (n_in %d out %d ws %zu)\n", n_in, out_size, ws_size); grid = -1; return; }
        int dev = 0, cus = 0;
        if (hipGetDevice(&dev) != hipSuccess || hipDeviceGetAttribute(&cus, hipDeviceAttributeMultiprocessorCount, dev) != hipSuccess) { grid = -1; return; }
        if (hipFuncSetAttribute((const void*)fwd, hipFuncAttributeMaxDynamicSharedMemorySize, LDS_BYTES) != hipSuccess) { fprintf(stderr, "kernel_launch: hipFuncSetAttribute failed\n"); grid = -1; return; }
        int per_cu = 0;
        (void)hipOccupancyMaxActiveBlocksPerMultiprocessor(&per_cu, (const void*)fwd, 512, LDS_BYTES);
        (void)hipGetLastError();
        grid = cus;
    }
    if (grid < 0) return;
    (void)hipMemsetAsync((char*)d_ws + WS_CTL, 0, CTL_BYTES, stream);
    Args a{};
    for (int i = 0; i < 23; ++i) a.in[i] = (const float*)d_in[i];
    a.out = (float*)d_out; a.ws = (unsigned char*)d_ws;
#if ONE_LAUNCH
    a.lo = 0; a.hi = DEPTH * NPH;
    hipLaunchKernelGGL(fwd, dim3(grid), dim3(512), LDS_BYTES, stream, a);
#else
    for (int k = 0; k < DEPTH * NPH; ++k) { a.lo = k; a.hi = k + 1; hipLaunchKernelGGL(fwd, dim3(grid), dim3(512), LDS_BYTES, stream, a); }
#endif
}
```

```cpp
#include <hip/hip_runtime.h>
#include <cstdio>
#include <cstdint>
#include <cmath>

#ifndef ONE_LAUNCH
#define ONE_LAUNCH 1
#endif


#define LAS __attribute__((address_space(3)))
typedef unsigned short bf16;
typedef short bf16x8 __attribute__((ext_vector_type(8)));
typedef float f32x4 __attribute__((ext_vector_type(4)));
typedef unsigned u32x4 __attribute__((ext_vector_type(4)));

constexpr int DM = 2048, SEQ = 4096, NB = 4, MTOK = NB * SEQ, DEPTH = 2;
constexpr int INC = 3120, PP = 3200;
constexpr int C_QA = 0, C_KA = 1024, C_VA = 1152, C_QN = 1280, C_KV = 2304, C_GN = 3072;
constexpr int NCMP = 255, CMPROWS = NB * NCMP * 2;
constexpr int NE = 64, EH = 512, LCAP = MTOK;
constexpr int NLOG = 80;
constexpr float ALPHA = 1.41421356237309515f;
constexpr float LN_EPS = 1e-5f;
constexpr int NPH = 11;

constexpr size_t MiB = 1u << 20;
constexpr size_t WS_CTL = 0, CTL_BYTES = 1 * MiB;
constexpr size_t WS_PROJ = 2 * MiB;
constexpr size_t WS_O = 102 * MiB;
constexpr size_t WS_Y = 166 * MiB;
constexpr size_t WS_X1 = 294 * MiB;
constexpr size_t WS_X2 = 422 * MiB;
constexpr size_t WS_HB = 550 * MiB;
constexpr size_t WS_KVC = 554 * MiB;
constexpr size_t WS_LOG = 555 * MiB;
constexpr size_t WS_LSLOT = 561 * MiB;
constexpr size_t WS_LW = 565 * MiB;
constexpr size_t WS_H = 569 * MiB;
constexpr size_t WS_CONTRIB = 601 * MiB;
constexpr size_t WS_WINT = 857 * MiB;
constexpr size_t WS_WOT = 881 * MiB;
constexpr size_t WS_XB = 897 * MiB;
constexpr size_t WS_X1B = 961 * MiB;
constexpr size_t WS_BG = 1025 * MiB;
constexpr size_t WS_BR = 1026 * MiB;
constexpr size_t WS_HB4 = 1027 * MiB;
constexpr size_t WS_END = 1043 * MiB;
constexpr int CW_BAR = 4096;
constexpr int CW_CNT = 16384;

constexpr int L_GEMM = 0;
constexpr int L_KV = 0;
constexpr int L_IMPA = 49152;
constexpr int L_IMPB = 65536;
constexpr int L_SEL = 82176;
constexpr int L_OCMP = 82944;
constexpr int L_TAB = 148480;
constexpr int L_BARW = 149504;
constexpr int LDS_BYTES = 150016;

__device__ __forceinline__ float bf2f(unsigned h) { return __uint_as_float(h << 16); }
__device__ __forceinline__ unsigned cvt_pk_bf16(float lo, float hi) { unsigned r; asm("v_cvt_pk_bf16_f32 %0, %1, %2" : "=v"(r) : "v"(lo), "v"(hi)); return r; }
__device__ __forceinline__ bf16 f2bf(float f) { return (bf16)(cvt_pk_bf16(f, 0.f) & 0xffffu); }
__device__ __forceinline__ float wave_sum(float v) {
#pragma unroll
    for (int o = 1; o < 64; o <<= 1) v += __shfl_xor(v, o);
    return v;
}
__device__ __forceinline__ float wave_max(float v) {
#pragma unroll
    for (int o = 1; o < 64; o <<= 1) v = fmaxf(v, __shfl_xor(v, o));
    return v;
}
__device__ __forceinline__ float gelu_tanh(float x) {
    const float u = 0.7978845608028654f * (x + 0.044715f * x * x * x);
    const float e = expf(2.f * u);
    const float th = 1.f - 2.f / (e + 1.f);
    return 0.5f * x * (1.f + th);
}
__device__ __forceinline__ float sigmoidf(float x) { return 1.f / (1.f + expf(-x)); }
__device__ __forceinline__ float rfl(float v) { return __builtin_bit_cast(float, __builtin_amdgcn_readfirstlane(__builtin_bit_cast(int, v))); }
#define WAVE_LDS_FENCE() do { asm volatile("s_waitcnt lgkmcnt(0)" ::: "memory"); __builtin_amdgcn_wave_barrier(); } while (0)

#define XB_TMO      128
#define XB_XCNT(j)  (256  + 64 * (j))
#define XB_XSUB(j)  (1280 + 64 * (j))
#define XB_XGEN(j)  (2304 + 64 * (j))
#define XB_TOP      3328
#define XB_TOPGEN   3392
#define XCD_BAR_WORDS 3456
#define XB_SPIN_CAP (1u << 24)

__device__ __forceinline__ unsigned xb_ld(unsigned* p)              { return __hip_atomic_load(p, __ATOMIC_RELAXED, __HIP_MEMORY_SCOPE_AGENT); }
__device__ __forceinline__ unsigned xb_add(unsigned* p, unsigned v) { return __hip_atomic_fetch_add(p, v, __ATOMIC_RELAXED, __HIP_MEMORY_SCOPE_AGENT); }
__device__ __forceinline__ unsigned xb_xcc_id() { return (unsigned)__builtin_amdgcn_s_getreg((3 << 11) | 20) & 0xFu; }
#define XB_SPIN(cond, bar) do { unsigned _sp = 0; while (cond) { __builtin_amdgcn_s_sleep(1); \
    if ((++_sp & 255u) == 0u) { if (xb_ld(&(bar)[XB_TMO])) break; if (_sp > XB_SPIN_CAP) { atomicAdd(&(bar)[XB_TMO], 1u); break; } } } } while (0)

struct XcdBarrier { unsigned* bar; unsigned x; volatile LAS unsigned* st; };

__device__ __forceinline__ XcdBarrier xcd_barrier_post(unsigned* bar, volatile LAS unsigned* st) {
    XcdBarrier b; b.bar = bar; b.x = xb_xcc_id(); b.st = st;
    if (threadIdx.x == 0) (void)xb_add(&bar[XB_XCNT(b.x)], 1u);
    return b;
}
__device__ __forceinline__ void xcd_barrier_complete(unsigned* bar, unsigned x, unsigned& nloc, unsigned& nx) {
    const unsigned G = gridDim.x * gridDim.y * gridDim.z;
    unsigned sum, cnt, mine, sp = 0u;
    for (;;) {
        sum = 0u; cnt = 0u; mine = 0u;
#pragma unroll
        for (unsigned j = 0; j < 16; ++j) { const unsigned c = xb_ld(&bar[XB_XCNT(j)]); sum += c; cnt += (c > 0u) ? 1u : 0u; mine = (j == x) ? c : mine; }
        if (sum == G) break;
        __builtin_amdgcn_s_sleep(1);
        if ((++sp & 255u) == 0u) { if (xb_ld(&bar[XB_TMO])) break; if (sp > XB_SPIN_CAP) { atomicAdd(&bar[XB_TMO], 1u); break; } }
    }
    nloc = mine > 0u ? mine : 1u; nx = cnt > 0u ? cnt : 1u;
}
__device__ __forceinline__ void xcd_barrier(const XcdBarrier& b) {
    asm volatile("s_waitcnt vmcnt(0)" ::: "memory");
    __syncthreads();
    if (threadIdx.x == 0) {
        unsigned* bar = b.bar;
        __builtin_amdgcn_s_waitcnt(0);
        unsigned nloc = b.st[0], nx = b.st[1];
        if (nloc == 0u) { xcd_barrier_complete(bar, b.x, nloc, nx); b.st[0] = nloc; b.st[1] = nx; }
        const unsigned old = xb_add(&bar[XB_XSUB(b.x)], 1u);
        const unsigned gen = old / nloc;
        if (old + 1u == (gen + 1u) * nloc) {
            __builtin_amdgcn_fence(__ATOMIC_RELEASE, "agent");
            asm volatile("s_waitcnt vmcnt(0)" ::: "memory");
            const unsigned og = xb_add(&bar[XB_TOP], 1u);
            const unsigned tg = og / nx;
            if (og + 1u == (tg + 1u) * nx) xb_add(&bar[XB_TOPGEN], 1u);
            else XB_SPIN(xb_ld(&bar[XB_TOPGEN]) == tg, bar);
            __builtin_amdgcn_fence(__ATOMIC_ACQUIRE, "agent");
            xb_add(&bar[XB_XGEN(b.x)], 1u);
            asm volatile("s_waitcnt vmcnt(0)" ::: "memory");
        } else {
            XB_SPIN(xb_ld(&bar[XB_XGEN(b.x)]) == gen, bar);
            __builtin_amdgcn_fence(__ATOMIC_ACQUIRE, "agent");
            asm volatile("s_waitcnt vmcnt(0)" ::: "memory");
        }
    }
    __syncthreads();
}

template <class AL, class BL, class EP>
__device__ __forceinline__ void gemm_tile(LAS unsigned char* lds, const AL& al, const BL& bl, const EP& ep, int K) {
    const int tid = threadIdx.x, wid = tid >> 6, lane = tid & 63, wr = wid >> 2, wc = wid & 3, fr = lane & 15, fq = lane >> 4;
    LAS bf16* As = (LAS bf16*)(lds + L_GEMM);
    LAS bf16* Bs = As + 128 * 40;
    const int ar = tid >> 2, akq = (tid & 3) * 8;
    const int bn = tid & 127, bkg = (tid >> 7) * 8;
    f32x4 acc[4][2];
#pragma unroll
    for (int m = 0; m < 4; ++m)
#pragma unroll
        for (int n = 0; n < 2; ++n) acc[m][n] = (f32x4){0.f, 0.f, 0.f, 0.f};
    bf16x8 ra = al.load(akq);
    float rb0 = bl.load(bkg + 0), rb1 = bl.load(bkg + 1), rb2 = bl.load(bkg + 2), rb3 = bl.load(bkg + 3),
          rb4 = bl.load(bkg + 4), rb5 = bl.load(bkg + 5), rb6 = bl.load(bkg + 6), rb7 = bl.load(bkg + 7);
    for (int k0 = 0; k0 < K; k0 += 32) {
        *(LAS bf16x8*)(As + ar * 40 + akq) = ra;
        u32x4 pb; pb.x = cvt_pk_bf16(rb0, rb1); pb.y = cvt_pk_bf16(rb2, rb3); pb.z = cvt_pk_bf16(rb4, rb5); pb.w = cvt_pk_bf16(rb6, rb7);
        *(LAS u32x4*)(Bs + bn * 40 + bkg) = pb;
        __syncthreads();
        if (k0 + 32 < K) {
            const int kn = k0 + 32;
            ra = al.load(kn + akq);
            rb0 = bl.load(kn + bkg + 0); rb1 = bl.load(kn + bkg + 1); rb2 = bl.load(kn + bkg + 2); rb3 = bl.load(kn + bkg + 3);
            rb4 = bl.load(kn + bkg + 4); rb5 = bl.load(kn + bkg + 5); rb6 = bl.load(kn + bkg + 6); rb7 = bl.load(kn + bkg + 7);
        }
        bf16x8 af[4], bfr[2];
#pragma unroll
        for (int m = 0; m < 4; ++m) af[m] = *(const LAS bf16x8*)(As + (wr * 64 + m * 16 + fr) * 40 + fq * 8);
#pragma unroll
        for (int n = 0; n < 2; ++n) bfr[n] = *(const LAS bf16x8*)(Bs + (wc * 32 + n * 16 + fr) * 40 + fq * 8);
#pragma unroll
        for (int m = 0; m < 4; ++m)
#pragma unroll
            for (int n = 0; n < 2; ++n) acc[m][n] = __builtin_amdgcn_mfma_f32_16x16x32_bf16(af[m], bfr[n], acc[m][n], 0, 0, 0);
        __syncthreads();
    }
    ep(acc, wr, wc, fr, fq);
}

__device__ __forceinline__ bf16x8 pack8(f32x4 a, f32x4 b) {
    u32x4 p; p.x = cvt_pk_bf16(a.x, a.y); p.y = cvt_pk_bf16(a.z, a.w); p.z = cvt_pk_bf16(b.x, b.y); p.w = cvt_pk_bf16(b.z, b.w);
    return __builtin_bit_cast(bf16x8, p);
}
__device__ __forceinline__ bf16x8 zero8() { u32x4 p = {0u, 0u, 0u, 0u}; return __builtin_bit_cast(bf16x8, p); }

struct ALf32 { const float* rowp; __device__ __forceinline__ bf16x8 load(int k) const { if (!rowp) return zero8(); const f32x4 a = *(const f32x4*)(rowp + k), b = *(const f32x4*)(rowp + k + 4); return pack8(a, b); } };
struct ALbf16 { const bf16* rowp; __device__ __forceinline__ bf16x8 load(int k) const { if (!rowp) return zero8(); return *(const bf16x8*)(rowp + k); } };
struct ALcmp { const bf16* base; const float* pe; int koff; __device__ __forceinline__ bf16x8 load(int kk) const {
        if (!base) return zero8();
        const int k = kk + koff;
        const int l = k >> 6, d = k & 63;
        const u32x4 v = *(const u32x4*)(base + (size_t)l * PP + d);
        const f32x4 p0 = *(const f32x4*)(pe + k), p1 = *(const f32x4*)(pe + k + 4);
        f32x4 a, b;
        a.x = bf2f(v.x & 0xffffu) + p0.x; a.y = bf2f(v.x >> 16) + p0.y; a.z = bf2f(v.y & 0xffffu) + p0.z; a.w = bf2f(v.y >> 16) + p0.w;
        b.x = bf2f(v.z & 0xffffu) + p1.x; b.y = bf2f(v.z >> 16) + p1.y; b.z = bf2f(v.w & 0xffffu) + p1.z; b.w = bf2f(v.w >> 16) + p1.w;
        return pack8(a, b); } };
struct ALsum4gelu { const float* rowp; size_t pstride; __device__ __forceinline__ bf16x8 load(int k) const {
        f32x4 a = *(const f32x4*)(rowp + k), b = *(const f32x4*)(rowp + k + 4);
#pragma unroll
        for (int s = 1; s < 4; ++s) { a = a + *(const f32x4*)(rowp + s * pstride + k); b = b + *(const f32x4*)(rowp + s * pstride + k + 4); }
        a.x = gelu_tanh(a.x); a.y = gelu_tanh(a.y); a.z = gelu_tanh(a.z); a.w = gelu_tanh(a.w);
        b.x = gelu_tanh(b.x); b.y = gelu_tanh(b.y); b.z = gelu_tanh(b.z); b.w = gelu_tanh(b.w);
        return pack8(a, b); } };
struct BLf32 { const float* colp; size_t ldb; __device__ __forceinline__ float load(int k) const { return colp ? colp[(size_t)k * ldb] : 0.f; } };

namespace pg8 {
#define PG8_LAS __attribute__((address_space(3)))
typedef unsigned short bf16_t;
typedef short bf16x8 __attribute__((ext_vector_type(8)));
typedef float f32x4 __attribute__((ext_vector_type(4)));
typedef unsigned u32x4 __attribute__((ext_vector_type(4)));
constexpr int BM = 256, BK = 64, HALF = 128, HTB = HALF * BK * 2  , STAGE_BYTES = 8 * HTB, NXCD = 8, WGM = 8;

__host__ __device__ __forceinline__ int lds_byte(int r, int c) { const int st = (r >> 4) * 2 + (c >> 5), rr = r & 15, cc = c & 31, ob = rr * 64 + cc * 2; return st * 1024 + (ob ^ (((ob >> 9) & 1) << 5)); }
__host__ __device__ __forceinline__ void stage_rc(int b, int& R, int& C) { const int st = b / 1024, sb = b % 1024, swz = sb ^ (((sb >> 9) & 1) << 5); R = (st >> 1) * 16 + swz / 64; C = (st & 1) * 32 + (swz % 64) / 2; }
__host__ __device__ __forceinline__ int perm32(int rho) { const int n = rho >> 4, i = rho & 15; return 8 * (i >> 2) + 4 * n + (i & 3); }

struct Unit { int pm, pn; };
struct Gemm { const bf16_t* A; const bf16_t* Bt; int M, N, K; };

struct StaticOrder {
    int nM, nN, nwg, G, c;
    __host__ __device__ void init(int M, int N, int G_, int c_) { nM = M / BM; nN = N / BM; nwg = nM * nN; G = G_; c = c_; }
    __host__ __device__ bool next(int i, Unit& u) const {
        const long L = (long)i * G + c; if (L >= nwg) return false;
        int wgid = (int)L; { const int q = nwg / NXCD, r = nwg % NXCD, xcd = wgid % NXCD, off = wgid / NXCD; wgid = (xcd < r ? xcd * (q + 1) : r * (q + 1) + (xcd - r) * q) + off; }
        const int nig = WGM * nN, gid = wgid / nig, fm = gid * WGM, gsz = (nM - fm) < WGM ? (nM - fm) : WGM;
        u.pm = fm + ((wgid % nig) % gsz); u.pn = (wgid % nig) / gsz; return true;
    }
    __device__ __forceinline__ void a_ready(const Unit&) const {}
    __device__ __forceinline__ void done(const Unit&) const {}
};

__device__ __forceinline__ unsigned cvt_pk_bf16(float lo, float hi) { unsigned r; asm volatile("v_cvt_pk_bf16_f32 %0, %1, %2" : "=v"(r) : "v"(lo), "v"(hi)); return r; }
typedef float f32x2 __attribute__((ext_vector_type(2)));
__device__ __forceinline__ f32x2 gelu_pk(f32x2 v) {
    const f32x2 av = __builtin_elementwise_abs(v), d = av * 0.2316418882f + 1.0f;
    f32x2 t; t.x = __builtin_amdgcn_rcpf(d.x); t.y = __builtin_amdgcn_rcpf(d.y);
    f32x2 q = t * 0.5307027145f + (-0.7265760135f); q = q * t + 0.7107068705f; q = q * t + (-0.142248368f); q = q * t + 0.127414796f; q = q * t;
    const f32x2 s = (v * v) * (-0.72134752044f);
    f32x2 e; e.x = __builtin_amdgcn_exp2f(s.x); e.y = __builtin_amdgcn_exp2f(s.y);
    const f32x2 m = v * (q * e), r = v - m;
    f32x2 o; o.x = v.x < 0.f ? m.x : r.x; o.y = v.y < 0.f ? m.y : r.y; return o;
}

template <int ACT  > struct EpiBf16 {
    static constexpr bool PERM = true, AFTER_DRAIN = false; static_assert(ACT == 0 || ACT == 1, "EpiBf16: ACT is 0 (none) or 1 (gelu_pk)");
    bf16_t* O; int ldc; const float* bias; int split_cols; size_t split_stride; float scale0;
    __device__ __forceinline__ void operator()(const f32x4 (&acc)[2][2][4][2], const Unit& u, int wr, int wc, int fr, int fq) const {
        const int row0 = u.pm * BM + wr * 64 + fr; int colt = u.pn * BM; bf16_t* base = O;
        float sc = 1.f; if (split_cols) { const int t = colt / split_cols; base += (size_t)t * split_stride; colt -= t * split_cols; if (t == 0) sc = scale0; }
        const int col0 = colt + wc * 32 + 8 * fq, bcol0 = u.pn * BM + wc * 32 + 8 * fq;
        f32x4 bv[2][2];
#pragma unroll
        for (int bj = 0; bj < 2; ++bj)
#pragma unroll
            for (int n = 0; n < 2; ++n) bv[bj][n] = bias ? *(const f32x4*)(bias + bcol0 + bj * HALF + 4 * n) : (f32x4){0.f, 0.f, 0.f, 0.f};
#pragma unroll
        for (int ai = 0; ai < 2; ++ai)
#pragma unroll
            for (int m = 0; m < 4; ++m) { bf16_t* rowp = base + (size_t)(row0 + ai * HALF + m * 16) * ldc + col0;
#pragma unroll
                for (int bj = 0; bj < 2; ++bj) { f32x4 v0 = acc[ai][bj][m][0] + bv[bj][0], v1 = acc[ai][bj][m][1] + bv[bj][1];
                    if (ACT == 1) { f32x2 a = gelu_pk((f32x2){v0[0], v0[1]}), b = gelu_pk((f32x2){v0[2], v0[3]}), c = gelu_pk((f32x2){v1[0], v1[1]}), d = gelu_pk((f32x2){v1[2], v1[3]});
                        v0 = (f32x4){a.x, a.y, b.x, b.y}; v1 = (f32x4){c.x, c.y, d.x, d.y}; }
                    v0 = v0 * sc; v1 = v1 * sc; u32x4 w; w.x = cvt_pk_bf16(v0[0], v0[1]); w.y = cvt_pk_bf16(v0[2], v0[3]); w.z = cvt_pk_bf16(v1[0], v1[1]); w.w = cvt_pk_bf16(v1[2], v1[3]);
                    *(u32x4*)(rowp + bj * HALF) = w; } }
    }
};

template <class Epi, class Sched, bool ALIGN_EPI = false, bool SP2 = false>
__device__ __forceinline__ void gemm_phase(PG8_LAS unsigned char* lds, const Gemm g, const Sched& S, const Epi& E) {
    const int tid = threadIdx.x, wid = __builtin_amdgcn_readfirstlane(tid >> 6), lane = tid & 63, wr = wid >> 2, wc = wid & 3, fr = lane & 15, fq = lane >> 4;
    const int K = g.K, nt = K / BK;
    unsigned voffA[2], voffB[2];
#pragma unroll
    for (int i = 0; i < 2; ++i) { int R, C; stage_rc(tid * 16 + i * 8192, R, C); const int Rb = Epi::PERM ? ((R & ~31) + perm32(R & 31)) : R;
        voffA[i] = (unsigned)(R * K + C) * 2u; voffB[i] = (unsigned)(Rb * K + C) * 2u; }
    const size_t kstep = (size_t)(BK * 2);
    const size_t hstep = (size_t)HALF * K * 2;
    const size_t tstep = 2 * hstep;
    const unsigned ldsw = (unsigned)wid * 1024u;
    const int aoff = lds_byte(wr * 64 + fr, fq * 8), boff = lds_byte(wc * 32 + fr, fq * 8);
#define PG8_SA(b, h) (((b) * 2 + (h)) * HTB)
#define PG8_SB(b, h) ((4 + (b) * 2 + (h)) * HTB)
#define PG8_STAGE(bufoff, gbase, voff) do { _Pragma("unroll") for (int _i = 0; _i < 2; ++_i) \
        __builtin_amdgcn_global_load_lds((const unsigned*)((const char*)(gbase) + (voff)[_i]), (PG8_LAS unsigned*)(lds + (bufoff) + ldsw + _i * 8192), 16, 0, 0); } while (0)
#define PG8_LDA(dst, b, h) do { _Pragma("unroll") for (int m = 0; m < 4; ++m) _Pragma("unroll") for (int k = 0; k < 2; ++k) dst[m][k] = *(const PG8_LAS bf16x8*)(lds + PG8_SA(b, h) + aoff + m * 2048 + k * 1024); } while (0)
#define PG8_LDB(dst, b, h) do { _Pragma("unroll") for (int n = 0; n < 2; ++n) _Pragma("unroll") for (int k = 0; k < 2; ++k) dst[n][k] = *(const PG8_LAS bf16x8*)(lds + PG8_SB(b, h) + boff + n * 2048 + k * 1024); } while (0)
#define PG8_MMA(ai, bj, At, Bt) do { __builtin_amdgcn_s_setprio(1); _Pragma("unroll") for (int m = 0; m < 4; ++m) _Pragma("unroll") for (int n = 0; n < 2; ++n) _Pragma("unroll") for (int k = 0; k < 2; ++k) \
        acc[ai][bj][m][n] = __builtin_amdgcn_mfma_f32_16x16x32_bf16(Bt[n][k], At[m][k], acc[ai][bj][m][n], 0, 0, 0); __builtin_amdgcn_s_setprio(0); } while (0)
#define PG8_WAIT_V(n) asm volatile("s_waitcnt vmcnt(" #n ")" ::: "memory")
#define PG8_WAIT_L(n) asm volatile("s_waitcnt lgkmcnt(" #n ")" ::: "memory")
#define PG8_BAR __builtin_amdgcn_s_barrier()
#define PG8_SCHED __builtin_amdgcn_sched_barrier(0)
    Unit cur, nxt; int ui = 0;
    if (!S.next(0, cur)) return;
    f32x4 acc[2][2][4][2];
#pragma unroll
    for (int a = 0; a < 2; ++a)
#pragma unroll
        for (int b = 0; b < 2; ++b)
#pragma unroll
            for (int m = 0; m < 4; ++m)
#pragma unroll
                for (int n = 0; n < 2; ++n) acc[a][b][m][n] = (f32x4){0.f, 0.f, 0.f, 0.f};
    bf16x8 At[4][2], B0[2][2], B1[2][2];
    const char* cA = (const char*)g.A + (size_t)cur.pm * tstep; const char* cB = (const char*)g.Bt + (size_t)cur.pn * tstep;
    S.a_ready(cur);
    if constexpr (SP2) {
        PG8_STAGE(PG8_SB(0, 0), cB, voffB); PG8_STAGE(PG8_SB(0, 1), cB + hstep, voffB); PG8_STAGE(PG8_SA(0, 0), cA, voffA); PG8_STAGE(PG8_SA(0, 1), cA + hstep, voffA);
        if (wr == 1) PG8_BAR;
        PG8_WAIT_V(2); PG8_BAR;
        PG8_STAGE(PG8_SB(1, 0), cB + kstep, voffB); PG8_STAGE(PG8_SA(1, 0), cA + kstep, voffA); PG8_STAGE(PG8_SB(1, 1), cB + hstep + kstep, voffB);
        PG8_WAIT_V(6); PG8_BAR;
    } else {
        PG8_STAGE(PG8_SB(0, 0), cB, voffB); PG8_STAGE(PG8_SA(0, 0), cA, voffA); PG8_STAGE(PG8_SB(0, 1), cB + hstep, voffB); PG8_STAGE(PG8_SA(0, 1), cA + hstep, voffA);
        if (wr == 1) PG8_BAR;
        PG8_WAIT_V(4); PG8_BAR;
        PG8_STAGE(PG8_SB(1, 0), cB + kstep, voffB); PG8_STAGE(PG8_SA(1, 0), cA + kstep, voffA); PG8_STAGE(PG8_SB(1, 1), cB + hstep + kstep, voffB);
        PG8_WAIT_V(6); PG8_BAR;
    }
    for (;;) {
        const bool has_next = S.next(ui + 1, nxt);
        const char* nA = has_next ? (const char*)g.A + (size_t)nxt.pm * tstep : cA; const char* nB = has_next ? (const char*)g.Bt + (size_t)nxt.pn * tstep : cB;
        for (int t = 0; t < nt; t += 2) {
            const bool last = (t == nt - 2);
            const char* a1 = cA + (size_t)(t + 1) * kstep;
            const char* a2 = last ? nA : cA + (size_t)(t + 2) * kstep; const char* b2 = last ? nB : cB + (size_t)(t + 2) * kstep;
            const char* a3 = a2 + kstep; const char* b3 = b2 + kstep;
            if (last && has_next) S.a_ready(nxt);
            if constexpr (SP2) {
            PG8_LDB(B0, 0, 0); PG8_LDB(B1, 0, 1); PG8_SCHED; PG8_LDA(At, 0, 0); PG8_STAGE(PG8_SA(1, 1), a1 + hstep, voffA);
            PG8_WAIT_V(8); PG8_WAIT_L(0); PG8_BAR; PG8_MMA(0, 0, At, B0); PG8_MMA(0, 1, At, B1); PG8_BAR; PG8_SCHED;
            PG8_LDA(At, 0, 1); PG8_STAGE(PG8_SB(0, 0), b2, voffB); PG8_STAGE(PG8_SB(0, 1), b2 + hstep, voffB); PG8_STAGE(PG8_SA(0, 0), a2, voffA);
            PG8_WAIT_V(8); PG8_WAIT_L(0); PG8_BAR; PG8_MMA(1, 0, At, B0); PG8_MMA(1, 1, At, B1); PG8_BAR; PG8_SCHED;
            PG8_LDB(B0, 1, 0); PG8_LDB(B1, 1, 1); PG8_SCHED; PG8_LDA(At, 1, 0); PG8_STAGE(PG8_SA(0, 1), a2 + hstep, voffA);
            PG8_WAIT_V(8); PG8_WAIT_L(0); PG8_BAR; PG8_MMA(0, 0, At, B0); PG8_MMA(0, 1, At, B1); PG8_BAR; PG8_SCHED;
            PG8_LDA(At, 1, 1); PG8_STAGE(PG8_SB(1, 0), b3, voffB); PG8_STAGE(PG8_SB(1, 1), b3 + hstep, voffB); PG8_STAGE(PG8_SA(1, 0), a3, voffA);
            PG8_WAIT_V(8); PG8_WAIT_L(0); PG8_BAR; PG8_MMA(1, 0, At, B0); PG8_MMA(1, 1, At, B1); PG8_BAR; PG8_SCHED;
            } else {
            PG8_LDB(B0, 0, 0); PG8_SCHED; PG8_LDA(At, 0, 0); PG8_STAGE(PG8_SA(1, 1), a1 + hstep, voffA);
            PG8_WAIT_L(8); PG8_BAR; PG8_WAIT_L(0); PG8_MMA(0, 0, At, B0); PG8_BAR; PG8_SCHED;
            PG8_LDB(B1, 0, 1); PG8_STAGE(PG8_SB(0, 0), b2, voffB);
            PG8_BAR; PG8_WAIT_L(0); PG8_MMA(0, 1, At, B1); PG8_BAR;
            PG8_LDA(At, 0, 1); PG8_STAGE(PG8_SA(0, 0), a2, voffA);
            PG8_BAR; PG8_WAIT_L(0); PG8_MMA(1, 0, At, B0); PG8_BAR; PG8_SCHED;
            PG8_STAGE(PG8_SB(0, 1), b2 + hstep, voffB);
            PG8_WAIT_V(6); PG8_BAR; PG8_MMA(1, 1, At, B1); PG8_BAR;
            PG8_LDB(B0, 1, 0); PG8_SCHED; PG8_LDA(At, 1, 0); PG8_STAGE(PG8_SA(0, 1), a2 + hstep, voffA);
            PG8_WAIT_L(8); PG8_BAR; PG8_WAIT_L(0); PG8_MMA(0, 0, At, B0); PG8_BAR; PG8_SCHED;
            PG8_LDB(B1, 1, 1); PG8_STAGE(PG8_SB(1, 0), b3, voffB);
            PG8_BAR; PG8_WAIT_L(0); PG8_MMA(0, 1, At, B1); PG8_BAR;
            PG8_LDA(At, 1, 1); PG8_STAGE(PG8_SA(1, 0), a3, voffA);
            PG8_BAR; PG8_WAIT_L(0); PG8_MMA(1, 0, At, B0); PG8_BAR; PG8_SCHED;
            PG8_STAGE(PG8_SB(1, 1), b3 + hstep, voffB);
            PG8_WAIT_V(6); PG8_BAR; PG8_MMA(1, 1, At, B1); PG8_BAR;
            }
        }
        if constexpr (ALIGN_EPI) { if (wr == 0) PG8_BAR; }
        if constexpr (!Epi::AFTER_DRAIN) { E(acc, cur, wr, wc, fr, fq); S.done(cur); }
        if (!has_next) break;
#pragma unroll
        for (int a = 0; a < 2; ++a)
#pragma unroll
            for (int b = 0; b < 2; ++b)
#pragma unroll
                for (int m = 0; m < 4; ++m)
#pragma unroll
                    for (int n = 0; n < 2; ++n) acc[a][b][m][n] = (f32x4){0.f, 0.f, 0.f, 0.f};
        cur = nxt; cA = nA; cB = nB; ++ui;
        if constexpr (ALIGN_EPI) { if (wr == 1) PG8_BAR; }
    }
    PG8_WAIT_V(0);
    if constexpr (!ALIGN_EPI) { if (wr == 0) PG8_BAR; }
    PG8_BAR;
    if constexpr (Epi::AFTER_DRAIN) { E.fused(acc, cur, wr, wc, fr, fq, lds, wid, lane); S.done(cur); }
#undef PG8_SA
#undef PG8_SB
#undef PG8_STAGE
#undef PG8_LDA
#undef PG8_LDB
#undef PG8_MMA
#undef PG8_WAIT_V
#undef PG8_WAIT_L
#undef PG8_BAR
#undef PG8_SCHED
}
}

namespace pg8 {
struct EpiF32Res {
    static constexpr bool PERM = false, AFTER_DRAIN = false;
    float* Y; const float* res; const bf16_t* resb; const float* bias; int ldc; float alpha;
    __device__ __forceinline__ void operator()(const f32x4 (&acc)[2][2][4][2], const Unit& u, int wr, int wc, int fr, int fq) const {
        typedef unsigned u32x2 __attribute__((ext_vector_type(2)));
        const int row0 = u.pm * BM + wr * 64 + fr, col0 = u.pn * BM + wc * 32 + 4 * fq;
#pragma unroll
        for (int ai = 0; ai < 2; ++ai)
#pragma unroll
            for (int m = 0; m < 4; ++m) { const size_t off = (size_t)(row0 + ai * HALF + m * 16) * ldc + col0;
#pragma unroll
                for (int bj = 0; bj < 2; ++bj)
#pragma unroll
                    for (int n = 0; n < 2; ++n) { const int cofs = bj * HALF + n * 16;
                        const f32x4 bv = *(const f32x4*)(bias + col0 + cofs); f32x4 rv;
                        if (res) rv = *(const f32x4*)(res + off + cofs);
                        else { const u32x2 rw = *(const u32x2*)(resb + off + cofs); rv.x = __uint_as_float(rw.x << 16); rv.y = __uint_as_float(rw.x & 0xffff0000u); rv.z = __uint_as_float(rw.y << 16); rv.w = __uint_as_float(rw.y & 0xffff0000u); }
                        *(f32x4*)(Y + off + cofs) = acc[ai][bj][m][n] + bv + rv * alpha; } }
    }
};
}

namespace mg {
constexpr int A_STAGE = 256 * 64 * 2, B_STAGE = 64 * 256 * 2;
typedef short s16x4 __attribute__((ext_vector_type(4)));
#define MG_OPAQUE(x) asm volatile("" : "+v"(x))
template <class EP>
__device__ __forceinline__ void tile(LAS unsigned char* lds, const bf16* a0, const bf16* a1, const bf16* a2, const bf16* a3, const float* bcol, const size_t ldb,
                                     const int K, const int mvalid, const EP& ep) {
    const int tid = threadIdx.x, w = __builtin_amdgcn_readfirstlane(tid >> 6), lane = tid & 63, wr = w >> 2, wc = w & 3, fr = lane & 15, fq = lane >> 4;
    const int achunk = ((tid & 7) ^ ((tid >> 4) & 7)) * 8;
    a0 += achunk; a1 += achunk; a2 += achunk; a3 += achunk;
    unsigned ard0 = (unsigned)(size_t)lds + (wr * 128 + fr) * 128 + ((fq ^ ((fr >> 1) & 7)) * 16);
    unsigned ard1 = (unsigned)(size_t)lds + (wr * 128 + fr) * 128 + (((4 + fq) ^ ((fr >> 1) & 7)) * 16);
    const int q = fr >> 2, p = fr & 3, rkey = q + 4 * (fq & 1);
    unsigned brd[4];
#pragma unroll
    for (int nn = 0; nn < 4; ++nn) brd[nn] = (unsigned)(size_t)lds + 2 * A_STAGE + (8 * fq + q) * 512 + (((wc * 4 + nn) ^ rkey) << 5) + p * 8;
    unsigned bwr[4];
#pragma unroll
    for (int j = 0; j < 4; ++j) bwr[j] = (unsigned)(size_t)lds + 2 * A_STAGE + (8 * w + j) * 512 + ((((lane >> 2) ^ (j + 4 * (w & 1)))) << 5) + (lane & 3) * 8;
    MG_OPAQUE(ard0); MG_OPAQUE(ard1);
#pragma unroll
    for (int j = 0; j < 4; ++j) { MG_OPAQUE(brd[j]); MG_OPAQUE(bwr[j]); }
    int mlim = (mvalid - wr * 128 + 15) >> 4; mlim = mlim < 0 ? 0 : (mlim > 8 ? 8 : mlim);
    const float* bp = bcol + (size_t)(8 * w) * ldb;
    f32x4 acc[8][4];
#pragma unroll
    for (int m = 0; m < 8; ++m)
#pragma unroll
        for (int nn = 0; nn < 4; ++nn) acc[m][nn] = (f32x4){0.f, 0.f, 0.f, 0.f};
    f32x4 rb[8];
    LAS unsigned char* const Aw = lds + w * 1024;
#define MG_DMA(BUF, k0) do { \
        __builtin_amdgcn_global_load_lds((const unsigned*)(a0 + (k0)), (LAS unsigned*)(Aw + (BUF) * A_STAGE), 16, 0, 0); \
        __builtin_amdgcn_global_load_lds((const unsigned*)(a1 + (k0)), (LAS unsigned*)(Aw + (BUF) * A_STAGE + 8192), 16, 0, 0); \
        __builtin_amdgcn_global_load_lds((const unsigned*)(a2 + (k0)), (LAS unsigned*)(Aw + (BUF) * A_STAGE + 16384), 16, 0, 0); \
        __builtin_amdgcn_global_load_lds((const unsigned*)(a3 + (k0)), (LAS unsigned*)(Aw + (BUF) * A_STAGE + 24576), 16, 0, 0); } while (0)
#define MG_BLOAD(k0) do { const float* p_ = bp + (size_t)(k0) * ldb; \
        _Pragma("unroll") for (int i = 0; i < 8; ++i) rb[i] = *(const f32x4*)(p_ + (size_t)i * ldb); } while (0)
#define MG_BWRITE(BUF) do { \
        _Pragma("unroll") for (int i = 0; i < 8; ++i) { typedef unsigned u32x2 __attribute__((ext_vector_type(2))); u32x2 pk; pk.x = cvt_pk_bf16(rb[i].x, rb[i].y); pk.y = cvt_pk_bf16(rb[i].z, rb[i].w); \
            *(LAS u32x2*)(size_t)(bwr[i & 3] + (BUF) * B_STAGE + (i >> 2) * 2048) = pk; } } while (0)
#define MG_COMPUTE(BUF) do { \
        _Pragma("unroll") for (int ks = 0; ks < 2; ++ks) { \
            bf16x8 Bf[4]; \
            _Pragma("unroll") for (int nn = 0; nn < 4; ++nn) { \
                const s16x4 v0 = __builtin_amdgcn_ds_read_tr16_b64_v4i16((LAS s16x4*)(size_t)(brd[nn] + (BUF) * B_STAGE + ks * 16384)), \
                            v1 = __builtin_amdgcn_ds_read_tr16_b64_v4i16((LAS s16x4*)(size_t)(brd[nn] + (BUF) * B_STAGE + ks * 16384 + 2048)); \
                Bf[nn] = (bf16x8){v0.x, v0.y, v0.z, v0.w, v1.x, v1.y, v1.z, v1.w}; } \
            _Pragma("unroll") for (int mh = 0; mh < 2; ++mh) { \
                bf16x8 Af[4]; \
                _Pragma("unroll") for (int mi = 0; mi < 4; ++mi) Af[mi] = *(const LAS bf16x8*)(size_t)((ks ? ard1 : ard0) + (BUF) * A_STAGE + (mh * 4 + mi) * 2048); \
                _Pragma("unroll") for (int mi = 0; mi < 4; ++mi) { if (mh * 4 + mi < mlim) { \
                    _Pragma("unroll") for (int nn = 0; nn < 4; ++nn) acc[mh * 4 + mi][nn] = __builtin_amdgcn_mfma_f32_16x16x32_bf16(Bf[nn], Af[mi], acc[mh * 4 + mi][nn], 0, 0, 0); } } \
                __builtin_amdgcn_sched_barrier(0); } } } while (0)
#define MG_SYNC() do { asm volatile("s_waitcnt vmcnt(0) lgkmcnt(0)" ::: "memory"); __syncthreads(); } while (0)
    MG_DMA(0, 0); MG_BLOAD(0); MG_BWRITE(0);
    MG_SYNC();
    const int T = K >> 6;
    for (int t = 0; t < T; t += 2) {
        MG_DMA(1, (t + 1) * 64); MG_BLOAD((t + 1) * 64);
        __builtin_amdgcn_sched_barrier(0);
        MG_COMPUTE(0);
        MG_BWRITE(1);
        MG_SYNC();
        const bool hn = t + 2 < T;
        if (hn) { MG_DMA(0, (t + 2) * 64); MG_BLOAD((t + 2) * 64); }
        __builtin_amdgcn_sched_barrier(0);
        MG_COMPUTE(1);
        if (hn) MG_BWRITE(0);
        MG_SYNC();
    }
#undef MG_DMA
#undef MG_BLOAD
#undef MG_BWRITE
#undef MG_COMPUTE
#undef MG_SYNC
    ep(acc, wr, wc, fr, fq);
}
struct EpiGU { bf16* H; int rowbase, mvalid, h0;
    __device__ __forceinline__ void operator()(const f32x4 (&acc)[8][4], int wr, int wc, int fr, int fq) const {
        typedef unsigned u32x2 __attribute__((ext_vector_type(2)));
#pragma unroll
        for (int m = 0; m < 8; ++m) { const int row = wr * 128 + m * 16 + fr;
            if (row < mvalid) {
#pragma unroll
                for (int hn = 0; hn < 2; ++hn) { const f32x4 g = acc[m][hn], u = acc[m][hn + 2]; f32x4 h;
                    h.x = g.x / (1.f + __expf(-g.x)) * u.x; h.y = g.y / (1.f + __expf(-g.y)) * u.y; h.z = g.z / (1.f + __expf(-g.z)) * u.z; h.w = g.w / (1.f + __expf(-g.w)) * u.w;
                    u32x2 pk; pk.x = cvt_pk_bf16(h.x, h.y); pk.y = cvt_pk_bf16(h.z, h.w);
                    *(u32x2*)(H + (size_t)(rowbase + row) * EH + h0 + wc * 32 + hn * 16 + 4 * fq) = pk; } } } } };
struct EpiDown { bf16* contrib; const int* lslot; const float* lw; int mvalid, n0;
    __device__ __forceinline__ void operator()(const f32x4 (&acc)[8][4], int wr, int wc, int fr, int fq) const {
        typedef unsigned u32x2 __attribute__((ext_vector_type(2)));
#pragma unroll
        for (int m = 0; m < 8; ++m) { const int row = wr * 128 + m * 16 + fr;
            if (row < mvalid) { const int slot = lslot[row]; const float wgt = lw[row];
#pragma unroll
                for (int nn = 0; nn < 4; ++nn) { const f32x4 v = acc[m][nn] * wgt; u32x2 pk; pk.x = cvt_pk_bf16(v.x, v.y); pk.y = cvt_pk_bf16(v.z, v.w);
                    *(u32x2*)(contrib + (size_t)slot * DM + n0 + wc * 64 + nn * 16 + 4 * fq) = pk; } } } } };
}

struct Args { const float* in[23]; float* out; unsigned char* ws; int lo, hi; };

struct Ctx {
    LAS unsigned char* lds;
    int tid, lane, wid;
    const Args* a;
    __device__ __forceinline__ const float* x_in() const { return a->in[0]; }
    __device__ __forceinline__ const float* w_in() const { return a->in[1]; }
    __device__ __forceinline__ const float* b_in() const { return a->in[2]; }
    __device__ __forceinline__ const float* sinks() const { return a->in[3]; }
    __device__ __forceinline__ const float* pe_k() const { return a->in[4]; }
    __device__ __forceinline__ const float* w1_k() const { return a->in[5]; }
    __device__ __forceinline__ const float* w2_k() const { return a->in[6]; }
    __device__ __forceinline__ const float* pe_v() const { return a->in[7]; }
    __device__ __forceinline__ const float* w1_v() const { return a->in[8]; }
    __device__ __forceinline__ const float* w2_v() const { return a->in[9]; }
    __device__ __forceinline__ const float* w_out() const { return a->in[10]; }
    __device__ __forceinline__ const float* b_out() const { return a->in[11]; }
    __device__ __forceinline__ const float* ln1_g() const { return a->in[12]; }
    __device__ __forceinline__ const float* ln1_b() const { return a->in[13]; }
    __device__ __forceinline__ const float* w_group() const { return a->in[14]; }
    __device__ __forceinline__ const float* b_group() const { return a->in[15]; }
    __device__ __forceinline__ const float* w_expert() const { return a->in[16]; }
    __device__ __forceinline__ const float* b_expert() const { return a->in[17]; }
    __device__ __forceinline__ const float* we_gate() const { return a->in[18]; }
    __device__ __forceinline__ const float* we_up() const { return a->in[19]; }
    __device__ __forceinline__ const float* we_down() const { return a->in[20]; }
    __device__ __forceinline__ const float* ln2_g() const { return a->in[21]; }
    __device__ __forceinline__ const float* ln2_b() const { return a->in[22]; }
    __device__ __forceinline__ float* out() const { return a->out; }
    __device__ __forceinline__ bf16* proj() const { return (bf16*)(a->ws + WS_PROJ); }
    __device__ __forceinline__ bf16* o() const { return (bf16*)(a->ws + WS_O); }
    __device__ __forceinline__ bf16* kvc() const { return (bf16*)(a->ws + WS_KVC); }
    __device__ __forceinline__ bf16* H() const { return (bf16*)(a->ws + WS_H); }
    __device__ __forceinline__ float* y() const { return (float*)(a->ws + WS_Y); }
    __device__ __forceinline__ float* x1() const { return (float*)(a->ws + WS_X1); }
    __device__ __forceinline__ float* x2() const { return (float*)(a->ws + WS_X2); }
    __device__ __forceinline__ float* hb() const { return (float*)(a->ws + WS_HB); }
    __device__ __forceinline__ float* logits() const { return (float*)(a->ws + WS_LOG); }
    __device__ __forceinline__ float* lw() const { return (float*)(a->ws + WS_LW); }
    __device__ __forceinline__ float* contrib() const { return (float*)(a->ws + WS_CONTRIB); }
    __device__ __forceinline__ int* lslot() const { return (int*)(a->ws + WS_LSLOT); }
    __device__ __forceinline__ bf16* wint() const { return (bf16*)(a->ws + WS_WINT); }
    __device__ __forceinline__ bf16* wot() const { return (bf16*)(a->ws + WS_WOT); }
    __device__ __forceinline__ bf16* xb() const { return (bf16*)(a->ws + WS_XB); }
    __device__ __forceinline__ bf16* bg() const { return (bf16*)(a->ws + WS_BG); }
    __device__ __forceinline__ bf16* br() const { return (bf16*)(a->ws + WS_BR); }
    __device__ __forceinline__ float* hb4() const { return (float*)(a->ws + WS_HB4); }
    __device__ __forceinline__ bf16* x1b() const { return (bf16*)(a->ws + WS_X1B); }
    __device__ __forceinline__ bf16* contribb() const { return (bf16*)(a->ws + WS_CONTRIB); }
    __device__ __forceinline__ unsigned* cnt() const { return (unsigned*)(a->ws + WS_CTL) + CW_CNT; }
};

constexpr int ATILE_BYTES = 64 * 64 * 2;
constexpr float C1 = 0.125f * 1.4426950408889634f;

__device__ __forceinline__ float xrow16_max(float x) {
    auto s = __builtin_amdgcn_permlane16_swap(__float_as_uint(x), __float_as_uint(x), false, false);
    x = fmaxf(__uint_as_float(s[0]), __uint_as_float(s[1]));
    auto t = __builtin_amdgcn_permlane32_swap(__float_as_uint(x), __float_as_uint(x), false, false);
    return fmaxf(__uint_as_float(t[0]), __uint_as_float(t[1]));
}
__device__ __forceinline__ float xrow16_sum(float x) {
    auto s = __builtin_amdgcn_permlane16_swap(__float_as_uint(x), __float_as_uint(x), false, false);
    x = __uint_as_float(s[0]) + __uint_as_float(s[1]);
    auto t = __builtin_amdgcn_permlane32_swap(__float_as_uint(x), __float_as_uint(x), false, false);
    return __uint_as_float(t[0]) + __uint_as_float(t[1]);
}
struct AttnRegs { f32x4 O[4][4]; float m[4], l[4]; bf16x8 Q[4][2]; };
struct ColCtx { int tt0; int t0; };
struct TileD { const bf16* k; const bf16* v; int pitch; float offrel; int mtype; int j; };
struct TileGen {
    int kind;
    int j, jend; unsigned long long rem; int c, jold;
    const bf16* kb; const bf16* vb;
    __device__ __forceinline__ bool next(TileD& d) {
        int jj;
        if (kind == 1) { if (!rem) return false; jj = 63 - __builtin_clzll(rem); rem &= ~(1ull << jj); }
        else { if (j > jend) return false; jj = jend--; }
        d.j = jj;
        if (kind == 2) { d.k = kb + (size_t)jj * 64 * 128; d.v = vb + (size_t)jj * 64 * 128; d.pitch = 128; d.offrel = (float)(1024 * jj + 31 - 64 * c); d.mtype = 3; }
        else { d.k = kb + (size_t)jj * 64 * PP; d.v = vb + (size_t)jj * 64 * PP; d.pitch = PP; d.offrel = (float)(64 * (jj - c)); d.mtype = (jj == c) ? 1 : (jj == jold ? 2 : 0); }
        return true;
    }
};

__device__ __forceinline__ void attn_load_q(AttnRegs& R, const bf16* qbase, int w, int fr, int fq) {
#pragma unroll
    for (int nt = 0; nt < 4; ++nt) {
        const int tt = 8 * w + 2 * nt + (fr >> 3);
        const bf16* p = qbase + (size_t)tt * PP + (fr & 7) * 64 + fq * 8;
        R.Q[nt][0] = *(const bf16x8*)p; R.Q[nt][1] = *(const bf16x8*)(p + 32);
    }
}
__device__ __forceinline__ void attn_reset(AttnRegs& R) {
#pragma unroll
    for (int nt = 0; nt < 4; ++nt) { R.m[nt] = -INFINITY; R.l[nt] = 0.f;
#pragma unroll
        for (int md = 0; md < 4; ++md) R.O[md][nt] = (f32x4){0.f, 0.f, 0.f, 0.f}; }
}
__device__ __forceinline__ void stage_issue(const TileD& d, LAS unsigned char* kdst, LAS unsigned char* vdst, int w, int lane) {
    const int r = 8 * w + (lane >> 3), ch = (lane & 7) ^ ((lane >> 3) & 7);
    __builtin_amdgcn_global_load_lds((const unsigned*)(d.k + (size_t)r * d.pitch + ch * 8), (LAS unsigned*)(kdst + w * 1024), 16, 0, 0);
    __builtin_amdgcn_global_load_lds((const unsigned*)(d.v + (size_t)r * d.pitch + ch * 8), (LAS unsigned*)(vdst + w * 1024), 16, 0, 0);
}

template <int MODE>
__device__ __forceinline__ void attn_half(AttnRegs& R, const LAS unsigned char* Kt, const LAS unsigned char* Vt, const int hk, const float A, const float kstep, const float off,
                                          const int mtype, const int hicmp, const unsigned enbits, const ColCtx& cc, const int fr, const int fq,
                                          LAS float* impA, LAS float* impB, const int jq0) {
    bf16x8 Kf[2][2];
#pragma unroll
    for (int m = 0; m < 2; ++m)
#pragma unroll
        for (int ks = 0; ks < 2; ++ks) Kf[m][ks] = *(const LAS bf16x8*)(Kt + (hk * 32 + m * 16 + fr) * 128 + (((ks * 4 + fq) ^ (fr & 7)) * 16));
    f32x4 S[2][4];
    const float ak = A * kstep;
#pragma unroll
    for (int m = 0; m < 2; ++m) {
        const float b0 = ak * (float)(hk * 32 + m * 16 + 4 * fq);
        const f32x4 cb = {b0, b0 + ak, b0 + 2.f * ak, b0 + 3.f * ak};
#pragma unroll
        for (int nt = 0; nt < 4; ++nt) {
            S[m][nt] = __builtin_amdgcn_mfma_f32_16x16x32_bf16(Kf[m][0], R.Q[nt][0], cb, 0, 0, 0);
            S[m][nt] = __builtin_amdgcn_mfma_f32_16x16x32_bf16(Kf[m][1], R.Q[nt][1], S[m][nt], 0, 0, 0);
        }
    }
    __builtin_amdgcn_sched_barrier(0);
    bool en[4];
#pragma unroll
    for (int nt = 0; nt < 4; ++nt) en[nt] = ((enbits >> nt) & 1u) != 0u;
    if (mtype != 0) {
#pragma unroll
        for (int nt = 0; nt < 4; ++nt) {
            const int tt = cc.tt0 + 2 * nt;
            int lo = 0, hi = 63;
            if (mtype == 1) hi = tt; else if (mtype == 2) lo = tt + 1; else { const int t = cc.t0 + tt; hi = (t >= 31 ? ((t - 31) >> 4) : -1) - hicmp; }
#pragma unroll
            for (int m = 0; m < 2; ++m)
#pragma unroll
                for (int r = 0; r < 4; ++r) { const int kk = hk * 32 + m * 16 + 4 * fq + r; if (kk < lo || kk > hi) S[m][nt][r] = -INFINITY; }
        }
    }
    bf16x8 Pf[4];
#pragma unroll
    for (int nt = 0; nt < 4; ++nt) {
        float add;
        if (MODE == 2) {
            add = (en[nt] && R.m[nt] > -INFINITY) ? C1 * (off - R.m[nt]) : -INFINITY;
        } else {
            float cm = fmaxf(fmaxf(fmaxf(S[0][nt][0], S[0][nt][1]), fmaxf(S[0][nt][2], S[0][nt][3])), fmaxf(fmaxf(S[1][nt][0], S[1][nt][1]), fmaxf(S[1][nt][2], S[1][nt][3])));
            if (!en[nt]) cm = -INFINITY;
            cm = xrow16_max(cm);
            const float mn = fmaxf(R.m[nt], cm + off);
            const float corr = (mn == -INFINITY) ? 1.f : __builtin_amdgcn_exp2f(C1 * (R.m[nt] - mn));
            add = (en[nt] && mn > -INFINITY) ? C1 * (off - mn) : -INFINITY;
            R.m[nt] = mn; R.l[nt] *= corr;
            if (MODE == 0) {
                if (__any(corr != 1.f)) {
#pragma unroll
                    for (int md = 0; md < 4; ++md) R.O[md][nt] = R.O[md][nt] * corr;
                }
            }
        }
        float p[2][4];
#pragma unroll
        for (int m = 0; m < 2; ++m)
#pragma unroll
            for (int r = 0; r < 4; ++r) p[m][r] = __builtin_amdgcn_exp2f(fmaf(S[m][nt][r], C1, add));
        if (MODE == 2) {
#pragma unroll
            for (int m = 0; m < 2; ++m) {
                float q4 = (p[m][0] + p[m][1]) + (p[m][2] + p[m][3]), p3 = p[m][3];
                q4 += __shfl_xor(q4, 1); p3 += __shfl_xor(p3, 1);
                q4 += __shfl_xor(q4, 2); p3 += __shfl_xor(p3, 2);
                q4 += __shfl_xor(q4, 4); p3 += __shfl_xor(p3, 4);
                if ((fr & 7) == 0) { const int jq = jq0 + hk * 8 + m * 4 + fq; impA[(cc.tt0 + 2 * nt) * 64 + jq] = q4; impB[(cc.tt0 + 2 * nt) * 65 + jq + 1] = p3; }
            }
        } else {
            R.l[nt] += ((p[0][0] + p[0][1]) + (p[0][2] + p[0][3])) + ((p[1][0] + p[1][1]) + (p[1][2] + p[1][3]));
        }
        if (MODE != 1) {
            u32x4 pk; pk.x = cvt_pk_bf16(p[0][0], p[0][1]); pk.y = cvt_pk_bf16(p[0][2], p[0][3]); pk.z = cvt_pk_bf16(p[1][0], p[1][1]); pk.w = cvt_pk_bf16(p[1][2], p[1][3]);
            Pf[nt] = __builtin_bit_cast(bf16x8, pk);
        }
        if (nt & 1) __builtin_amdgcn_sched_barrier(0);
    }
    __builtin_amdgcn_sched_barrier(0);
    if (MODE != 1) {
#pragma unroll
        for (int md = 0; md < 4; ++md) {
            typedef short s16x4 __attribute__((ext_vector_type(4)));
            const int key0 = hk * 32 + 4 * fq + (fr >> 2);
            const LAS unsigned char* vp = Vt + key0 * 128 + (((md * 2 + ((fr & 3) >> 1)) ^ (key0 & 7)) * 16) + (fr & 1) * 8;
            const s16x4 v0 = __builtin_amdgcn_ds_read_tr16_b64_v4i16((LAS s16x4*)vp), v1 = __builtin_amdgcn_ds_read_tr16_b64_v4i16((LAS s16x4*)(vp + 16 * 128));
            const bf16x8 Vf = {v0.x, v0.y, v0.z, v0.w, v1.x, v1.y, v1.z, v1.w};
#pragma unroll
            for (int nt = 0; nt < 4; ++nt) R.O[md][nt] = __builtin_amdgcn_mfma_f32_16x16x32_bf16(Vf, Pf[nt], R.O[md][nt], 0, 0, 0);
        }
    }
}

template <int MODE, bool USE_SEL>
__device__ __forceinline__ void attn_sweep(AttnRegs& R, LAS unsigned char* lds, TileGen tg, const ColCtx& cc, const float A, const float kstep,
                                           const int w, const int lane, const int fr, const int fq) {
    LAS unsigned char* Kb = lds + L_KV;
    LAS float* impA = (LAS float*)(lds + L_IMPA); LAS float* impB = (LAS float*)(lds + L_IMPB);
    const LAS unsigned* selw = (const LAS unsigned*)(lds + L_SEL);
    TileGen ta = tg;
    TileD cur, pf;
    if (!tg.next(cur)) return;
    ta.next(pf); stage_issue(pf, Kb, Kb + ATILE_BYTES, w, lane);
    bool more = ta.next(pf);
    if (more) stage_issue(pf, Kb + 2 * ATILE_BYTES, Kb + 3 * ATILE_BYTES, w, lane);
    if (more) asm volatile("s_waitcnt vmcnt(2)" ::: "memory"); else asm volatile("s_waitcnt vmcnt(0)" ::: "memory");
    __syncthreads();
    int st = 0;
    for (;;) {
        int st2 = st + 2; st2 = st2 >= 3 ? st2 - 3 : st2;
        if (more) { more = ta.next(pf); if (more) stage_issue(pf, Kb + st2 * (2 * ATILE_BYTES), Kb + st2 * (2 * ATILE_BYTES) + ATILE_BYTES, w, lane); }
        unsigned enbits = 15u;
        if (USE_SEL) {
            enbits = 0u;
#pragma unroll
            for (int nt = 0; nt < 4; ++nt) { const int tt = cc.tt0 + 2 * nt; const unsigned sw = selw[2 * tt + (cur.j >> 5)]; enbits |= ((sw >> (cur.j & 31)) & 1u) << nt; }
        }
        if (__any(enbits != 0u)) {
            const LAS unsigned char* Kt = Kb + st * (2 * ATILE_BYTES); const LAS unsigned char* Vt = Kt + ATILE_BYTES;
            const float off = A * cur.offrel;
#pragma unroll 1
            for (int hk = 0; hk < 2; ++hk) attn_half<MODE>(R, Kt, Vt, hk, A, kstep, off, cur.mtype, 64 * cur.j, enbits, cc, fr, fq, impA, impB, cur.j * 16);
        }
        if (more) asm volatile("s_waitcnt vmcnt(2)" ::: "memory"); else asm volatile("s_waitcnt vmcnt(0)" ::: "memory");
        __syncthreads();
        if (!tg.next(cur)) break;
        st = st + 1 >= 3 ? 0 : st + 1;
    }
}
__device__ __forceinline__ void attn_ltot(const AttnRegs& R, float (&lt)[4]) {
#pragma unroll
    for (int nt = 0; nt < 4; ++nt) lt[nt] = xrow16_sum(R.l[nt]);
}
__device__ __forceinline__ void attn_store(const AttnRegs& R, const float (&sc)[4], bf16* obase, const ColCtx& cc, int fr, int fq, const LAS unsigned char* parked) {
    typedef unsigned u32x2 __attribute__((ext_vector_type(2)));
    u32x2 old[4][4];
    if (parked) {
#pragma unroll
        for (int nt = 0; nt < 4; ++nt)
#pragma unroll
            for (int md = 0; md < 4; ++md) old[nt][md] = *(const u32x2*)(obase + (size_t)(cc.tt0 + 2 * nt) * DM + (fr & 7) * 64 + md * 16 + 4 * fq);
    }
#pragma unroll
    for (int nt = 0; nt < 4; ++nt)
#pragma unroll
        for (int md = 0; md < 4; ++md) {
            f32x4 v = R.O[md][nt] * sc[nt];
            u32x2* p = (u32x2*)(obase + (size_t)(cc.tt0 + 2 * nt) * DM + (fr & 7) * 64 + md * 16 + 4 * fq);
            if (parked) { const u32x2 pk = *(const LAS u32x2*)(parked + ((nt * 4 + md) * 64) * 8); const u32x2 ow = old[nt][md];
                v.x += bf2f(ow.x & 0xffffu) + bf2f(pk.x & 0xffffu); v.y += bf2f(ow.x >> 16) + bf2f(pk.x >> 16);
                v.z += bf2f(ow.y & 0xffffu) + bf2f(pk.y & 0xffffu); v.w += bf2f(ow.y >> 16) + bf2f(pk.y >> 16); }
            u32x2 nw; nw.x = cvt_pk_bf16(v.x, v.y); nw.y = cvt_pk_bf16(v.z, v.w);
            *p = nw;
        }
}
__device__ __forceinline__ void attn_park(const AttnRegs& R, const float (&sc)[4], LAS unsigned char* park) {
    typedef unsigned u32x2 __attribute__((ext_vector_type(2)));
#pragma unroll
    for (int nt = 0; nt < 4; ++nt)
#pragma unroll
        for (int md = 0; md < 4; ++md) { const f32x4 v = R.O[md][nt] * sc[nt]; u32x2 nw; nw.x = cvt_pk_bf16(v.x, v.y); nw.y = cvt_pk_bf16(v.z, v.w); *(LAS u32x2*)(park + ((nt * 4 + md) * 64) * 8) = nw; }
}
__device__ __forceinline__ void attn_colctx(ColCtx& cc, int w, int fr, int t0) { cc.tt0 = 8 * w + (fr >> 3); cc.t0 = t0; }

__device__ __forceinline__ void win_unit(const Ctx& c, int L, int u) {
    const int tid = c.tid, lane = c.lane, w = c.wid, fr = lane & 15, fq = lane >> 4;
    const int cch = u & 63, g = (u >> 6) & 1, b = u >> 7, t0 = cch * 64;
    const bf16* pb = c.proj() + (size_t)b * SEQ * PP;
    AttnRegs R; attn_reset(R);
    attn_load_q(R, pb + (size_t)t0 * PP + C_QN + g * 512, w, fr, fq);
    ColCtx cc; attn_colctx(cc, w, fr, t0);
    const float A = 8.f * exp2f(-(float)(g * 8 + (fr & 7) + 1) * 0.5f);
    TileGen tg; tg.kind = 0; tg.c = cch; tg.j = cch - 8 < 0 ? 0 : cch - 8; tg.jend = cch; tg.jold = cch - 8; tg.rem = 0ull;
    tg.kb = pb + C_KV + 4 * 128 + g * 64; tg.vb = pb + C_KV + 5 * 128 + g * 64;
    attn_sweep<0, false>(R, c.lds, tg, cc, A, 1.f, w, lane, fr, fq);
    float lt[4], sc[4]; attn_ltot(R, lt);
#pragma unroll
    for (int nt = 0; nt < 4; ++nt) { const float gv = bf2f(pb[(size_t)(t0 + cc.tt0 + 2 * nt) * PP + C_GN + g * 24 + (fr & 7) * 3 + 2]); sc[nt] = sigmoidf(gv) / lt[nt]; }
    attn_store(R, sc, c.o() + ((size_t)b * SEQ + t0) * DM + 1024 + g * 512, cc, fr, fq, nullptr);
}
__device__ __forceinline__ void swa_unit(const Ctx& c, int L, int u) {
    const int tid = c.tid, lane = c.lane, w = c.wid, fr = lane & 15, fq = lane >> 4;
    const int cch = u & 63, g = (u >> 6) & 1, b = u >> 7, t0 = cch * 64;
    const bf16* pb = c.proj() + (size_t)b * SEQ * PP;
    AttnRegs R; attn_reset(R);
    attn_load_q(R, pb + (size_t)t0 * PP + C_QA + g * 512, w, fr, fq);
    ColCtx cc; attn_colctx(cc, w, fr, t0);
    const int a = g * 8 + (fr & 7);
    const float A = 8.f * exp2f(-(float)(2 * a + 1) * 0.25f);
    const float sink8 = 8.f * c.sinks()[L * 16 + a];
#pragma unroll
    for (int nt = 0; nt < 4; ++nt) { R.m[nt] = sink8 + A * (float)(cc.tt0 + 2 * nt); R.l[nt] = fq == 0 ? 1.f : 0.f; }
    TileGen tg; tg.kind = 0; tg.c = cch; tg.j = cch - 2 < 0 ? 0 : cch - 2; tg.jend = cch; tg.jold = cch - 2; tg.rem = 0ull;
    tg.kb = pb + C_KA + g * 64; tg.vb = pb + C_VA + g * 64;
    attn_sweep<0, false>(R, c.lds, tg, cc, A, 1.f, w, lane, fr, fq);
    float lt[4], sc[4]; attn_ltot(R, lt);
#pragma unroll
    for (int nt = 0; nt < 4; ++nt) sc[nt] = 1.f / lt[nt];
    attn_store(R, sc, c.o() + ((size_t)b * SEQ + t0) * DM + g * 512, cc, fr, fq, nullptr);
}
__device__ __forceinline__ void cmpslc_unit(const Ctx& c, int L, int u) {
    const int tid = c.tid, lane = c.lane, w = c.wid, fr = lane & 15, fq = lane >> 4;
    const int cch = u & 63, g = (u >> 6) & 1, b = u >> 7, t0 = cch * 64;
    const bf16* pb = c.proj() + (size_t)b * SEQ * PP;
    LAS float* impA = (LAS float*)(c.lds + L_IMPA); LAS float* impB = (LAS float*)(c.lds + L_IMPB);
    LAS unsigned* selw = (LAS unsigned*)(c.lds + L_SEL);
    AttnRegs R; attn_reset(R);
    attn_load_q(R, pb + (size_t)t0 * PP + C_QN + g * 512, w, fr, fq);
    ColCtx cc; attn_colctx(cc, w, fr, t0);
    const float A = 8.f * exp2f(-(float)(g * 8 + (fr & 7) + 1) * 0.5f);
    bf16* obase = c.o() + ((size_t)b * SEQ + t0) * DM + 1024 + g * 512;
    const bf16* gbase = pb + (size_t)t0 * PP + C_GN + g * 24 + (fr & 7) * 3;
    for (int i = lane; i < 8 * 64; i += 64) impA[(8 * w) * 64 + i] = 0.f;
    for (int i = lane; i < 8 * 65; i += 64) impB[(8 * w) * 65 + i] = 0.f;
    WAVE_LDS_FENCE();
    int ncl = 4 * cch + 2; if (ncl > NCMP - 1) ncl = NCMP - 1;
    TileGen tg; tg.kind = 2; tg.c = cch; tg.j = 0; tg.jend = ncl >> 6; tg.jold = -1; tg.rem = 0ull;
    tg.kb = c.kvc() + ((size_t)(b * NCMP) * 2 + g) * 64; tg.vb = c.kvc() + (size_t)2048 * 64 + ((size_t)(b * NCMP) * 2 + g) * 64;
    attn_sweep<1, false>(R, c.lds, tg, cc, A, 16.f, w, lane, fr, fq);
    { float lt[4]; attn_ltot(R, lt);
#pragma unroll
      for (int nt = 0; nt < 4; ++nt) R.m[nt] = lt[nt] > 0.f ? R.m[nt] + __builtin_amdgcn_logf(lt[nt]) * (1.f / C1) : -INFINITY; }
    attn_sweep<2, false>(R, c.lds, tg, cc, A, 16.f, w, lane, fr, fq);
    { float sc[4];
#pragma unroll
      for (int nt = 0; nt < 4; ++nt) sc[nt] = sigmoidf(bf2f(gbase[(size_t)(cc.tt0 + 2 * nt) * PP + 0]));
      attn_park(R, sc, c.lds + L_OCMP + w * 8192 + lane * 8); }
    WAVE_LDS_FENCE();
    for (int i = 0; i < 8; ++i) {
        const int ti = 8 * w + i, j = lane;
        const float imp = impA[ti * 64 + j] + impB[ti * 65 + j];
        const bool forced = (j == 0) || (j == cch) || (j == cch - 1); const bool valid = j <= cch;
        const float score = valid ? (forced ? INFINITY : imp) : -INFINITY;
        int rank = 0;
#pragma unroll 8
        for (int k = 0; k < 64; ++k) { const float sk = __uint_as_float((unsigned)__builtin_amdgcn_readlane((int)__float_as_uint(score), k)); rank += ((sk > score) || (sk == score && k < lane)) ? 1 : 0; }
        const unsigned long long msk = __ballot((rank < 16) && (score > -INFINITY));
        if (lane == 0) { selw[2 * ti] = (unsigned)msk; selw[2 * ti + 1] = (unsigned)(msk >> 32); }
    }
    asm volatile("s_waitcnt vmcnt(0) lgkmcnt(0)" ::: "memory");
    __syncthreads();
    unsigned ulo = selw[2 * lane], uhi = selw[2 * lane + 1];
#pragma unroll
    for (int o = 1; o < 64; o <<= 1) { ulo |= __shfl_xor(ulo, o); uhi |= __shfl_xor(uhi, o); }
    const unsigned long long uni = ((unsigned long long)__builtin_amdgcn_readfirstlane(uhi) << 32) | (unsigned long long)__builtin_amdgcn_readfirstlane(ulo);
    attn_reset(R);
    tg.kind = 1; tg.rem = uni; tg.j = 0; tg.jend = -1; tg.jold = -1;
    tg.kb = pb + C_KV + 2 * 128 + g * 64; tg.vb = pb + C_KV + 3 * 128 + g * 64;
    attn_sweep<0, true>(R, c.lds, tg, cc, A, 1.f, w, lane, fr, fq);
    { float lt[4], sc[4]; attn_ltot(R, lt);
#pragma unroll
      for (int nt = 0; nt < 4; ++nt) sc[nt] = sigmoidf(bf2f(gbase[(size_t)(cc.tt0 + 2 * nt) * PP + 1])) / lt[nt];
      attn_store(R, sc, obase, cc, fr, fq, c.lds + L_OCMP + w * 8192 + lane * 8); }
    __syncthreads();
}

#define EPI_LOOP for (int m = 0; m < 4; ++m) for (int n = 0; n < 2; ++n) for (int j = 0; j < 4; ++j)
struct EpiProj { bf16* proj; const float* bias; int row0, col0;
    __device__ __forceinline__ void operator()(const f32x4 (&acc)[4][2], int wr, int wc, int fr, int fq) const {
#pragma unroll
        for (int m = 0; m < 4; ++m)
#pragma unroll
            for (int n = 0; n < 2; ++n)
#pragma unroll
                for (int j = 0; j < 4; ++j) { const int r = row0 + wr * 64 + m * 16 + fq * 4 + j, cc = col0 + wc * 32 + n * 16 + fr;
                    const float v = cc < INC ? acc[m][n][j] + bias[cc] : 0.f; proj[(size_t)r * PP + cc] = f2bf(v); } } };
struct EpiCmp1 { float* hb; int row0, col0;
    __device__ __forceinline__ void operator()(const f32x4 (&acc)[4][2], int wr, int wc, int fr, int fq) const {
#pragma unroll
        for (int m = 0; m < 4; ++m)
#pragma unroll
            for (int n = 0; n < 2; ++n)
#pragma unroll
                for (int j = 0; j < 4; ++j) { const int r = row0 + wr * 64 + m * 16 + fq * 4 + j, cc = col0 + wc * 32 + n * 16 + fr;
                    hb[(size_t)r * 256 + cc] = acc[m][n][j]; } } };
struct EpiCmp2 { bf16* kvc; int row0;
    __device__ __forceinline__ void operator()(const f32x4 (&acc)[4][2], int wr, int wc, int fr, int fq) const {
#pragma unroll
        for (int m = 0; m < 4; ++m)
#pragma unroll
            for (int n = 0; n < 2; ++n)
#pragma unroll
                for (int j = 0; j < 4; ++j) { const int r = row0 + wr * 64 + m * 16 + fq * 4 + j, cc = wc * 32 + n * 16 + fr;
                    if (cc < 64) kvc[(size_t)r * 64 + cc] = f2bf(acc[m][n][j]); } } };
struct EpiOut { float* y; const float* bias; const float* xres; int row0, col0;
    __device__ __forceinline__ void operator()(const f32x4 (&acc)[4][2], int wr, int wc, int fr, int fq) const {
#pragma unroll
        for (int m = 0; m < 4; ++m)
#pragma unroll
            for (int n = 0; n < 2; ++n)
#pragma unroll
                for (int j = 0; j < 4; ++j) { const int r = row0 + wr * 64 + m * 16 + fq * 4 + j, cc = col0 + wc * 32 + n * 16 + fr;
                    y[(size_t)r * DM + cc] = acc[m][n][j] + bias[cc] + ALPHA * xres[(size_t)r * DM + cc]; } } };
struct EpiLogit { float* lg; const float* bg; const float* be; int row0;
    __device__ __forceinline__ void operator()(const f32x4 (&acc)[4][2], int wr, int wc, int fr, int fq) const {
#pragma unroll
        for (int m = 0; m < 4; ++m)
#pragma unroll
            for (int n = 0; n < 2; ++n)
#pragma unroll
                for (int j = 0; j < 4; ++j) { const int r = row0 + wr * 64 + m * 16 + fq * 4 + j, cc = wc * 32 + n * 16 + fr;
                    if (cc < 72) lg[(size_t)r * NLOG + cc] = acc[m][n][j] + (cc < 8 ? bg[cc] : be[cc - 8]); } } };
struct EpiMoe1 { bf16* H; int rowbase, cnt, rt, ct;
    __device__ __forceinline__ void operator()(const f32x4 (&acc)[4][2], int wr, int wc, int fr, int fq) const {
#pragma unroll
        for (int m = 0; m < 4; ++m)
#pragma unroll
            for (int j = 0; j < 4; ++j) { const int pos = rt * 128 + wr * 64 + m * 16 + fq * 4 + j;
                if (pos < cnt) { const float gv = acc[m][0][j], uv = acc[m][1][j]; const float hv = gv / (1.f + expf(-gv)) * uv;
                    H[(size_t)(rowbase + pos) * EH + ct * 64 + wc * 16 + fr] = f2bf(hv); } } } };
struct EpiMoe2 { float* contrib; const int* lslot; const float* lw; int cnt, rt, col0;
    __device__ __forceinline__ void operator()(const f32x4 (&acc)[4][2], int wr, int wc, int fr, int fq) const {
#pragma unroll
        for (int m = 0; m < 4; ++m)
#pragma unroll
            for (int j = 0; j < 4; ++j) { const int pos = rt * 128 + wr * 64 + m * 16 + fq * 4 + j;
                if (pos < cnt) { const int slot = lslot[pos]; const float w = lw[pos];
#pragma unroll
                    for (int n = 0; n < 2; ++n) contrib[(size_t)slot * DM + col0 + wc * 32 + n * 16 + fr] = acc[m][n][j] * w; } } } };


template <int NT, class EP>
__device__ __forceinline__ void skinny_unit(LAS unsigned char* lds, const bf16* A, const bf16* Bt, const EP& ep, int w, int lane) {
    const int fr = lane & 15, fq = lane >> 4, rg = w & 3, kh = w >> 2;
    const bf16* ap = A + (size_t)(rg * 16 + fr) * DM + kh * 1024 + fq * 8;
    const bf16* bp = Bt + (size_t)fr * DM + kh * 1024 + fq * 8;
    f32x4 acc[NT];
#pragma unroll
    for (int n = 0; n < NT; ++n) acc[n] = (f32x4){0.f, 0.f, 0.f, 0.f};
#pragma unroll 4
    for (int k = 0; k < 1024; k += 32) {
        const bf16x8 a = *(const bf16x8*)(ap + k);
#pragma unroll
        for (int n = 0; n < NT; ++n) { const bf16x8 b = *(const bf16x8*)(bp + (size_t)n * 16 * DM + k); acc[n] = __builtin_amdgcn_mfma_f32_16x16x32_bf16(b, a, acc[n], 0, 0, 0); }
    }
    LAS f32x4* red = (LAS f32x4*)lds + (rg * NT) * 64 + lane;
    if (kh == 1) {
#pragma unroll
        for (int n = 0; n < NT; ++n) red[n * 64] = acc[n];
    }
    __syncthreads();
    if (kh == 0) {
#pragma unroll
        for (int n = 0; n < NT; ++n) acc[n] = acc[n] + red[n * 64];
        ep(acc, rg * 16 + fr, fq);
    }
    __syncthreads();
}
struct EpiGateCols { bf16* proj; const float* bias; int row0;
    __device__ __forceinline__ void operator()(const f32x4 (&acc)[3], int r, int fq) const {
        typedef unsigned u32x2 __attribute__((ext_vector_type(2)));
#pragma unroll
        for (int n = 0; n < 3; ++n) { const int cc = n * 16 + 4 * fq; const f32x4 bv = *(const f32x4*)(bias + 3072 + cc); const f32x4 v = acc[n] + bv;
            u32x2 pk; pk.x = cvt_pk_bf16(v.x, v.y); pk.y = cvt_pk_bf16(v.z, v.w); *(u32x2*)(proj + (size_t)(row0 + r) * PP + 3072 + cc) = pk; } } };
struct EpiLogitS { float* lg; const float* bg; const float* be; int row0;
    __device__ __forceinline__ void operator()(const f32x4 (&acc)[5], int r, int fq) const {
#pragma unroll
        for (int n = 0; n < 5; ++n) { const int cc = n * 16 + 4 * fq; f32x4 v = acc[n];
            if (cc < 8) v = v + *(const f32x4*)(bg + cc); else if (cc < 72) v = v + *(const f32x4*)(be + cc - 8);
            *(f32x4*)(lg + (size_t)(row0 + r) * NLOG + cc) = v; } } };

__device__ __forceinline__ void p0_transpose_item(const float* W, int K, int ldw, int N, bf16* WT, LAS float* scr, int item, int lane) {
    const int nblk = N / 32, kb = item / nblk, nb = item % nblk, k0 = 64 * kb, n0 = 32 * nb;
#pragma unroll 8
    for (int i = 0; i < 32; ++i) { const int kk = 2 * i + (lane >> 5); scr[kk * 33 + (lane & 31)] = W[(size_t)(k0 + kk) * ldw + n0 + (lane & 31)]; }
    WAVE_LDS_FENCE();
    const int ch = lane & 7;
#pragma unroll
    for (int j = 0; j < 4; ++j) { const int n = (lane >> 3) + 8 * j; const LAS float* s = scr + (8 * ch) * 33 + n;
        u32x4 o; o.x = cvt_pk_bf16(s[0 * 33], s[1 * 33]); o.y = cvt_pk_bf16(s[2 * 33], s[3 * 33]); o.z = cvt_pk_bf16(s[4 * 33], s[5 * 33]); o.w = cvt_pk_bf16(s[6 * 33], s[7 * 33]);
        *(u32x4*)(WT + (size_t)(n0 + n) * K + k0 + 8 * ch) = o; }
    WAVE_LDS_FENCE();
}
__device__ __forceinline__ void ph_prologue(const Ctx& c) {
    LAS float* scr = (LAS float*)(c.lds + c.wid * 16384);
    const int gw = blockIdx.x * 8 + c.wid, NGW = gridDim.x * 8;
    constexpr int I_IN = (DM / 64) * (3072 / 32), I_OUT = (DM / 64) * (DM / 32);
    for (int it = gw; it < DEPTH * (I_IN + I_OUT); it += NGW) {
        int r = it; const int L = r / (I_IN + I_OUT); r -= L * (I_IN + I_OUT);
        if (r < I_IN) p0_transpose_item(c.w_in() + (size_t)L * DM * INC, DM, INC, 3072, c.wint() + (size_t)L * 3072 * DM, scr, r, c.lane);
        else p0_transpose_item(c.w_out() + (size_t)L * DM * DM, DM, DM, DM, c.wot() + (size_t)L * DM * DM, scr, r - I_IN, c.lane);
    }
    {
        const int gt = blockIdx.x * 512 + c.tid, NT_ = gridDim.x * 512;
        for (int it = gt; it < DEPTH * 128 * (DM / 8); it += NT_) {
            const int k8 = it % (DM / 8), n = (it / (DM / 8)) % 128, L = it / (128 * (DM / 8));
            const float* srcp = nullptr; size_t ld = 0; bf16* dst = nullptr;
            if (n < 48) { srcp = c.w_in() + (size_t)L * DM * INC + 3072 + n; ld = INC; dst = c.bg() + ((size_t)L * 48 + n) * DM; }
            else { const int m_ = n - 48; dst = c.br() + ((size_t)L * 80 + m_) * DM;
                if (m_ < 8) { srcp = c.w_group() + (size_t)L * DM * 8 + m_; ld = 8; } else if (m_ < 72) { srcp = c.w_expert() + (size_t)L * DM * 64 + (m_ - 8); ld = 64; } }
            float v[8];
#pragma unroll
            for (int i = 0; i < 8; ++i) v[i] = srcp ? srcp[(size_t)(k8 * 8 + i) * ld] : 0.f;
            u32x4 o; o.x = cvt_pk_bf16(v[0], v[1]); o.y = cvt_pk_bf16(v[2], v[3]); o.z = cvt_pk_bf16(v[4], v[5]); o.w = cvt_pk_bf16(v[6], v[7]);
            *(u32x4*)(dst + k8 * 8) = o;
        }
    }
    for (int m = gw; m < MTOK; m += NGW) {
        const f32x4* xr = (const f32x4*)(c.x_in() + (size_t)m * DM) + c.lane; unsigned long long* o8 = (unsigned long long*)(c.xb() + (size_t)m * DM) + c.lane;
#pragma unroll
        for (int j = 0; j < 8; ++j) { const f32x4 v = xr[64 * j]; o8[64 * j] = (unsigned long long)cvt_pk_bf16(v.x, v.y) | ((unsigned long long)cvt_pk_bf16(v.z, v.w) << 32); }
    }
}
__device__ __forceinline__ void ph_inproj(const Ctx& c, int L, const float* xin) {
    {
        pg8::Gemm g{c.xb(), c.wint() + (size_t)L * 3072 * DM, MTOK, 3072, DM}; pg8::StaticOrder S; S.init(MTOK, 3072, (int)gridDim.x, (int)blockIdx.x);
        pg8::EpiBf16<0> E{c.proj(), PP, c.b_in() + L * INC, 0, 0, 1.f};
        pg8::gemm_phase<pg8::EpiBf16<0>, pg8::StaticOrder, true, true>(c.lds, g, S, E);
    }
    for (int u = blockIdx.x; u < MTOK / 64; u += gridDim.x) {
        EpiGateCols ep{c.proj(), c.b_in() + L * INC, u * 64};
        skinny_unit<3>(c.lds, c.xb() + (size_t)u * 64 * DM, c.bg() + (size_t)L * 48 * DM, ep, c.wid, c.lane);
    }
}
__device__ __forceinline__ void ph_cmp1_swa(const Ctx& c, int L) {
    const int ar = c.tid >> 2, bn = c.tid & 127;
    for (int uu = blockIdx.x; uu < 256; uu += gridDim.x) {
        const int ksp = uu & 3, u = uu >> 2;
        const int which = u >> 5, rt = (u >> 1) & 15, ct = u & 1;
        const int r = rt * 128 + ar;
        const bf16* base = nullptr;
        if (r < CMPROWS) { const int g = r & 1, bn_ = r >> 1, n = bn_ % NCMP, b = bn_ / NCMP;
            base = c.proj() + ((size_t)b * SEQ + 16 * n) * PP + C_KV + which * 128 + g * 64; }
        ALcmp al{base, (which ? c.pe_v() : c.pe_k()) + (size_t)L * 2048, ksp * 512};
        BLf32 bl{(which ? c.w1_v() : c.w1_k()) + (size_t)L * 2048 * 256 + (size_t)(ksp * 512) * 256 + ct * 128 + bn, (size_t)256};
        EpiCmp1 ep{c.hb4() + ((size_t)ksp * 2 + which) * 2048 * 256, rt * 128, ct * 128};
        gemm_tile(c.lds, al, bl, ep, 512);
    }
    __syncthreads();
    for (int u = blockIdx.x; u < NB * 2 * 64; u += gridDim.x) win_unit(c, L, u);
    for (int u = blockIdx.x; u < NB * 2 * 64; u += gridDim.x) swa_unit(c, L, u);
}
__device__ __forceinline__ void ph_cmp2(const Ctx& c, int L) {
    const int ar = c.tid >> 2, bn = c.tid & 127;
    for (int u = blockIdx.x; u < 32; u += gridDim.x) {
        const int which = u >> 4, rt = u & 15;
        ALsum4gelu al{c.hb4() + (size_t)which * 2048 * 256 + (size_t)(rt * 128 + ar) * 256, (size_t)2 * 2048 * 256};
        BLf32 bl{bn < 64 ? (which ? c.w2_v() : c.w2_k()) + (size_t)L * 256 * 64 + bn : nullptr, (size_t)64};
        EpiCmp2 ep{c.kvc() + (size_t)which * 2048 * 64, rt * 128};
        gemm_tile(c.lds, al, bl, ep, 256);
    }
}
__device__ __forceinline__ void ph_nsa(const Ctx& c, int L) {
    for (int i = blockIdx.x; i < NB * 2 * 64; i += gridDim.x) {
        const int r = i >> 8, q = i & 255, bg = q >> 5, ci = q & 31;
        cmpslc_unit(c, L, bg * 64 + (r ? 63 - ci : ci));
    }
}
__device__ __forceinline__ void ph_outproj(const Ctx& c, int L, const float* xin) {
    pg8::Gemm g{c.o(), c.wot() + (size_t)L * DM * DM, MTOK, DM, DM}; pg8::StaticOrder S; S.init(MTOK, DM, (int)gridDim.x, (int)blockIdx.x);
    pg8::EpiF32Res E{c.y(), xin, c.xb(), c.b_out() + L * DM, DM, ALPHA};
    pg8::gemm_phase<pg8::EpiF32Res, pg8::StaticOrder, true, true>(c.lds, g, S, E);
}
__device__ __forceinline__ void ph_ln(const Ctx& c, const float* src, const bf16* srcb, float sscale, const bf16* add, float* dst, const float* gam, const float* bet, bf16* dstb) {
    const int lane = c.lane;
    for (int r = blockIdx.x * 8 + c.wid; r < MTOK; r += gridDim.x * 8) {
        f32x4 v[8]; float s = 0.f;
        if (src) { const f32x4* sp = (const f32x4*)(src + (size_t)r * DM) + lane;
#pragma unroll
            for (int j = 0; j < 8; ++j) { v[j] = sp[64 * j] * sscale; }
        } else { typedef unsigned u32x2 __attribute__((ext_vector_type(2))); const u32x2* sp = (const u32x2*)(srcb + (size_t)r * DM) + lane;
#pragma unroll
            for (int j = 0; j < 8; ++j) { const u32x2 pw = sp[64 * j]; v[j].x = bf2f(pw.x & 0xffffu) * sscale; v[j].y = bf2f(pw.x >> 16) * sscale; v[j].z = bf2f(pw.y & 0xffffu) * sscale; v[j].w = bf2f(pw.y >> 16) * sscale; }
        }
        if (add) {
            typedef unsigned u32x2 __attribute__((ext_vector_type(2)));
            const u32x2* a0 = (const u32x2*)(add + (size_t)(2 * r) * DM) + lane; const u32x2* a1 = (const u32x2*)(add + (size_t)(2 * r + 1) * DM) + lane;
#pragma unroll
            for (int j = 0; j < 8; ++j) { const u32x2 p0 = a0[64 * j], p1 = a1[64 * j];
                v[j].x += bf2f(p0.x & 0xffffu) + bf2f(p1.x & 0xffffu); v[j].y += bf2f(p0.x >> 16) + bf2f(p1.x >> 16);
                v[j].z += bf2f(p0.y & 0xffffu) + bf2f(p1.y & 0xffffu); v[j].w += bf2f(p0.y >> 16) + bf2f(p1.y >> 16); }
        }
#pragma unroll
        for (int j = 0; j < 8; ++j) s += (v[j].x + v[j].y) + (v[j].z + v[j].w);
        const float mean = wave_sum(s) * (1.f / DM); float s2 = 0.f;
#pragma unroll
        for (int j = 0; j < 8; ++j) { v[j] = v[j] - mean; s2 += (v[j].x * v[j].x + v[j].y * v[j].y) + (v[j].z * v[j].z + v[j].w * v[j].w); }
        const float rstd = 1.f / sqrtf(wave_sum(s2) * (1.f / DM) + LN_EPS);
        const f32x4* gp = (const f32x4*)gam + lane; const f32x4* bp = (const f32x4*)bet + lane;
#pragma unroll
        for (int j = 0; j < 8; ++j) v[j] = v[j] * rstd * gp[64 * j] + bp[64 * j];
        if (dst) { f32x4* dp = (f32x4*)(dst + (size_t)r * DM) + lane;
#pragma unroll
            for (int j = 0; j < 8; ++j) dp[64 * j] = v[j]; }
        if (dstb) { unsigned long long* o8 = (unsigned long long*)(dstb + (size_t)r * DM) + lane;
#pragma unroll
            for (int j = 0; j < 8; ++j) o8[64 * j] = (unsigned long long)cvt_pk_bf16(v[j].x, v[j].y) | ((unsigned long long)cvt_pk_bf16(v[j].z, v[j].w) << 32); }
    }
}
__device__ __forceinline__ void ph_router(const Ctx& c, int L) {
    for (int u = blockIdx.x; u < MTOK / 64; u += gridDim.x) {
        EpiLogitS ep{c.logits(), c.b_group() + L * 8, c.b_expert() + L * 64, u * 64};
        skinny_unit<5>(c.lds, c.x1b() + (size_t)u * 64 * DM, c.br() + (size_t)L * 80 * DM, ep, c.wid, c.lane);
    }
}
__device__ __forceinline__ void ph_route(const Ctx& c, int L) {
    unsigned* cnt = c.cnt() + L * 64;
    for (int tok = blockIdx.x * 512 + c.tid; tok < MTOK; tok += gridDim.x * 512) {
        const float* lg = c.logits() + (size_t)tok * NLOG;
        float gl[8];
#pragma unroll
        for (int i = 0; i < 8; ++i) gl[i] = lg[i];
        int gs = 0; float gm = gl[0];
#pragma unroll
        for (int i = 1; i < 8; ++i) if (gl[i] > gm) { gm = gl[i]; gs = i; }
        float gsum = 0.f;
#pragma unroll
        for (int i = 0; i < 8; ++i) gsum += expf(gl[i] - gm);
        const float gw = 1.f / gsum;
        float el[8];
#pragma unroll
        for (int i = 0; i < 8; ++i) el[i] = lg[8 + gs * 8 + i];
        int i0 = 0; float v0 = el[0];
#pragma unroll
        for (int i = 1; i < 8; ++i) if (el[i] > v0) { v0 = el[i]; i0 = i; }
        int i1 = -1; float v1 = -INFINITY;
#pragma unroll
        for (int i = 0; i < 8; ++i) if (i != i0 && el[i] > v1) { v1 = el[i]; i1 = i; }
        const float e1 = expf(v1 - v0);
        const float w0 = gw / (1.f + e1), w1 = gw * e1 / (1.f + e1);
        const int ea = gs * 8 + i0, eb = gs * 8 + i1;
        const unsigned pa = atomicAdd(&cnt[ea], 1u); c.lslot()[(size_t)ea * LCAP + pa] = tok * 2; c.lw()[(size_t)ea * LCAP + pa] = w0;
        const unsigned pb = atomicAdd(&cnt[eb], 1u); c.lslot()[(size_t)eb * LCAP + pb] = tok * 2 + 1; c.lw()[(size_t)eb * LCAP + pb] = w1;
    }
}
__device__ __forceinline__ void moe_tables(const Ctx& c, int L) {
    LAS int* tab = (LAS int*)(c.lds + L_TAB);
    __syncthreads();
    if (c.tid < 64) tab[c.tid] = (int)c.cnt()[L * 64 + c.tid];
    __syncthreads();
    if (c.tid == 0) { int rb = 0, tb = 0; for (int e = 0; e < 64; ++e) { tab[64 + e] = rb; tab[128 + e] = tb; rb += tab[e]; tb += (tab[e] + 255) >> 8; } tab[192] = tb; }
    __syncthreads();
}
__device__ __forceinline__ int moe_find(const LAS int* tab, int rtg) { const int lane = threadIdx.x & 63; const unsigned long long m = __ballot(tab[128 + lane] <= rtg); return (int)__builtin_popcountll(m) - 1; }
__device__ __forceinline__ int vcu_id() { const int G = gridDim.x, bx = blockIdx.x; return (G % 8 == 0) ? (bx % 8) * (G / 8) + bx / 8 : bx; }
__device__ __forceinline__ void ph_moe1(const Ctx& c, int L) {
    moe_tables(c, L);
    const LAS int* tab = (const LAS int*)(c.lds + L_TAB);
    const int ntile = tab[192], lane = c.lane, tid = c.tid;
    for (int u = vcu_id(); u < ntile * 4; u += gridDim.x) {
        const int ct = u / ntile, rtg = u - ct * ntile; const int e = moe_find(tab, rtg); const int rt = rtg - tab[128 + e], cnt = tab[e], rowbase = tab[64 + e];
        int mvalid = cnt - rt * 256; if (mvalid > 256) mvalid = 256;
        const int* ls = c.lslot() + (size_t)e * LCAP + rt * 256;
        const bf16* ap[4];
#pragma unroll
        for (int i = 0; i < 4; ++i) { const int row = (tid >> 3) + 64 * i; const int slot = ls[row < mvalid ? row : 0]; ap[i] = c.x1b() + (size_t)(slot >> 1) * DM; }
        const int h0 = ct * 128;
        const int wcv = lane >> 4, nnv = (lane >> 2) & 3, within = 4 * (lane & 3);
        const float* Wsel = ((nnv >> 1) ? c.we_up() : c.we_gate()) + ((size_t)L * NE + e) * DM * EH;
        const float* bcol = Wsel + h0 + wcv * 32 + (nnv & 1) * 16 + within;
        mg::EpiGU ep{c.H(), rowbase + rt * 256, mvalid, h0};
        mg::tile(c.lds, ap[0], ap[1], ap[2], ap[3], bcol, (size_t)EH, DM, mvalid, ep);
    }
}
__device__ __forceinline__ void ph_moe2(const Ctx& c, int L) {
    moe_tables(c, L);
    const LAS int* tab = (const LAS int*)(c.lds + L_TAB);
    const int ntile = tab[192], lane = c.lane, tid = c.tid;
    for (int u = vcu_id(); u < ntile * 8; u += gridDim.x) {
        const int ct = u / ntile, rtg = u - ct * ntile; const int e = moe_find(tab, rtg); const int rt = rtg - tab[128 + e], cnt = tab[e], rowbase = tab[64 + e];
        int mvalid = cnt - rt * 256; if (mvalid > 256) mvalid = 256;
        const bf16* ap[4];
#pragma unroll
        for (int i = 0; i < 4; ++i) { const int row = (tid >> 3) + 64 * i; ap[i] = c.H() + (size_t)(rowbase + rt * 256 + (row < mvalid ? row : 0)) * EH; }
        const float* bcol = c.we_down() + ((size_t)L * NE + e) * EH * DM + ct * 256 + 4 * lane;
        mg::EpiDown ep{c.contribb(), c.lslot() + (size_t)e * LCAP + rt * 256, c.lw() + (size_t)e * LCAP + rt * 256, mvalid, ct * 256};
        mg::tile(c.lds, ap[0], ap[1], ap[2], ap[3], bcol, (size_t)DM, EH, mvalid, ep);
    }
}

__global__ void __launch_bounds__(512, 2) fwd(Args a) {
    extern __shared__ __attribute__((aligned(16))) unsigned char smem[];
    unsigned char* ws = a.ws;
    const int tid0 = threadIdx.x;
    volatile LAS unsigned* barw = (volatile LAS unsigned*)((LAS unsigned char*)smem + L_BARW);
    if (tid0 < 4) barw[tid0] = 0u;
    __syncthreads();
    const int lo = a.lo, hi = a.hi;
    XcdBarrier bar; bar.bar = (unsigned*)(ws + WS_CTL) + CW_BAR; bar.x = 0; bar.st = barw;
    if (hi - lo > 1) bar = xcd_barrier_post((unsigned*)(ws + WS_CTL) + CW_BAR, barw);
#ifndef PHMASK
#define PHMASK 0x7ff
#endif
#define IN(k) (((PHMASK >> ((k) % NPH)) & 1) && lo <= (k) && (k) < hi)
#ifndef DUPMASK
#define DUPMASK 0
#endif
#define DUP(k) ((DUPMASK >> ((k) % NPH)) & 1)
#define SEAM(k) do { if ((k) + 1 < hi) xcd_barrier(bar); } while (0)
#define PCTX() Ctx c; { int t_ = threadIdx.x; asm volatile("" : "+v"(t_)); c.tid = t_; c.lane = t_ & 63; c.wid = __builtin_amdgcn_readfirstlane(t_ >> 6); c.lds = (LAS unsigned char*)smem; c.a = &a; }
#define LAYER_BODY(L) { const int pb = (L) * NPH; \
        if (IN(pb + 0)) { PCTX(); ph_inproj(c, L, L == 0 ? c.x_in() : c.x2()); if (DUP(0)) { ph_inproj(c, L, L == 0 ? c.x_in() : c.x2()); } SEAM(pb + 0); } \
        if (IN(pb + 1)) { PCTX(); ph_cmp1_swa(c, L); if (DUP(1)) { ph_cmp1_swa(c, L); } SEAM(pb + 1); } \
        if (IN(pb + 2)) { PCTX(); ph_cmp2(c, L); if (DUP(2)) { ph_cmp2(c, L); } SEAM(pb + 2); } \
        if (IN(pb + 3)) { PCTX(); ph_nsa(c, L); if (DUP(3)) { ph_nsa(c, L); } SEAM(pb + 3); } \
        if (IN(pb + 4)) { PCTX(); ph_outproj(c, L, L == 0 ? c.x_in() : nullptr); if (DUP(4)) { ph_outproj(c, L, L == 0 ? c.x_in() : nullptr); } SEAM(pb + 4); } \
        if (IN(pb + 5)) { PCTX(); ph_ln(c, c.y(), nullptr, 1.f, nullptr, nullptr, c.ln1_g() + L * DM, c.ln1_b() + L * DM, c.x1b()); if (DUP(5)) { ph_ln(c, c.y(), nullptr, 1.f, nullptr, nullptr, c.ln1_g() + L * DM, c.ln1_b() + L * DM, c.x1b()); } SEAM(pb + 5); } \
        if (IN(pb + 6)) { PCTX(); ph_router(c, L); if (DUP(6)) { ph_router(c, L); } SEAM(pb + 6); } \
        if (IN(pb + 7)) { PCTX(); ph_route(c, L); if (DUP(7)) { ph_route(c, L); } SEAM(pb + 7); } \
        if (IN(pb + 8)) { PCTX(); ph_moe1(c, L); if (DUP(8)) { ph_moe1(c, L); } SEAM(pb + 8); } \
        if (IN(pb + 9)) { PCTX(); ph_moe2(c, L); if (DUP(9)) { ph_moe2(c, L); } SEAM(pb + 9); } \
        if (IN(pb + 10)) { PCTX(); ph_ln(c, nullptr, c.x1b(), ALPHA, c.contribb(), L == DEPTH - 1 ? c.out() : nullptr, c.ln2_g() + L * DM, c.ln2_b() + L * DM, L == DEPTH - 1 ? nullptr : c.xb()); if (DUP(10)) { ph_ln(c, nullptr, c.x1b(), ALPHA, c.contribb(), L == DEPTH - 1 ? c.out() : nullptr, c.ln2_g() + L * DM, c.ln2_b() + L * DM, L == DEPTH - 1 ? nullptr : c.xb()); } SEAM(pb + 10); } \
    }
    if (lo <= 0) { PCTX(); ph_prologue(c); if (hi > 0) xcd_barrier(bar); }
    LAYER_BODY(0)
    LAYER_BODY(1)
#undef IN
#undef SEAM
}

extern "C" void kernel_launch(void* const* d_in, const int* in_sizes, int n_in, void* d_out, int out_size, void* d_ws, size_t ws_size, hipStream_t stream) {
    static int grid = 0;
    if (grid == 0) {
        if (n_in != 23 || out_size != MTOK * DM || ws_size < WS_END) { fprintf(stderr, "kernel_launch: unexpected shapes (n_in %d out %d ws %zu)\n", n_in, out_size, ws_size); grid = -1; return; }
        int dev = 0, cus = 0;
        if (hipGetDevice(&dev) != hipSuccess || hipDeviceGetAttribute(&cus, hipDeviceAttributeMultiprocessorCount, dev) != hipSuccess) { grid = -1; return; }
        if (hipFuncSetAttribute((const void*)fwd, hipFuncAttributeMaxDynamicSharedMemorySize, LDS_BYTES) != hipSuccess) { fprintf(stderr, "kernel_launch: hipFuncSetAttribute failed\n"); grid = -1; return; }
        int per_cu = 0;
        (void)hipOccupancyMaxActiveBlocksPerMultiprocessor(&per_cu, (const void*)fwd, 512, LDS_BYTES);
        (void)hipGetLastError();
        grid = cus;
    }
    if (grid < 0) return;
    (void)hipMemsetAsync((char*)d_ws + WS_CTL, 0, CTL_BYTES, stream);
    Args a{};
    for (int i = 0; i < 23; ++i) a.in[i] = (const float*)d_in[i];
    a.out = (float*)d_out; a.ws = (unsigned char*)d_ws;
#if ONE_LAUNCH
    a.lo = 0; a.hi = DEPTH * NPH;
    hipLaunchKernelGGL(fwd, dim3(grid), dim3(512), LDS_BYTES, stream, a);
#else
    for (int k = 0; k < DEPTH * NPH; ++k) { a.lo = k; a.hi = k + 1; hipLaunchKernelGGL(fwd, dim3(grid), dim3(512), LDS_BYTES, stream, a); }
#endif
}
```

```cpp
#include <hip/hip_runtime.h>
#include <cstdio>
#include <cstdint>
#include <cmath>

#ifndef ONE_LAUNCH
#define ONE_LAUNCH 1
#endif


#define LAS __attribute__((address_space(3)))
typedef unsigned short bf16;
typedef short bf16x8 __attribute__((ext_vector_type(8)));
typedef float f32x4 __attribute__((ext_vector_type(4)));
typedef unsigned u32x4 __attribute__((ext_vector_type(4)));

constexpr int DM = 2048, SEQ = 4096, NB = 4, MTOK = NB * SEQ, DEPTH = 2;
constexpr int INC = 3120, PP = 3200;
constexpr int C_QA = 0, C_KA = 1024, C_VA = 1152, C_QN = 1280, C_KV = 2304, C_GN = 3072;
constexpr int NCMP = 255, CMPROWS = NB * NCMP * 2;
constexpr int NE = 64, EH = 512, LCAP = MTOK;
constexpr int NLOG = 80;
constexpr float ALPHA = 1.41421356237309515f;
constexpr float LN_EPS = 1e-5f;
constexpr int NPH = 11;

constexpr size_t MiB = 1u << 20;
constexpr size_t WS_CTL = 0, CTL_BYTES = 1 * MiB;
constexpr size_t WS_PROJ = 2 * MiB;
constexpr size_t WS_O = 102 * MiB;
constexpr size_t WS_Y = 166 * MiB;
constexpr size_t WS_X1 = 294 * MiB;
constexpr size_t WS_X2 = 422 * MiB;
constexpr size_t WS_HB = 550 * MiB;
constexpr size_t WS_KVC = 554 * MiB;
constexpr size_t WS_LOG = 555 * MiB;
constexpr size_t WS_LSLOT = 561 * MiB;
constexpr size_t WS_LW = 565 * MiB;
constexpr size_t WS_H = 569 * MiB;
constexpr size_t WS_CONTRIB = 601 * MiB;
constexpr size_t WS_WINT = 857 * MiB;
constexpr size_t WS_WOT = 881 * MiB;
constexpr size_t WS_XB = 897 * MiB;
constexpr size_t WS_X1B = 961 * MiB;
constexpr size_t WS_BG = 1025 * MiB;
constexpr size_t WS_BR = 1026 * MiB;
constexpr size_t WS_HB4 = 1027 * MiB;
constexpr size_t WS_END = 1043 * MiB;
constexpr int CW_BAR = 4096;
constexpr int CW_CNT = 16384;

constexpr int L_GEMM = 0;
constexpr int L_KV = 0;
constexpr int L_IMPA = 49152;
constexpr int L_IMPB = 65536;
constexpr int L_SEL = 82176;
constexpr int L_OCMP = 82944;
constexpr int L_TAB = 148480;
constexpr int L_BARW = 149504;
constexpr int LDS_BYTES = 150016;

__device__ __forceinline__ float bf2f(unsigned h) { return __uint_as_float(h << 16); }
__device__ __forceinline__ unsigned cvt_pk_bf16(float lo, float hi) { unsigned r; asm("v_cvt_pk_bf16_f32 %0, %1, %2" : "=v"(r) : "v"(lo), "v"(hi)); return r; }
__device__ __forceinline__ bf16 f2bf(float f) { return (bf16)(cvt_pk_bf16(f, 0.f) & 0xffffu); }
__device__ __forceinline__ float wave_sum(float v) {
#pragma unroll
    for (int o = 1; o < 64; o <<= 1) v += __shfl_xor(v, o);
    return v;
}
__device__ __forceinline__ float wave_max(float v) {
#pragma unroll
    for (int o = 1; o < 64; o <<= 1) v = fmaxf(v, __shfl_xor(v, o));
    return v;
}
__device__ __forceinline__ float gelu_tanh(float x) {
    const float u = 0.7978845608028654f * (x + 0.044715f * x * x * x);
    const float e = expf(2.f * u);
    const float th = 1.f - 2.f / (e + 1.f);
    return 0.5f * x * (1.f + th);
}
__device__ __forceinline__ float sigmoidf(float x) { return 1.f / (1.f + expf(-x)); }
__device__ __forceinline__ float rfl(float v) { return __builtin_bit_cast(float, __builtin_amdgcn_readfirstlane(__builtin_bit_cast(int, v))); }
#define WAVE_LDS_FENCE() do { asm volatile("s_waitcnt lgkmcnt(0)" ::: "memory"); __builtin_amdgcn_wave_barrier(); } while (0)

#define XB_TMO      128
#define XB_XCNT(j)  (256  + 64 * (j))
#define XB_XSUB(j)  (1280 + 64 * (j))
#define XB_XGEN(j)  (2304 + 64 * (j))
#define XB_TOP      3328
#define XB_TOPGEN   3392
#define XCD_BAR_WORDS 3456
#define XB_SPIN_CAP (1u << 24)

__device__ __forceinline__ unsigned xb_ld(unsigned* p)              { return __hip_atomic_load(p, __ATOMIC_RELAXED, __HIP_MEMORY_SCOPE_AGENT); }
__device__ __forceinline__ unsigned xb_add(unsigned* p, unsigned v) { return __hip_atomic_fetch_add(p, v, __ATOMIC_RELAXED, __HIP_MEMORY_SCOPE_AGENT); }
__device__ __forceinline__ unsigned xb_xcc_id() { return (unsigned)__builtin_amdgcn_s_getreg((3 << 11) | 20) & 0xFu; }
#define XB_SPIN(cond, bar) do { unsigned _sp = 0; while (cond) { __builtin_amdgcn_s_sleep(1); \
    if ((++_sp & 255u) == 0u) { if (xb_ld(&(bar)[XB_TMO])) break; if (_sp > XB_SPIN_CAP) { atomicAdd(&(bar)[XB_TMO], 1u); break; } } } } while (0)

struct XcdBarrier { unsigned* bar; unsigned x; volatile LAS unsigned* st; };

__device__ __forceinline__ XcdBarrier xcd_barrier_post(unsigned* bar, volatile LAS unsigned* st) {
    XcdBarrier b; b.bar = bar; b.x = xb_xcc_id(); b.st = st;
    if (threadIdx.x == 0) (void)xb_add(&bar[XB_XCNT(b.x)], 1u);
    return b;
}
__device__ __forceinline__ void xcd_barrier_complete(unsigned* bar, unsigned x, unsigned& nloc, unsigned& nx) {
    const unsigned G = gridDim.x * gridDim.y * gridDim.z;
    unsigned sum, cnt, mine, sp = 0u;
    for (;;) {
        sum = 0u; cnt = 0u; mine = 0u;
#pragma unroll
        for (unsigned j = 0; j < 16; ++j) { const unsigned c = xb_ld(&bar[XB_XCNT(j)]); sum += c; cnt += (c > 0u) ? 1u : 0u; mine = (j == x) ? c : mine; }
        if (sum == G) break;
        __builtin_amdgcn_s_sleep(1);
        if ((++sp & 255u) == 0u) { if (xb_ld(&bar[XB_TMO])) break; if (sp > XB_SPIN_CAP) { atomicAdd(&bar[XB_TMO], 1u); break; } }
    }
    nloc = mine > 0u ? mine : 1u; nx = cnt > 0u ? cnt : 1u;
}
__device__ __forceinline__ void xcd_barrier(const XcdBarrier& b) {
    asm volatile("s_waitcnt vmcnt(0)" ::: "memory");
    __syncthreads();
    if (threadIdx.x == 0) {
        unsigned* bar = b.bar;
        __builtin_amdgcn_s_waitcnt(0);
        unsigned nloc = b.st[0], nx = b.st[1];
        if (nloc == 0u) { xcd_barrier_complete(bar, b.x, nloc, nx); b.st[0] = nloc; b.st[1] = nx; }
        const unsigned old = xb_add(&bar[XB_XSUB(b.x)], 1u);
        const unsigned gen = old / nloc;
        if (old + 1u == (gen + 1u) * nloc) {
            __builtin_amdgcn_fence(__ATOMIC_RELEASE, "agent");
            asm volatile("s_waitcnt vmcnt(0)" ::: "memory");
            const unsigned og = xb_add(&bar[XB_TOP], 1u);
            const unsigned tg = og / nx;
            if (og + 1u == (tg + 1u) * nx) xb_add(&bar[XB_TOPGEN], 1u);
            else XB_SPIN(xb_ld(&bar[XB_TOPGEN]) == tg, bar);
            __builtin_amdgcn_fence(__ATOMIC_ACQUIRE, "agent");
            xb_add(&bar[XB_XGEN(b.x)], 1u);
            asm volatile("s_waitcnt vmcnt(0)" ::: "memory");
        } else {
            XB_SPIN(xb_ld(&bar[XB_XGEN(b.x)]) == gen, bar);
            __builtin_amdgcn_fence(__ATOMIC_ACQUIRE, "agent");
            asm volatile("s_waitcnt vmcnt(0)" ::: "memory");
        }
    }
    __syncthreads();
}

template <class AL, class BL, class EP>
__device__ __forceinline__ void gemm_tile(LAS unsigned char* lds, const AL& al, const BL& bl, const EP& ep, int K) {
    const int tid = threadIdx.x, wid = tid >> 6, lane = tid & 63, wr = wid >> 2, wc = wid & 3, fr = lane & 15, fq = lane >> 4;
    LAS bf16* As = (LAS bf16*)(lds + L_GEMM);
    LAS bf16* Bs = As + 128 * 40;
    const int ar = tid >> 2, akq = (tid & 3) * 8;
    const int bn = tid & 127, bkg = (tid >> 7) * 8;
    f32x4 acc[4][2];
#pragma unroll
    for (int m = 0; m < 4; ++m)
#pragma unroll
        for (int n = 0; n < 2; ++n) acc[m][n] = (f32x4){0.f, 0.f, 0.f, 0.f};
    bf16x8 ra = al.load(akq);
    float rb0 = bl.load(bkg + 0), rb1 = bl.load(bkg + 1), rb2 = bl.load(bkg + 2), rb3 = bl.load(bkg + 3),
          rb4 = bl.load(bkg + 4), rb5 = bl.load(bkg + 5), rb6 = bl.load(bkg + 6), rb7 = bl.load(bkg + 7);
    for (int k0 = 0; k0 < K; k0 += 32) {
        *(LAS bf16x8*)(As + ar * 40 + akq) = ra;
        u32x4 pb; pb.x = cvt_pk_bf16(rb0, rb1); pb.y = cvt_pk_bf16(rb2, rb3); pb.z = cvt_pk_bf16(rb4, rb5); pb.w = cvt_pk_bf16(rb6, rb7);
        *(LAS u32x4*)(Bs + bn * 40 + bkg) = pb;
        __syncthreads();
        if (k0 + 32 < K) {
            const int kn = k0 + 32;
            ra = al.load(kn + akq);
            rb0 = bl.load(kn + bkg + 0); rb1 = bl.load(kn + bkg + 1); rb2 = bl.load(kn + bkg + 2); rb3 = bl.load(kn + bkg + 3);
            rb4 = bl.load(kn + bkg + 4); rb5 = bl.load(kn + bkg + 5); rb6 = bl.load(kn + bkg + 6); rb7 = bl.load(kn + bkg + 7);
        }
        bf16x8 af[4], bfr[2];
#pragma unroll
        for (int m = 0; m < 4; ++m) af[m] = *(const LAS bf16x8*)(As + (wr * 64 + m * 16 + fr) * 40 + fq * 8);
#pragma unroll
        for (int n = 0; n < 2; ++n) bfr[n] = *(const LAS bf16x8*)(Bs + (wc * 32 + n * 16 + fr) * 40 + fq * 8);
#pragma unroll
        for (int m = 0; m < 4; ++m)
#pragma unroll
            for (int n = 0; n < 2; ++n) acc[m][n] = __builtin_amdgcn_mfma_f32_16x16x32_bf16(af[m], bfr[n], acc[m][n], 0, 0, 0);
        __syncthreads();
    }
    ep(acc, wr, wc, fr, fq);
}

__device__ __forceinline__ bf16x8 pack8(f32x4 a, f32x4 b) {
    u32x4 p; p.x = cvt_pk_bf16(a.x, a.y); p.y = cvt_pk_bf16(a.z, a.w); p.z = cvt_pk_bf16(b.x, b.y); p.w = cvt_pk_bf16(b.z, b.w);
    return __builtin_bit_cast(bf16x8, p);
}
__device__ __forceinline__ bf16x8 zero8() { u32x4 p = {0u, 0u, 0u, 0u}; return __builtin_bit_cast(bf16x8, p); }

struct ALf32 { const float* rowp; __device__ __forceinline__ bf16x8 load(int k) const { if (!rowp) return zero8(); const f32x4 a = *(const f32x4*)(rowp + k), b = *(const f32x4*)(rowp + k + 4); return pack8(a, b); } };
struct ALbf16 { const bf16* rowp; __device__ __forceinline__ bf16x8 load(int k) const { if (!rowp) return zero8(); return *(const bf16x8*)(rowp + k); } };
struct ALcmp { const bf16* base; const float* pe; int koff; __device__ __forceinline__ bf16x8 load(int kk) const {
        if (!base) return zero8();
        const int k = kk + koff;
        const int l = k >> 6, d = k & 63;
        const u32x4 v = *(const u32x4*)(base + (size_t)l * PP + d);
        const f32x4 p0 = *(const f32x4*)(pe + k), p1 = *(const f32x4*)(pe + k + 4);
        f32x4 a, b;
        a.x = bf2f(v.x & 0xffffu) + p0.x; a.y = bf2f(v.x >> 16) + p0.y; a.z = bf2f(v.y & 0xffffu) + p0.z; a.w = bf2f(v.y >> 16) + p0.w;
        b.x = bf2f(v.z & 0xffffu) + p1.x; b.y = bf2f(v.z >> 16) + p1.y; b.z = bf2f(v.w & 0xffffu) + p1.z; b.w = bf2f(v.w >> 16) + p1.w;
        return pack8(a, b); } };
struct ALsum4gelu { const float* rowp; size_t pstride; __device__ __forceinline__ bf16x8 load(int k) const {
        f32x4 a = *(const f32x4*)(rowp + k), b = *(const f32x4*)(rowp + k + 4);
#pragma unroll
        for (int s = 1; s < 4; ++s) { a = a + *(const f32x4*)(rowp + s * pstride + k); b = b + *(const f32x4*)(rowp + s * pstride + k + 4); }
        a.x = gelu_tanh(a.x); a.y = gelu_tanh(a.y); a.z = gelu_tanh(a.z); a.w = gelu_tanh(a.w);
        b.x = gelu_tanh(b.x); b.y = gelu_tanh(b.y); b.z = gelu_tanh(b.z); b.w = gelu_tanh(b.w);
        return pack8(a, b); } };
struct BLf32 { const float* colp; size_t ldb; __device__ __forceinline__ float load(int k) const { return colp ? colp[(size_t)k * ldb] : 0.f; } };

namespace pg8 {
#define PG8_LAS __attribute__((address_space(3)))
typedef unsigned short bf16_t;
typedef short bf16x8 __attribute__((ext_vector_type(8)));
typedef float f32x4 __attribute__((ext_vector_type(4)));
typedef unsigned u32x4 __attribute__((ext_vector_type(4)));
constexpr int BM = 256, BK = 64, HALF = 128, HTB = HALF * BK * 2  , STAGE_BYTES = 8 * HTB, NXCD = 8, WGM = 8;

__host__ __device__ __forceinline__ int lds_byte(int r, int c) { const int st = (r >> 4) * 2 + (c >> 5), rr = r & 15, cc = c & 31, ob = rr * 64 + cc * 2; return st * 1024 + (ob ^ (((ob >> 9) & 1) << 5)); }
__host__ __device__ __forceinline__ void stage_rc(int b, int& R, int& C) { const int st = b / 1024, sb = b % 1024, swz = sb ^ (((sb >> 9) & 1) << 5); R = (st >> 1) * 16 + swz / 64; C = (st & 1) * 32 + (swz % 64) / 2; }
__host__ __device__ __forceinline__ int perm32(int rho) { const int n = rho >> 4, i = rho & 15; return 8 * (i >> 2) + 4 * n + (i & 3); }

struct Unit { int pm, pn; };
struct Gemm { const bf16_t* A; const bf16_t* Bt; int M, N, K; };

struct StaticOrder {
    int nM, nN, nwg, G, c;
    __host__ __device__ void init(int M, int N, int G_, int c_) { nM = M / BM; nN = N / BM; nwg = nM * nN; G = G_; c = c_; }
    __host__ __device__ bool next(int i, Unit& u) const {
        const long L = (long)i * G + c; if (L >= nwg) return false;
        int wgid = (int)L; { const int q = nwg / NXCD, r = nwg % NXCD, xcd = wgid % NXCD, off = wgid / NXCD; wgid = (xcd < r ? xcd * (q + 1) : r * (q + 1) + (xcd - r) * q) + off; }
        const int nig = WGM * nN, gid = wgid / nig, fm = gid * WGM, gsz = (nM - fm) < WGM ? (nM - fm) : WGM;
        u.pm = fm + ((wgid % nig) % gsz); u.pn = (wgid % nig) / gsz; return true;
    }
    __device__ __forceinline__ void a_ready(const Unit&) const {}
    __device__ __forceinline__ void done(const Unit&) const {}
};

__device__ __forceinline__ unsigned cvt_pk_bf16(float lo, float hi) { unsigned r; asm volatile("v_cvt_pk_bf16_f32 %0, %1, %2" : "=v"(r) : "v"(lo), "v"(hi)); return r; }
typedef float f32x2 __attribute__((ext_vector_type(2)));
__device__ __forceinline__ f32x2 gelu_pk(f32x2 v) {
    const f32x2 av = __builtin_elementwise_abs(v), d = av * 0.2316418882f + 1.0f;
    f32x2 t; t.x = __builtin_amdgcn_rcpf(d.x); t.y = __builtin_amdgcn_rcpf(d.y);
    f32x2 q = t * 0.5307027145f + (-0.7265760135f); q = q * t + 0.7107068705f; q = q * t + (-0.142248368f); q = q * t + 0.127414796f; q = q * t;
    const f32x2 s = (v * v) * (-0.72134752044f);
    f32x2 e; e.x = __builtin_amdgcn_exp2f(s.x); e.y = __builtin_amdgcn_exp2f(s.y);
    const f32x2 m = v * (q * e), r = v - m;
    f32x2 o; o.x = v.x < 0.f ? m.x : r.x; o.y = v.y < 0.f ? m.y : r.y; return o;
}

template <int ACT  > struct EpiBf16 {
    static constexpr bool PERM = true, AFTER_DRAIN = false; static_assert(ACT == 0 || ACT == 1, "EpiBf16: ACT is 0 (none) or 1 (gelu_pk)");
    bf16_t* O; int ldc; const float* bias; int split_cols; size_t split_stride; float scale0;
    __device__ __forceinline__ void operator()(const f32x4 (&acc)[2][2][4][2], const Unit& u, int wr, int wc, int fr, int fq) const {
        const int row0 = u.pm * BM + wr * 64 + fr; int colt = u.pn * BM; bf16_t* base = O;
        float sc = 1.f; if (split_cols) { const int t = colt / split_cols; base += (size_t)t * split_stride; colt -= t * split_cols; if (t == 0) sc = scale0; }
        const int col0 = colt + wc * 32 + 8 * fq, bcol0 = u.pn * BM + wc * 32 + 8 * fq;
        f32x4 bv[2][2];
#pragma unroll
        for (int bj = 0; bj < 2; ++bj)
#pragma unroll
            for (int n = 0; n < 2; ++n) bv[bj][n] = bias ? *(const f32x4*)(bias + bcol0 + bj * HALF + 4 * n) : (f32x4){0.f, 0.f, 0.f, 0.f};
#pragma unroll
        for (int ai = 0; ai < 2; ++ai)
#pragma unroll
            for (int m = 0; m < 4; ++m) { bf16_t* rowp = base + (size_t)(row0 + ai * HALF + m * 16) * ldc + col0;
#pragma unroll
                for (int bj = 0; bj < 2; ++bj) { f32x4 v0 = acc[ai][bj][m][0] + bv[bj][0], v1 = acc[ai][bj][m][1] + bv[bj][1];
                    if (ACT == 1) { f32x2 a = gelu_pk((f32x2){v0[0], v0[1]}), b = gelu_pk((f32x2){v0[2], v0[3]}), c = gelu_pk((f32x2){v1[0], v1[1]}), d = gelu_pk((f32x2){v1[2], v1[3]});
                        v0 = (f32x4){a.x, a.y, b.x, b.y}; v1 = (f32x4){c.x, c.y, d.x, d.y}; }
                    v0 = v0 * sc; v1 = v1 * sc; u32x4 w; w.x = cvt_pk_bf16(v0[0], v0[1]); w.y = cvt_pk_bf16(v0[2], v0[3]); w.z = cvt_pk_bf16(v1[0], v1[1]); w.w = cvt_pk_bf16(v1[2], v1[3]);
                    *(u32x4*)(rowp + bj * HALF) = w; } }
    }
};

template <class Epi, class Sched, bool ALIGN_EPI = false, bool SP2 = false>
__device__ __forceinline__ void gemm_phase(PG8_LAS unsigned char* lds, const Gemm g, const Sched& S, const Epi& E) {
    const int tid = threadIdx.x, wid = __builtin_amdgcn_readfirstlane(tid >> 6), lane = tid & 63, wr = wid >> 2, wc = wid & 3, fr = lane & 15, fq = lane >> 4;
    const int K = g.K, nt = K / BK;
    unsigned voffA[2], voffB[2];
#pragma unroll
    for (int i = 0; i < 2; ++i) { int R, C; stage_rc(tid * 16 + i * 8192, R, C); const int Rb = Epi::PERM ? ((R & ~31) + perm32(R & 31)) : R;
        voffA[i] = (unsigned)(R * K + C) * 2u; voffB[i] = (unsigned)(Rb * K + C) * 2u; }
    const size_t kstep = (size_t)(BK * 2);
    const size_t hstep = (size_t)HALF * K * 2;
    const size_t tstep = 2 * hstep;
    const unsigned ldsw = (unsigned)wid * 1024u;
    const int aoff = lds_byte(wr * 64 + fr, fq * 8), boff = lds_byte(wc * 32 + fr, fq * 8);
#define PG8_SA(b, h) (((b) * 2 + (h)) * HTB)
#define PG8_SB(b, h) ((4 + (b) * 2 + (h)) * HTB)
#define PG8_STAGE(bufoff, gbase, voff) do { _Pragma("unroll") for (int _i = 0; _i < 2; ++_i) \
        __builtin_amdgcn_global_load_lds((const unsigned*)((const char*)(gbase) + (voff)[_i]), (PG8_LAS unsigned*)(lds + (bufoff) + ldsw + _i * 8192), 16, 0, 0); } while (0)
#define PG8_LDA(dst, b, h) do { _Pragma("unroll") for (int m = 0; m < 4; ++m) _Pragma("unroll") for (int k = 0; k < 2; ++k) dst[m][k] = *(const PG8_LAS bf16x8*)(lds + PG8_SA(b, h) + aoff + m * 2048 + k * 1024); } while (0)
#define PG8_LDB(dst, b, h) do { _Pragma("unroll") for (int n = 0; n < 2; ++n) _Pragma("unroll") for (int k = 0; k < 2; ++k) dst[n][k] = *(const PG8_LAS bf16x8*)(lds + PG8_SB(b, h) + boff + n * 2048 + k * 1024); } while (0)
#define PG8_MMA(ai, bj, At, Bt) do { __builtin_amdgcn_s_setprio(1); _Pragma("unroll") for (int m = 0; m < 4; ++m) _Pragma("unroll") for (int n = 0; n < 2; ++n) _Pragma("unroll") for (int k = 0; k < 2; ++k) \
        acc[ai][bj][m][n] = __builtin_amdgcn_mfma_f32_16x16x32_bf16(Bt[n][k], At[m][k], acc[ai][bj][m][n], 0, 0, 0); __builtin_amdgcn_s_setprio(0); } while (0)
#define PG8_WAIT_V(n) asm volatile("s_waitcnt vmcnt(" #n ")" ::: "memory")
#define PG8_WAIT_L(n) asm volatile("s_waitcnt lgkmcnt(" #n ")" ::: "memory")
#define PG8_BAR __builtin_amdgcn_s_barrier()
#define PG8_SCHED __builtin_amdgcn_sched_barrier(0)
    Unit cur, nxt; int ui = 0;
    if (!S.next(0, cur)) return;
    f32x4 acc[2][2][4][2];
#pragma unroll
    for (int a = 0; a < 2; ++a)
#pragma unroll
        for (int b = 0; b < 2; ++b)
#pragma unroll
            for (int m = 0; m < 4; ++m)
#pragma unroll
                for (int n = 0; n < 2; ++n) acc[a][b][m][n] = (f32x4){0.f, 0.f, 0.f, 0.f};
    bf16x8 At[4][2], B0[2][2], B1[2][2];
    const char* cA = (const char*)g.A + (size_t)cur.pm * tstep; const char* cB = (const char*)g.Bt + (size_t)cur.pn * tstep;
    S.a_ready(cur);
    if constexpr (SP2) {
        PG8_STAGE(PG8_SB(0, 0), cB, voffB); PG8_STAGE(PG8_SB(0, 1), cB + hstep, voffB); PG8_STAGE(PG8_SA(0, 0), cA, voffA); PG8_STAGE(PG8_SA(0, 1), cA + hstep, voffA);
        if (wr == 1) PG8_BAR;
        PG8_WAIT_V(2); PG8_BAR;
        PG8_STAGE(PG8_SB(1, 0), cB + kstep, voffB); PG8_STAGE(PG8_SA(1, 0), cA + kstep, voffA); PG8_STAGE(PG8_SB(1, 1), cB + hstep + kstep, voffB);
        PG8_WAIT_V(6); PG8_BAR;
    } else {
        PG8_STAGE(PG8_SB(0, 0), cB, voffB); PG8_STAGE(PG8_SA(0, 0), cA, voffA); PG8_STAGE(PG8_SB(0, 1), cB + hstep, voffB); PG8_STAGE(PG8_SA(0, 1), cA + hstep, voffA);
        if (wr == 1) PG8_BAR;
        PG8_WAIT_V(4); PG8_BAR;
        PG8_STAGE(PG8_SB(1, 0), cB + kstep, voffB); PG8_STAGE(PG8_SA(1, 0), cA + kstep, voffA); PG8_STAGE(PG8_SB(1, 1), cB + hstep + kstep, voffB);
        PG8_WAIT_V(6); PG8_BAR;
    }
    for (;;) {
        const bool has_next = S.next(ui + 1, nxt);
        const char* nA = has_next ? (const char*)g.A + (size_t)nxt.pm * tstep : cA; const char* nB = has_next ? (const char*)g.Bt + (size_t)nxt.pn * tstep : cB;
        for (int t = 0; t < nt; t += 2) {
            const bool last = (t == nt - 2);
            const char* a1 = cA + (size_t)(t + 1) * kstep;
            const char* a2 = last ? nA : cA + (size_t)(t + 2) * kstep; const char* b2 = last ? nB : cB + (size_t)(t + 2) * kstep;
            const char* a3 = a2 + kstep; const char* b3 = b2 + kstep;
            if (last && has_next) S.a_ready(nxt);
            if constexpr (SP2) {
            PG8_LDB(B0, 0, 0); PG8_LDB(B1, 0, 1); PG8_SCHED; PG8_LDA(At, 0, 0); PG8_STAGE(PG8_SA(1, 1), a1 + hstep, voffA);
            PG8_WAIT_V(8); PG8_WAIT_L(0); PG8_BAR; PG8_MMA(0, 0, At, B0); PG8_MMA(0, 1, At, B1); PG8_BAR; PG8_SCHED;
            PG8_LDA(At, 0, 1); PG8_STAGE(PG8_SB(0, 0), b2, voffB); PG8_STAGE(PG8_SB(0, 1), b2 + hstep, voffB); PG8_STAGE(PG8_SA(0, 0), a2, voffA);
            PG8_WAIT_V(8); PG8_WAIT_L(0); PG8_BAR; PG8_MMA(1, 0, At, B0); PG8_MMA(1, 1, At, B1); PG8_BAR; PG8_SCHED;
            PG8_LDB(B0, 1, 0); PG8_LDB(B1, 1, 1); PG8_SCHED; PG8_LDA(At, 1, 0); PG8_STAGE(PG8_SA(0, 1), a2 + hstep, voffA);
            PG8_WAIT_V(8); PG8_WAIT_L(0); PG8_BAR; PG8_MMA(0, 0, At, B0); PG8_MMA(0, 1, At, B1); PG8_BAR; PG8_SCHED;
            PG8_LDA(At, 1, 1); PG8_STAGE(PG8_SB(1, 0), b3, voffB); PG8_STAGE(PG8_SB(1, 1), b3 + hstep, voffB); PG8_STAGE(PG8_SA(1, 0), a3, voffA);
            PG8_WAIT_V(8); PG8_WAIT_L(0); PG8_BAR; PG8_MMA(1, 0, At, B0); PG8_MMA(1, 1, At, B1); PG8_BAR; PG8_SCHED;
            } else {
            PG8_LDB(B0, 0, 0); PG8_SCHED; PG8_LDA(At, 0, 0); PG8_STAGE(PG8_SA(1, 1), a1 + hstep, voffA);
            PG8_WAIT_L(8); PG8_BAR; PG8_WAIT_L(0); PG8_MMA(0, 0, At, B0); PG8_BAR; PG8_SCHED;
            PG8_LDB(B1, 0, 1); PG8_STAGE(PG8_SB(0, 0), b2, voffB);
            PG8_BAR; PG8_WAIT_L(0); PG8_MMA(0, 1, At, B1); PG8_BAR;
            PG8_LDA(At, 0, 1); PG8_STAGE(PG8_SA(0, 0), a2, voffA);
            PG8_BAR; PG8_WAIT_L(0); PG8_MMA(1, 0, At, B0); PG8_BAR; PG8_SCHED;
            PG8_STAGE(PG8_SB(0, 1), b2 + hstep, voffB);
            PG8_WAIT_V(6); PG8_BAR; PG8_MMA(1, 1, At, B1); PG8_BAR;
            PG8_LDB(B0, 1, 0); PG8_SCHED; PG8_LDA(At, 1, 0); PG8_STAGE(PG8_SA(0, 1), a2 + hstep, voffA);
            PG8_WAIT_L(8); PG8_BAR; PG8_WAIT_L(0); PG8_MMA(0, 0, At, B0); PG8_BAR; PG8_SCHED;
            PG8_LDB(B1, 1, 1); PG8_STAGE(PG8_SB(1, 0), b3, voffB);
            PG8_BAR; PG8_WAIT_L(0); PG8_MMA(0, 1, At, B1); PG8_BAR;
            PG8_LDA(At, 1, 1); PG8_STAGE(PG8_SA(1, 0), a3, voffA);
            PG8_BAR; PG8_WAIT_L(0); PG8_MMA(1, 0, At, B0); PG8_BAR; PG8_SCHED;
            PG8_STAGE(PG8_SB(1, 1), b3 + hstep, voffB);
            PG8_WAIT_V(6); PG8_BAR; PG8_MMA(1, 1, At, B1); PG8_BAR;
            }
        }
        if constexpr (ALIGN_EPI) { if (wr == 0) PG8_BAR; }
        if constexpr (!Epi::AFTER_DRAIN) { E(acc, cur, wr, wc, fr, fq); S.done(cur); }
        if (!has_next) break;
#pragma unroll
        for (int a = 0; a < 2; ++a)
#pragma unroll
            for (int b = 0; b < 2; ++b)
#pragma unroll
                for (int m = 0; m < 4; ++m)
#pragma unroll
                    for (int n = 0; n < 2; ++n) acc[a][b][m][n] = (f32x4){0.f, 0.f, 0.f, 0.f};
        cur = nxt; cA = nA; cB = nB; ++ui;
        if constexpr (ALIGN_EPI) { if (wr == 1) PG8_BAR; }
    }
    PG8_WAIT_V(0);
    if constexpr (!ALIGN_EPI) { if (wr == 0) PG8_BAR; }
    PG8_BAR;
    if constexpr (Epi::AFTER_DRAIN) { E.fused(acc, cur, wr, wc, fr, fq, lds, wid, lane); S.done(cur); }
#undef PG8_SA
#undef PG8_SB
#undef PG8_STAGE
#undef PG8_LDA
#undef PG8_LDB
#undef PG8_MMA
#undef PG8_WAIT_V
#undef PG8_WAIT_L
#undef PG8_BAR
#undef PG8_SCHED
}
}

namespace pg8 {
struct EpiF32Res {
    static constexpr bool PERM = false, AFTER_DRAIN = false;
    float* Y; const float* res; const bf16_t* resb; const float* bias; int ldc; float alpha;
    __device__ __forceinline__ void operator()(const f32x4 (&acc)[2][2][4][2], const Unit& u, int wr, int wc, int fr, int fq) const {
        typedef unsigned u32x2 __attribute__((ext_vector_type(2)));
        const int row0 = u.pm * BM + wr * 64 + fr, col0 = u.pn * BM + wc * 32 + 4 * fq;
#pragma unroll
        for (int ai = 0; ai < 2; ++ai)
#pragma unroll
            for (int m = 0; m < 4; ++m) { const size_t off = (size_t)(row0 + ai * HALF + m * 16) * ldc + col0;
#pragma unroll
                for (int bj = 0; bj < 2; ++bj)
#pragma unroll
                    for (int n = 0; n < 2; ++n) { const int cofs = bj * HALF + n * 16;
                        const f32x4 bv = *(const f32x4*)(bias + col0 + cofs); f32x4 rv;
                        if (res) rv = *(const f32x4*)(res + off + cofs);
                        else { const u32x2 rw = *(const u32x2*)(resb + off + cofs); rv.x = __uint_as_float(rw.x << 16); rv.y = __uint_as_float(rw.x & 0xffff0000u); rv.z = __uint_as_float(rw.y << 16); rv.w = __uint_as_float(rw.y & 0xffff0000u); }
                        *(f32x4*)(Y + off + cofs) = acc[ai][bj][m][n] + bv + rv * alpha; } }
    }
};
}

namespace mg {
constexpr int A_STAGE = 256 * 64 * 2, B_STAGE = 64 * 256 * 2;
typedef short s16x4 __attribute__((ext_vector_type(4)));
#define MG_OPAQUE(x) asm volatile("" : "+v"(x))
template <class EP>
__device__ __forceinline__ void tile(LAS unsigned char* lds, const bf16* a0, const bf16* a1, const bf16* a2, const bf16* a3, const float* bcol, const size_t ldb,
                                     const int K, const int mvalid, const EP& ep) {
    const int tid = threadIdx.x, w = __builtin_amdgcn_readfirstlane(tid >> 6), lane = tid & 63, wr = w >> 2, wc = w & 3, fr = lane & 15, fq = lane >> 4;
    const int achunk = ((tid & 7) ^ ((tid >> 4) & 7)) * 8;
    a0 += achunk; a1 += achunk; a2 += achunk; a3 += achunk;
    unsigned ard0 = (unsigned)(size_t)lds + (wr * 128 + fr) * 128 + ((fq ^ ((fr >> 1) & 7)) * 16);
    unsigned ard1 = (unsigned)(size_t)lds + (wr * 128 + fr) * 128 + (((4 + fq) ^ ((fr >> 1) & 7)) * 16);
    const int q = fr >> 2, p = fr & 3, rkey = q + 4 * (fq & 1);
    unsigned brd[4];
#pragma unroll
    for (int nn = 0; nn < 4; ++nn) brd[nn] = (unsigned)(size_t)lds + 2 * A_STAGE + (8 * fq + q) * 512 + (((wc * 4 + nn) ^ rkey) << 5) + p * 8;
    unsigned bwr[4];
#pragma unroll
    for (int j = 0; j < 4; ++j) bwr[j] = (unsigned)(size_t)lds + 2 * A_STAGE + (8 * w + j) * 512 + ((((lane >> 2) ^ (j + 4 * (w & 1)))) << 5) + (lane & 3) * 8;
    MG_OPAQUE(ard0); MG_OPAQUE(ard1);
#pragma unroll
    for (int j = 0; j < 4; ++j) { MG_OPAQUE(brd[j]); MG_OPAQUE(bwr[j]); }
    int mlim = (mvalid - wr * 128 + 15) >> 4; mlim = mlim < 0 ? 0 : (mlim > 8 ? 8 : mlim);
    const float* bp = bcol + (size_t)(8 * w) * ldb;
    f32x4 acc[8][4];
#pragma unroll
    for (int m = 0; m < 8; ++m)
#pragma unroll
        for (int nn = 0; nn < 4; ++nn) acc[m][nn] = (f32x4){0.f, 0.f, 0.f, 0.f};
    f32x4 rb[8];
    LAS unsigned char* const Aw = lds + w * 1024;
#define MG_DMA(BUF, k0) do { \
        __builtin_amdgcn_global_load_lds((const unsigned*)(a0 + (k0)), (LAS unsigned*)(Aw + (BUF) * A_STAGE), 16, 0, 0); \
        __builtin_amdgcn_global_load_lds((const unsigned*)(a1 + (k0)), (LAS unsigned*)(Aw + (BUF) * A_STAGE + 8192), 16, 0, 0); \
        __builtin_amdgcn_global_load_lds((const unsigned*)(a2 + (k0)), (LAS unsigned*)(Aw + (BUF) * A_STAGE + 16384), 16, 0, 0); \
        __builtin_amdgcn_global_load_lds((const unsigned*)(a3 + (k0)), (LAS unsigned*)(Aw + (BUF) * A_STAGE + 24576), 16, 0, 0); } while (0)
#define MG_BLOAD(k0) do { const float* p_ = bp + (size_t)(k0) * ldb; \
        _Pragma("unroll") for (int i = 0; i < 8; ++i) rb[i] = *(const f32x4*)(p_ + (size_t)i * ldb); } while (0)
#define MG_BWRITE(BUF) do { \
        _Pragma("unroll") for (int i = 0; i < 8; ++i) { typedef unsigned u32x2 __attribute__((ext_vector_type(2))); u32x2 pk; pk.x = cvt_pk_bf16(rb[i].x, rb[i].y); pk.y = cvt_pk_bf16(rb[i].z, rb[i].w); \
            *(LAS u32x2*)(size_t)(bwr[i & 3] + (BUF) * B_STAGE + (i >> 2) * 2048) = pk; } } while (0)
#define MG_COMPUTE(BUF) do { \
        _Pragma("unroll") for (int ks = 0; ks < 2; ++ks) { \
            bf16x8 Bf[4]; \
            _Pragma("unroll") for (int nn = 0; nn < 4; ++nn) { \
                const s16x4 v0 = __builtin_amdgcn_ds_read_tr16_b64_v4i16((LAS s16x4*)(size_t)(brd[nn] + (BUF) * B_STAGE + ks * 16384)), \
                            v1 = __builtin_amdgcn_ds_read_tr16_b64_v4i16((LAS s16x4*)(size_t)(brd[nn] + (BUF) * B_STAGE + ks * 16384 + 2048)); \
                Bf[nn] = (bf16x8){v0.x, v0.y, v0.z, v0.w, v1.x, v1.y, v1.z, v1.w}; } \
            _Pragma("unroll") for (int mh = 0; mh < 2; ++mh) { \
                bf16x8 Af[4]; \
                _Pragma("unroll") for (int mi = 0; mi < 4; ++mi) Af[mi] = *(const LAS bf16x8*)(size_t)((ks ? ard1 : ard0) + (BUF) * A_STAGE + (mh * 4 + mi) * 2048); \
                _Pragma("unroll") for (int mi = 0; mi < 4; ++mi) { if (mh * 4 + mi < mlim) { \
                    _Pragma("unroll") for (int nn = 0; nn < 4; ++nn) acc[mh * 4 + mi][nn] = __builtin_amdgcn_mfma_f32_16x16x32_bf16(Bf[nn], Af[mi], acc[mh * 4 + mi][nn], 0, 0, 0); } } \
                __builtin_amdgcn_sched_barrier(0); } } } while (0)
#define MG_SYNC() do { asm volatile("s_waitcnt vmcnt(0) lgkmcnt(0)" ::: "memory"); __syncthreads(); } while (0)
    MG_DMA(0, 0); MG_BLOAD(0); MG_BWRITE(0);
    MG_SYNC();
    const int T = K >> 6;
    for (int t = 0; t < T; t += 2) {
        MG_DMA(1, (t + 1) * 64); MG_BLOAD((t + 1) * 64);
        __builtin_amdgcn_sched_barrier(0);
        MG_COMPUTE(0);
        MG_BWRITE(1);
        MG_SYNC();
        const bool hn = t + 2 < T;
        if (hn) { MG_DMA(0, (t + 2) * 64); MG_BLOAD((t + 2) * 64); }
        __builtin_amdgcn_sched_barrier(0);
        MG_COMPUTE(1);
        if (hn) MG_BWRITE(0);
        MG_SYNC();
    }
#undef MG_DMA
#undef MG_BLOAD
#undef MG_BWRITE
#undef MG_COMPUTE
#undef MG_SYNC
    ep(acc, wr, wc, fr, fq);
}
struct EpiGU { bf16* H; int rowbase, mvalid, h0;
    __device__ __forceinline__ void operator()(const f32x4 (&acc)[8][4], int wr, int wc, int fr, int fq) const {
        typedef unsigned u32x2 __attribute__((ext_vector_type(2)));
#pragma unroll
        for (int m = 0; m < 8; ++m) { const int row = wr * 128 + m * 16 + fr;
            if (row < mvalid) {
#pragma unroll
                for (int hn = 0; hn < 2; ++hn) { const f32x4 g = acc[m][hn], u = acc[m][hn + 2]; f32x4 h;
                    h.x = g.x / (1.f + __expf(-g.x)) * u.x; h.y = g.y / (1.f + __expf(-g.y)) * u.y; h.z = g.z / (1.f + __expf(-g.z)) * u.z; h.w = g.w / (1.f + __expf(-g.w)) * u.w;
                    u32x2 pk; pk.x = cvt_pk_bf16(h.x, h.y); pk.y = cvt_pk_bf16(h.z, h.w);
                    *(u32x2*)(H + (size_t)(rowbase + row) * EH + h0 + wc * 32 + hn * 16 + 4 * fq) = pk; } } } } };
struct EpiDown { bf16* contrib; const int* lslot; const float* lw; int mvalid, n0;
    __device__ __forceinline__ void operator()(const f32x4 (&acc)[8][4], int wr, int wc, int fr, int fq) const {
        typedef unsigned u32x2 __attribute__((ext_vector_type(2)));
#pragma unroll
        for (int m = 0; m < 8; ++m) { const int row = wr * 128 + m * 16 + fr;
            if (row < mvalid) { const int slot = lslot[row]; const float wgt = lw[row];
#pragma unroll
                for (int nn = 0; nn < 4; ++nn) { const f32x4 v = acc[m][nn] * wgt; u32x2 pk; pk.x = cvt_pk_bf16(v.x, v.y); pk.y = cvt_pk_bf16(v.z, v.w);
                    *(u32x2*)(contrib + (size_t)slot * DM + n0 + wc * 64 + nn * 16 + 4 * fq) = pk; } } } } };
}

struct Args { const float* in[23]; float* out; unsigned char* ws; int lo, hi; };

struct Ctx {
    LAS unsigned char* lds;
    int tid, lane, wid;
    const Args* a;
    __device__ __forceinline__ const float* x_in() const { return a->in[0]; }
    __device__ __forceinline__ const float* w_in() const { return a->in[1]; }
    __device__ __forceinline__ const float* b_in() const { return a->in[2]; }
    __device__ __forceinline__ const float* sinks() const { return a->in[3]; }
    __device__ __forceinline__ const float* pe_k() const { return a->in[4]; }
    __device__ __forceinline__ const float* w1_k() const { return a->in[5]; }
    __device__ __forceinline__ const float* w2_k() const { return a->in[6]; }
    __device__ __forceinline__ const float* pe_v() const { return a->in[7]; }
    __device__ __forceinline__ const float* w1_v() const { return a->in[8]; }
    __device__ __forceinline__ const float* w2_v() const { return a->in[9]; }
    __device__ __forceinline__ const float* w_out() const { return a->in[10]; }
    __device__ __forceinline__ const float* b_out() const { return a->in[11]; }
    __device__ __forceinline__ const float* ln1_g() const { return a->in[12]; }
    __device__ __forceinline__ const float* ln1_b() const { return a->in[13]; }
    __device__ __forceinline__ const float* w_group() const { return a->in[14]; }
    __device__ __forceinline__ const float* b_group() const { return a->in[15]; }
    __device__ __forceinline__ const float* w_expert() const { return a->in[16]; }
    __device__ __forceinline__ const float* b_expert() const { return a->in[17]; }
    __device__ __forceinline__ const float* we_gate() const { return a->in[18]; }
    __device__ __forceinline__ const float* we_up() const { return a->in[19]; }
    __device__ __forceinline__ const float* we_down() const { return a->in[20]; }
    __device__ __forceinline__ const float* ln2_g() const { return a->in[21]; }
    __device__ __forceinline__ const float* ln2_b() const { return a->in[22]; }
    __device__ __forceinline__ float* out() const { return a->out; }
    __device__ __forceinline__ bf16* proj() const { return (bf16*)(a->ws + WS_PROJ); }
    __device__ __forceinline__ bf16* o() const { return (bf16*)(a->ws + WS_O); }
    __device__ __forceinline__ bf16* kvc() const { return (bf16*)(a->ws + WS_KVC); }
    __device__ __forceinline__ bf16* H() const { return (bf16*)(a->ws + WS_H); }
    __device__ __forceinline__ float* y() const { return (float*)(a->ws + WS_Y); }
    __device__ __forceinline__ float* x1() const { return (float*)(a->ws + WS_X1); }
    __device__ __forceinline__ float* x2() const { return (float*)(a->ws + WS_X2); }
    __device__ __forceinline__ float* hb() const { return (float*)(a->ws + WS_HB); }
    __device__ __forceinline__ float* logits() const { return (float*)(a->ws + WS_LOG); }
    __device__ __forceinline__ float* lw() const { return (float*)(a->ws + WS_LW); }
    __device__ __forceinline__ float* contrib() const { return (float*)(a->ws + WS_CONTRIB); }
    __device__ __forceinline__ int* lslot() const { return (int*)(a->ws + WS_LSLOT); }
    __device__ __forceinline__ bf16* wint() const { return (bf16*)(a->ws + WS_WINT); }
    __device__ __forceinline__ bf16* wot() const { return (bf16*)(a->ws + WS_WOT); }
    __device__ __forceinline__ bf16* xb() const { return (bf16*)(a->ws + WS_XB); }
    __device__ __forceinline__ bf16* bg() const { return (bf16*)(a->ws + WS_BG); }
    __device__ __forceinline__ bf16* br() const { return (bf16*)(a->ws + WS_BR); }
    __device__ __forceinline__ float* hb4() const { return (float*)(a->ws + WS_HB4); }
    __device__ __forceinline__ bf16* x1b() const { return (bf16*)(a->ws + WS_X1B); }
    __device__ __forceinline__ bf16* contribb() const { return (bf16*)(a->ws + WS_CONTRIB); }
    __device__ __forceinline__ unsigned* cnt() const { return (unsigned*)(a->ws + WS_CTL) + CW_CNT; }
};

constexpr int ATILE_BYTES = 64 * 64 * 2;
constexpr float C1 = 0.125f * 1.4426950408889634f;

__device__ __forceinline__ float xrow16_max(float x) {
    auto s = __builtin_amdgcn_permlane16_swap(__float_as_uint(x), __float_as_uint(x), false, false);
    x = fmaxf(__uint_as_float(s[0]), __uint_as_float(s[1]));
    auto t = __builtin_amdgcn_permlane32_swap(__float_as_uint(x), __float_as_uint(x), false, false);
    return fmaxf(__uint_as_float(t[0]), __uint_as_float(t[1]));
}
__device__ __forceinline__ float xrow16_sum(float x) {
    auto s = __builtin_amdgcn_permlane16_swap(__float_as_uint(x), __float_as_uint(x), false, false);
    x = __uint_as_float(s[0]) + __uint_as_float(s[1]);
    auto t = __builtin_amdgcn_permlane32_swap(__float_as_uint(x), __float_as_uint(x), false, false);
    return __uint_as_float(t[0]) + __uint_as_float(t[1]);
}
struct AttnRegs { f32x4 O[4][4]; float m[4], l[4]; bf16x8 Q[4][2]; };
struct ColCtx { int tt0; int t0; };
struct TileD { const bf16* k; const bf16* v; int pitch; float offrel; int mtype; int j; };
struct TileGen {
    int kind;
    int j, jend; unsigned long long rem; int c, jold;
    const bf16* kb; const bf16* vb;
    __device__ __forceinline__ bool next(TileD& d) {
        int jj;
        if (kind == 1) { if (!rem) return false; jj = 63 - __builtin_clzll(rem); rem &= ~(1ull << jj); }
        else { if (j > jend) return false; jj = jend--; }
        d.j = jj;
        if (kind == 2) { d.k = kb + (size_t)jj * 64 * 128; d.v = vb + (size_t)jj * 64 * 128; d.pitch = 128; d.offrel = (float)(1024 * jj + 31 - 64 * c); d.mtype = 3; }
        else { d.k = kb + (size_t)jj * 64 * PP; d.v = vb + (size_t)jj * 64 * PP; d.pitch = PP; d.offrel = (float)(64 * (jj - c)); d.mtype = (jj == c) ? 1 : (jj == jold ? 2 : 0); }
        return true;
    }
};

__device__ __forceinline__ void attn_load_q(AttnRegs& R, const bf16* qbase, int w, int fr, int fq) {
#pragma unroll
    for (int nt = 0; nt < 4; ++nt) {
        const int tt = 8 * w + 2 * nt + (fr >> 3);
        const bf16* p = qbase + (size_t)tt * PP + (fr & 7) * 64 + fq * 8;
        R.Q[nt][0] = *(const bf16x8*)p; R.Q[nt][1] = *(const bf16x8*)(p + 32);
    }
}
__device__ __forceinline__ void attn_reset(AttnRegs& R) {
#pragma unroll
    for (int nt = 0; nt < 4; ++nt) { R.m[nt] = -INFINITY; R.l[nt] = 0.f;
#pragma unroll
        for (int md = 0; md < 4; ++md) R.O[md][nt] = (f32x4){0.f, 0.f, 0.f, 0.f}; }
}
__device__ __forceinline__ void stage_issue(const TileD& d, LAS unsigned char* kdst, LAS unsigned char* vdst, int w, int lane) {
    const int r = 8 * w + (lane >> 3), ch = (lane & 7) ^ ((lane >> 3) & 7);
    __builtin_amdgcn_global_load_lds((const unsigned*)(d.k + (size_t)r * d.pitch + ch * 8), (LAS unsigned*)(kdst + w * 1024), 16, 0, 0);
    __builtin_amdgcn_global_load_lds((const unsigned*)(d.v + (size_t)r * d.pitch + ch * 8), (LAS unsigned*)(vdst + w * 1024), 16, 0, 0);
}

template <int MODE>
__device__ __forceinline__ void attn_half(AttnRegs& R, const LAS unsigned char* Kt, const LAS unsigned char* Vt, const int hk, const float A, const float kstep, const float off,
                                          const int mtype, const int hicmp, const unsigned enbits, const ColCtx& cc, const int fr, const int fq,
                                          LAS float* impA, LAS float* impB, const int jq0) {
    bf16x8 Kf[2][2];
#pragma unroll
    for (int m = 0; m < 2; ++m)
#pragma unroll
        for (int ks = 0; ks < 2; ++ks) Kf[m][ks] = *(const LAS bf16x8*)(Kt + (hk * 32 + m * 16 + fr) * 128 + (((ks * 4 + fq) ^ (fr & 7)) * 16));
    f32x4 S[2][4];
    const float ak = A * kstep;
#pragma unroll
    for (int m = 0; m < 2; ++m) {
        const float b0 = ak * (float)(hk * 32 + m * 16 + 4 * fq);
        const f32x4 cb = {b0, b0 + ak, b0 + 2.f * ak, b0 + 3.f * ak};
#pragma unroll
        for (int nt = 0; nt < 4; ++nt) {
            S[m][nt] = __builtin_amdgcn_mfma_f32_16x16x32_bf16(Kf[m][0], R.Q[nt][0], cb, 0, 0, 0);
            S[m][nt] = __builtin_amdgcn_mfma_f32_16x16x32_bf16(Kf[m][1], R.Q[nt][1], S[m][nt], 0, 0, 0);
        }
    }
    __builtin_amdgcn_sched_barrier(0);
    bool en[4];
#pragma unroll
    for (int nt = 0; nt < 4; ++nt) en[nt] = ((enbits >> nt) & 1u) != 0u;
    if (mtype != 0) {
#pragma unroll
        for (int nt = 0; nt < 4; ++nt) {
            const int tt = cc.tt0 + 2 * nt;
            int lo = 0, hi = 63;
            if (mtype == 1) hi = tt; else if (mtype == 2) lo = tt + 1; else { const int t = cc.t0 + tt; hi = (t >= 31 ? ((t - 31) >> 4) : -1) - hicmp; }
#pragma unroll
            for (int m = 0; m < 2; ++m)
#pragma unroll
                for (int r = 0; r < 4; ++r) { const int kk = hk * 32 + m * 16 + 4 * fq + r; if (kk < lo || kk > hi) S[m][nt][r] = -INFINITY; }
        }
    }
    bf16x8 Pf[4];
#pragma unroll
    for (int nt = 0; nt < 4; ++nt) {
        float add;
        if (MODE == 2) {
            add = (en[nt] && R.m[nt] > -INFINITY) ? C1 * (off - R.m[nt]) : -INFINITY;
        } else {
            float cm = fmaxf(fmaxf(fmaxf(S[0][nt][0], S[0][nt][1]), fmaxf(S[0][nt][2], S[0][nt][3])), fmaxf(fmaxf(S[1][nt][0], S[1][nt][1]), fmaxf(S[1][nt][2], S[1][nt][3])));
            if (!en[nt]) cm = -INFINITY;
            cm = xrow16_max(cm);
            const float mn = fmaxf(R.m[nt], cm + off);
            const float corr = (mn == -INFINITY) ? 1.f : __builtin_amdgcn_exp2f(C1 * (R.m[nt] - mn));
            add = (en[nt] && mn > -INFINITY) ? C1 * (off - mn) : -INFINITY;
            R.m[nt] = mn; R.l[nt] *= corr;
            if (MODE == 0) {
                if (__any(corr != 1.f)) {
#pragma unroll
                    for (int md = 0; md < 4; ++md) R.O[md][nt] = R.O[md][nt] * corr;
                }
            }
        }
        float p[2][4];
#pragma unroll
        for (int m = 0; m < 2; ++m)
#pragma unroll
            for (int r = 0; r < 4; ++r) p[m][r] = __builtin_amdgcn_exp2f(fmaf(S[m][nt][r], C1, add));
        if (MODE == 2) {
#pragma unroll
            for (int m = 0; m < 2; ++m) {
                float q4 = (p[m][0] + p[m][1]) + (p[m][2] + p[m][3]), p3 = p[m][3];
                q4 += __shfl_xor(q4, 1); p3 += __shfl_xor(p3, 1);
                q4 += __shfl_xor(q4, 2); p3 += __shfl_xor(p3, 2);
                q4 += __shfl_xor(q4, 4); p3 += __shfl_xor(p3, 4);
                if ((fr & 7) == 0) { const int jq = jq0 + hk * 8 + m * 4 + fq; impA[(cc.tt0 + 2 * nt) * 64 + jq] = q4; impB[(cc.tt0 + 2 * nt) * 65 + jq + 1] = p3; }
            }
        } else {
            R.l[nt] += ((p[0][0] + p[0][1]) + (p[0][2] + p[0][3])) + ((p[1][0] + p[1][1]) + (p[1][2] + p[1][3]));
        }
        if (MODE != 1) {
            u32x4 pk; pk.x = cvt_pk_bf16(p[0][0], p[0][1]); pk.y = cvt_pk_bf16(p[0][2], p[0][3]); pk.z = cvt_pk_bf16(p[1][0], p[1][1]); pk.w = cvt_pk_bf16(p[1][2], p[1][3]);
            Pf[nt] = __builtin_bit_cast(bf16x8, pk);
        }
        if (nt & 1) __builtin_amdgcn_sched_barrier(0);
    }
    __builtin_amdgcn_sched_barrier(0);
    if (MODE != 1) {
#pragma unroll
        for (int md = 0; md < 4; ++md) {
            typedef short s16x4 __attribute__((ext_vector_type(4)));
            const int key0 = hk * 32 + 4 * fq + (fr >> 2);
            const LAS unsigned char* vp = Vt + key0 * 128 + (((md * 2 + ((fr & 3) >> 1)) ^ (key0 & 7)) * 16) + (fr & 1) * 8;
            const s16x4 v0 = __builtin_amdgcn_ds_read_tr16_b64_v4i16((LAS s16x4*)vp), v1 = __builtin_amdgcn_ds_read_tr16_b64_v4i16((LAS s16x4*)(vp + 16 * 128));
            const bf16x8 Vf = {v0.x, v0.y, v0.z, v0.w, v1.x, v1.y, v1.z, v1.w};
#pragma unroll
            for (int nt = 0; nt < 4; ++nt) R.O[md][nt] = __builtin_amdgcn_mfma_f32_16x16x32_bf16(Vf, Pf[nt], R.O[md][nt], 0, 0, 0);
        }
    }
}

template <int MODE, bool USE_SEL>
__device__ __forceinline__ void attn_sweep(AttnRegs& R, LAS unsigned char* lds, TileGen tg, const ColCtx& cc, const float A, const float kstep,
                                           const int w, const int lane, const int fr, const int fq) {
    LAS unsigned char* Kb = lds + L_KV;
    LAS float* impA = (LAS float*)(lds + L_IMPA); LAS float* impB = (LAS float*)(lds + L_IMPB);
    const LAS unsigned* selw = (const LAS unsigned*)(lds + L_SEL);
    TileGen ta = tg;
    TileD cur, pf;
    if (!tg.next(cur)) return;
    ta.next(pf); stage_issue(pf, Kb, Kb + ATILE_BYTES, w, lane);
    bool more = ta.next(pf);
    if (more) stage_issue(pf, Kb + 2 * ATILE_BYTES, Kb + 3 * ATILE_BYTES, w, lane);
    if (more) asm volatile("s_waitcnt vmcnt(2)" ::: "memory"); else asm volatile("s_waitcnt vmcnt(0)" ::: "memory");
    __syncthreads();
    int st = 0;
    for (;;) {
        int st2 = st + 2; st2 = st2 >= 3 ? st2 - 3 : st2;
        if (more) { more = ta.next(pf); if (more) stage_issue(pf, Kb + st2 * (2 * ATILE_BYTES), Kb + st2 * (2 * ATILE_BYTES) + ATILE_BYTES, w, lane); }
        unsigned enbits = 15u;
        if (USE_SEL) {
            enbits = 0u;
#pragma unroll
            for (int nt = 0; nt < 4; ++nt) { const int tt = cc.tt0 + 2 * nt; const unsigned sw = selw[2 * tt + (cur.j >> 5)]; enbits |= ((sw >> (cur.j & 31)) & 1u) << nt; }
        }
        if (__any(enbits != 0u)) {
            const LAS unsigned char* Kt = Kb + st * (2 * ATILE_BYTES); const LAS unsigned char* Vt = Kt + ATILE_BYTES;
            const float off = A * cur.offrel;
#pragma unroll 1
            for (int hk = 0; hk < 2; ++hk) attn_half<MODE>(R, Kt, Vt, hk, A, kstep, off, cur.mtype, 64 * cur.j, enbits, cc, fr, fq, impA, impB, cur.j * 16);
        }
        if (more) asm volatile("s_waitcnt vmcnt(2)" ::: "memory"); else asm volatile("s_waitcnt vmcnt(0)" ::: "memory");
        __syncthreads();
        if (!tg.next(cur)) break;
        st = st + 1 >= 3 ? 0 : st + 1;
    }
}
__device__ __forceinline__ void attn_ltot(const AttnRegs& R, float (&lt)[4]) {
#pragma unroll
    for (int nt = 0; nt < 4; ++nt) lt[nt] = xrow16_sum(R.l[nt]);
}
__device__ __forceinline__ void attn_store(const AttnRegs& R, const float (&sc)[4], bf16* obase, const ColCtx& cc, int fr, int fq, const LAS unsigned char* parked) {
    typedef unsigned u32x2 __attribute__((ext_vector_type(2)));
    u32x2 old[4][4];
    if (parked) {
#pragma unroll
        for (int nt = 0; nt < 4; ++nt)
#pragma unroll
            for (int md = 0; md < 4; ++md) old[nt][md] = *(const u32x2*)(obase + (size_t)(cc.tt0 + 2 * nt) * DM + (fr & 7) * 64 + md * 16 + 4 * fq);
    }
#pragma unroll
    for (int nt = 0; nt < 4; ++nt)
#pragma unroll
        for (int md = 0; md < 4; ++md) {
            f32x4 v = R.O[md][nt] * sc[nt];
            u32x2* p = (u32x2*)(obase + (size_t)(cc.tt0 + 2 * nt) * DM + (fr & 7) * 64 + md * 16 + 4 * fq);
            if (parked) { const u32x2 pk = *(const LAS u32x2*)(parked + ((nt * 4 + md) * 64) * 8); const u32x2 ow = old[nt][md];
                v.x += bf2f(ow.x & 0xffffu) + bf2f(pk.x & 0xffffu); v.y += bf2f(ow.x >> 16) + bf2f(pk.x >> 16);
                v.z += bf2f(ow.y & 0xffffu) + bf2f(pk.y & 0xffffu); v.w += bf2f(ow.y >> 16) + bf2f(pk.y >> 16); }
            u32x2 nw; nw.x = cvt_pk_bf16(v.x, v.y); nw.y = cvt_pk_bf16(v.z, v.w);
            *p = nw;
        }
}
__device__ __forceinline__ void attn_park(const AttnRegs& R, const float (&sc)[4], LAS unsigned char* park) {
    typedef unsigned u32x2 __attribute__((ext_vector_type(2)));
#pragma unroll
    for (int nt = 0; nt < 4; ++nt)
#pragma unroll
        for (int md = 0; md < 4; ++md) { const f32x4 v = R.O[md][nt] * sc[nt]; u32x2 nw; nw.x = cvt_pk_bf16(v.x, v.y); nw.y = cvt_pk_bf16(v.z, v.w); *(LAS u32x2*)(park + ((nt * 4 + md) * 64) * 8) = nw; }
}
__device__ __forceinline__ void attn_colctx(ColCtx& cc, int w, int fr, int t0) { cc.tt0 = 8 * w + (fr >> 3); cc.t0 = t0; }

__device__ __forceinline__ void win_unit(const Ctx& c, int L, int u) {
    const int tid = c.tid, lane = c.lane, w = c.wid, fr = lane & 15, fq = lane >> 4;
    const int cch = u & 63, g = (u >> 6) & 1, b = u >> 7, t0 = cch * 64;
    const bf16* pb = c.proj() + (size_t)b * SEQ * PP;
    AttnRegs R; attn_reset(R);
    attn_load_q(R, pb + (size_t)t0 * PP + C_QN + g * 512, w, fr, fq);
    ColCtx cc; attn_colctx(cc, w, fr, t0);
    const float A = 8.f * exp2f(-(float)(g * 8 + (fr & 7) + 1) * 0.5f);
    TileGen tg; tg.kind = 0; tg.c = cch; tg.j = cch - 8 < 0 ? 0 : cch - 8; tg.jend = cch; tg.jold = cch - 8; tg.rem = 0ull;
    tg.kb = pb + C_KV + 4 * 128 + g * 64; tg.vb = pb + C_KV + 5 * 128 + g * 64;
    attn_sweep<0, false>(R, c.lds, tg, cc, A, 1.f, w, lane, fr, fq);
    float lt[4], sc[4]; attn_ltot(R, lt);
#pragma unroll
    for (int nt = 0; nt < 4; ++nt) { const float gv = bf2f(pb[(size_t)(t0 + cc.tt0 + 2 * nt) * PP + C_GN + g * 24 + (fr & 7) * 3 + 2]); sc[nt] = sigmoidf(gv) / lt[nt]; }
    attn_store(R, sc, c.o() + ((size_t)b * SEQ + t0) * DM + 1024 + g * 512, cc, fr, fq, nullptr);
}
__device__ __forceinline__ void swa_unit(const Ctx& c, int L, int u) {
    const int tid = c.tid, lane = c.lane, w = c.wid, fr = lane & 15, fq = lane >> 4;
    const int cch = u & 63, g = (u >> 6) & 1, b = u >> 7, t0 = cch * 64;
    const bf16* pb = c.proj() + (size_t)b * SEQ * PP;
    AttnRegs R; attn_reset(R);
    attn_load_q(R, pb + (size_t)t0 * PP + C_QA + g * 512, w, fr, fq);
    ColCtx cc; attn_colctx(cc, w, fr, t0);
    const int a = g * 8 + (fr & 7);
    const float A = 8.f * exp2f(-(float)(2 * a + 1) * 0.25f);
    const float sink8 = 8.f * c.sinks()[L * 16 + a];
#pragma unroll
    for (int nt = 0; nt < 4; ++nt) { R.m[nt] = sink8 + A * (float)(cc.tt0 + 2 * nt); R.l[nt] = fq == 0 ? 1.f : 0.f; }
    TileGen tg; tg.kind = 0; tg.c = cch; tg.j = cch - 2 < 0 ? 0 : cch - 2; tg.jend = cch; tg.jold = cch - 2; tg.rem = 0ull;
    tg.kb = pb + C_KA + g * 64; tg.vb = pb + C_VA + g * 64;
    attn_sweep<0, false>(R, c.lds, tg, cc, A, 1.f, w, lane, fr, fq);
    float lt[4], sc[4]; attn_ltot(R, lt);
#pragma unroll
    for (int nt = 0; nt < 4; ++nt) sc[nt] = 1.f / lt[nt];
    attn_store(R, sc, c.o() + ((size_t)b * SEQ + t0) * DM + g * 512, cc, fr, fq, nullptr);
}
__device__ __forceinline__ void cmpslc_unit(const Ctx& c, int L, int u) {
    const int tid = c.tid, lane = c.lane, w = c.wid, fr = lane & 15, fq = lane >> 4;
    const int cch = u & 63, g = (u >> 6) & 1, b = u >> 7, t0 = cch * 64;
    const bf16* pb = c.proj() + (size_t)b * SEQ * PP;
    LAS float* impA = (LAS float*)(c.lds + L_IMPA); LAS float* impB = (LAS float*)(c.lds + L_IMPB);
    LAS unsigned* selw = (LAS unsigned*)(c.lds + L_SEL);
    AttnRegs R; attn_reset(R);
    attn_load_q(R, pb + (size_t)t0 * PP + C_QN + g * 512, w, fr, fq);
    ColCtx cc; attn_colctx(cc, w, fr, t0);
    const float A = 8.f * exp2f(-(float)(g * 8 + (fr & 7) + 1) * 0.5f);
    bf16* obase = c.o() + ((size_t)b * SEQ + t0) * DM + 1024 + g * 512;
    const bf16* gbase = pb + (size_t)t0 * PP + C_GN + g * 24 + (fr & 7) * 3;
    for (int i = lane; i < 8 * 64; i += 64) impA[(8 * w) * 64 + i] = 0.f;
    for (int i = lane; i < 8 * 65; i += 64) impB[(8 * w) * 65 + i] = 0.f;
    WAVE_LDS_FENCE();
    int ncl = 4 * cch + 2; if (ncl > NCMP - 1) ncl = NCMP - 1;
    TileGen tg; tg.kind = 2; tg.c = cch; tg.j = 0; tg.jend = ncl >> 6; tg.jold = -1; tg.rem = 0ull;
    tg.kb = c.kvc() + ((size_t)(b * NCMP) * 2 + g) * 64; tg.vb = c.kvc() + (size_t)2048 * 64 + ((size_t)(b * NCMP) * 2 + g) * 64;
    attn_sweep<1, false>(R, c.lds, tg, cc, A, 16.f, w, lane, fr, fq);
    { float lt[4]; attn_ltot(R, lt);
#pragma unroll
      for (int nt = 0; nt < 4; ++nt) R.m[nt] = lt[nt] > 0.f ? R.m[nt] + __builtin_amdgcn_logf(lt[nt]) * (1.f / C1) : -INFINITY; }
    attn_sweep<2, false>(R, c.lds, tg, cc, A, 16.f, w, lane, fr, fq);
    { float sc[4];
#pragma unroll
      for (int nt = 0; nt < 4; ++nt) sc[nt] = sigmoidf(bf2f(gbase[(size_t)(cc.tt0 + 2 * nt) * PP + 0]));
      attn_park(R, sc, c.lds + L_OCMP + w * 8192 + lane * 8); }
    WAVE_LDS_FENCE();
    for (int i = 0; i < 8; ++i) {
        const int ti = 8 * w + i, j = lane;
        const float imp = impA[ti * 64 + j] + impB[ti * 65 + j];
        const bool forced = (j == 0) || (j == cch) || (j == cch - 1); const bool valid = j <= cch;
        const float score = valid ? (forced ? INFINITY : imp) : -INFINITY;
        int rank = 0;
#pragma unroll 8
        for (int k = 0; k < 64; ++k) { const float sk = __uint_as_float((unsigned)__builtin_amdgcn_readlane((int)__float_as_uint(score), k)); rank += ((sk > score) || (sk == score && k < lane)) ? 1 : 0; }
        const unsigned long long msk = __ballot((rank < 16) && (score > -INFINITY));
        if (lane == 0) { selw[2 * ti] = (unsigned)msk; selw[2 * ti + 1] = (unsigned)(msk >> 32); }
    }
    asm volatile("s_waitcnt vmcnt(0) lgkmcnt(0)" ::: "memory");
    __syncthreads();
    unsigned ulo = selw[2 * lane], uhi = selw[2 * lane + 1];
#pragma unroll
    for (int o = 1; o < 64; o <<= 1) { ulo |= __shfl_xor(ulo, o); uhi |= __shfl_xor(uhi, o); }
    const unsigned long long uni = ((unsigned long long)__builtin_amdgcn_readfirstlane(uhi) << 32) | (unsigned long long)__builtin_amdgcn_readfirstlane(ulo);
    attn_reset(R);
    tg.kind = 1; tg.rem = uni; tg.j = 0; tg.jend = -1; tg.jold = -1;
    tg.kb = pb + C_KV + 2 * 128 + g * 64; tg.vb = pb + C_KV + 3 * 128 + g * 64;
    attn_sweep<0, true>(R, c.lds, tg, cc, A, 1.f, w, lane, fr, fq);
    { float lt[4], sc[4]; attn_ltot(R, lt);
#pragma unroll
      for (int nt = 0; nt < 4; ++nt) sc[nt] = sigmoidf(bf2f(gbase[(size_t)(cc.tt0 + 2 * nt) * PP + 1])) / lt[nt];
      attn_store(R, sc, obase, cc, fr, fq, c.lds + L_OCMP + w * 8192 + lane * 8); }
    __syncthreads();
}

#define EPI_LOOP for (int m = 0; m < 4; ++m) for (int n = 0; n < 2; ++n) for (int j = 0; j < 4; ++j)
struct EpiProj { bf16* proj; const float* bias; int row0, col0;
    __device__ __forceinline__ void operator()(const f32x4 (&acc)[4][2], int wr, int wc, int fr, int fq) const {
#pragma unroll
        for (int m = 0; m < 4; ++m)
#pragma unroll
            for (int n = 0; n < 2; ++n)
#pragma unroll
                for (int j = 0; j < 4; ++j) { const int r = row0 + wr * 64 + m * 16 + fq * 4 + j, cc = col0 + wc * 32 + n * 16 + fr;
                    const float v = cc < INC ? acc[m][n][j] + bias[cc] : 0.f; proj[(size_t)r * PP + cc] = f2bf(v); } } };
struct EpiCmp1 { float* hb; int row0, col0;
    __device__ __forceinline__ void operator()(const f32x4 (&acc)[4][2], int wr, int wc, int fr, int fq) const {
#pragma unroll
        for (int m = 0; m < 4; ++m)
#pragma unroll
            for (int n = 0; n < 2; ++n)
#pragma unroll
                for (int j = 0; j < 4; ++j) { const int r = row0 + wr * 64 + m * 16 + fq * 4 + j, cc = col0 + wc * 32 + n * 16 + fr;
                    hb[(size_t)r * 256 + cc] = acc[m][n][j]; } } };
struct EpiCmp2 { bf16* kvc; int row0;
    __device__ __forceinline__ void operator()(const f32x4 (&acc)[4][2], int wr, int wc, int fr, int fq) const {
#pragma unroll
        for (int m = 0; m < 4; ++m)
#pragma unroll
            for (int n = 0; n < 2; ++n)
#pragma unroll
                for (int j = 0; j < 4; ++j) { const int r = row0 + wr * 64 + m * 16 + fq * 4 + j, cc = wc * 32 + n * 16 + fr;
                    if (cc < 64) kvc[(size_t)r * 64 + cc] = f2bf(acc[m][n][j]); } } };
struct EpiOut { float* y; const float* bias; const float* xres; int row0, col0;
    __device__ __forceinline__ void operator()(const f32x4 (&acc)[4][2], int wr, int wc, int fr, int fq) const {
#pragma unroll
        for (int m = 0; m < 4; ++m)
#pragma unroll
            for (int n = 0; n < 2; ++n)
#pragma unroll
                for (int j = 0; j < 4; ++j) { const int r = row0 + wr * 64 + m * 16 + fq * 4 + j, cc = col0 + wc * 32 + n * 16 + fr;
                    y[(size_t)r * DM + cc] = acc[m][n][j] + bias[cc] + ALPHA * xres[(size_t)r * DM + cc]; } } };
struct EpiLogit { float* lg; const float* bg; const float* be; int row0;
    __device__ __forceinline__ void operator()(const f32x4 (&acc)[4][2], int wr, int wc, int fr, int fq) const {
#pragma unroll
        for (int m = 0; m < 4; ++m)
#pragma unroll
            for (int n = 0; n < 2; ++n)
#pragma unroll
                for (int j = 0; j < 4; ++j) { const int r = row0 + wr * 64 + m * 16 + fq * 4 + j, cc = wc * 32 + n * 16 + fr;
                    if (cc < 72) lg[(size_t)r * NLOG + cc] = acc[m][n][j] + (cc < 8 ? bg[cc] : be[cc - 8]); } } };
struct EpiMoe1 { bf16* H; int rowbase, cnt, rt, ct;
    __device__ __forceinline__ void operator()(const f32x4 (&acc)[4][2], int wr, int wc, int fr, int fq) const {
#pragma unroll
        for (int m = 0; m < 4; ++m)
#pragma unroll
            for (int j = 0; j < 4; ++j) { const int pos = rt * 128 + wr * 64 + m * 16 + fq * 4 + j;
                if (pos < cnt) { const float gv = acc[m][0][j], uv = acc[m][1][j]; const float hv = gv / (1.f + expf(-gv)) * uv;
                    H[(size_t)(rowbase + pos) * EH + ct * 64 + wc * 16 + fr] = f2bf(hv); } } } };
struct EpiMoe2 { float* contrib; const int* lslot; const float* lw; int cnt, rt, col0;
    __device__ __forceinline__ void operator()(const f32x4 (&acc)[4][2], int wr, int wc, int fr, int fq) const {
#pragma unroll
        for (int m = 0; m < 4; ++m)
#pragma unroll
            for (int j = 0; j < 4; ++j) { const int pos = rt * 128 + wr * 64 + m * 16 + fq * 4 + j;
                if (pos < cnt) { const int slot = lslot[pos]; const float w = lw[pos];
#pragma unroll
                    for (int n = 0; n < 2; ++n) contrib[(size_t)slot * DM + col0 + wc * 32 + n * 16 + fr] = acc[m][n][j] * w; } } } };


template <int NT, class EP>
__device__ __forceinline__ void skinny_unit(LAS unsigned char* lds, const bf16* A, const bf16* Bt, const EP& ep, int w, int lane) {
    const int fr = lane & 15, fq = lane >> 4, rg = w & 3, kh = w >> 2;
    const bf16* ap = A + (size_t)(rg * 16 + fr) * DM + kh * 1024 + fq * 8;
    const bf16* bp = Bt + (size_t)fr * DM + kh * 1024 + fq * 8;
    f32x4 acc[NT];
#pragma unroll
    for (int n = 0; n < NT; ++n) acc[n] = (f32x4){0.f, 0.f, 0.f, 0.f};
#pragma unroll 4
    for (int k = 0; k < 1024; k += 32) {
        const bf16x8 a = *(const bf16x8*)(ap + k);
#pragma unroll
        for (int n = 0; n < NT; ++n) { const bf16x8 b = *(const bf16x8*)(bp + (size_t)n * 16 * DM + k); acc[n] = __builtin_amdgcn_mfma_f32_16x16x32_bf16(b, a, acc[n], 0, 0, 0); }
    }
    LAS f32x4* red = (LAS f32x4*)lds + (rg * NT) * 64 + lane;
    if (kh == 1) {
#pragma unroll
        for (int n = 0; n < NT; ++n) red[n * 64] = acc[n];
    }
    __syncthreads();
    if (kh == 0) {
#pragma unroll
        for (int n = 0; n < NT; ++n) acc[n] = acc[n] + red[n * 64];
        ep(acc, rg * 16 + fr, fq);
    }
    __syncthreads();
}
struct EpiGateCols { bf16* proj; const float* bias; int row0;
    __device__ __forceinline__ void operator()(const f32x4 (&acc)[3], int r, int fq) const {
        typedef unsigned u32x2 __attribute__((ext_vector_type(2)));
#pragma unroll
        for (int n = 0; n < 3; ++n) { const int cc = n * 16 + 4 * fq; const f32x4 bv = *(const f32x4*)(bias + 3072 + cc); const f32x4 v = acc[n] + bv;
            u32x2 pk; pk.x = cvt_pk_bf16(v.x, v.y); pk.y = cvt_pk_bf16(v.z, v.w); *(u32x2*)(proj + (size_t)(row0 + r) * PP + 3072 + cc) = pk; } } };
struct EpiLogitLds { LAS float* lgs; const float* bg; const float* be;
    __device__ __forceinline__ void operator()(const f32x4 (&acc)[5], int r, int fq) const {
#pragma unroll
        for (int n = 0; n < 5; ++n) { const int cc = n * 16 + 4 * fq; f32x4 v = acc[n];
            if (cc < 8) v = v + *(const f32x4*)(bg + cc); else if (cc < 72) v = v + *(const f32x4*)(be + cc - 8);
            *(LAS f32x4*)(lgs + r * NLOG + cc) = v; } } };
struct EpiLogitS { float* lg; const float* bg; const float* be; int row0;
    __device__ __forceinline__ void operator()(const f32x4 (&acc)[5], int r, int fq) const {
#pragma unroll
        for (int n = 0; n < 5; ++n) { const int cc = n * 16 + 4 * fq; f32x4 v = acc[n];
            if (cc < 8) v = v + *(const f32x4*)(bg + cc); else if (cc < 72) v = v + *(const f32x4*)(be + cc - 8);
            *(f32x4*)(lg + (size_t)(row0 + r) * NLOG + cc) = v; } } };

__device__ __forceinline__ void p0_transpose_item(const float* W, int K, int ldw, int N, bf16* WT, LAS float* scr, int item, int lane) {
    const int nblk = N / 32, kb = item / nblk, nb = item % nblk, k0 = 64 * kb, n0 = 32 * nb;
#pragma unroll 8
    for (int i = 0; i < 32; ++i) { const int kk = 2 * i + (lane >> 5); scr[kk * 33 + (lane & 31)] = W[(size_t)(k0 + kk) * ldw + n0 + (lane & 31)]; }
    WAVE_LDS_FENCE();
    const int ch = lane & 7;
#pragma unroll
    for (int j = 0; j < 4; ++j) { const int n = (lane >> 3) + 8 * j; const LAS float* s = scr + (8 * ch) * 33 + n;
        u32x4 o; o.x = cvt_pk_bf16(s[0 * 33], s[1 * 33]); o.y = cvt_pk_bf16(s[2 * 33], s[3 * 33]); o.z = cvt_pk_bf16(s[4 * 33], s[5 * 33]); o.w = cvt_pk_bf16(s[6 * 33], s[7 * 33]);
        *(u32x4*)(WT + (size_t)(n0 + n) * K + k0 + 8 * ch) = o; }
    WAVE_LDS_FENCE();
}
__device__ __forceinline__ void ph_prologue(const Ctx& c) {
    LAS float* scr = (LAS float*)(c.lds + c.wid * 16384);
    const int gw = blockIdx.x * 8 + c.wid, NGW = gridDim.x * 8;
    constexpr int I_IN = (DM / 64) * (3072 / 32), I_OUT = (DM / 64) * (DM / 32);
    for (int it = gw; it < DEPTH * (I_IN + I_OUT); it += NGW) {
        int r = it; const int L = r / (I_IN + I_OUT); r -= L * (I_IN + I_OUT);
        if (r < I_IN) p0_transpose_item(c.w_in() + (size_t)L * DM * INC, DM, INC, 3072, c.wint() + (size_t)L * 3072 * DM, scr, r, c.lane);
        else p0_transpose_item(c.w_out() + (size_t)L * DM * DM, DM, DM, DM, c.wot() + (size_t)L * DM * DM, scr, r - I_IN, c.lane);
    }
    {
        const int gt = blockIdx.x * 512 + c.tid, NT_ = gridDim.x * 512;
        for (int it = gt; it < DEPTH * 128 * (DM / 8); it += NT_) {
            const int k8 = it % (DM / 8), n = (it / (DM / 8)) % 128, L = it / (128 * (DM / 8));
            const float* srcp = nullptr; size_t ld = 0; bf16* dst = nullptr;
            if (n < 48) { srcp = c.w_in() + (size_t)L * DM * INC + 3072 + n; ld = INC; dst = c.bg() + ((size_t)L * 48 + n) * DM; }
            else { const int m_ = n - 48; dst = c.br() + ((size_t)L * 80 + m_) * DM;
                if (m_ < 8) { srcp = c.w_group() + (size_t)L * DM * 8 + m_; ld = 8; } else if (m_ < 72) { srcp = c.w_expert() + (size_t)L * DM * 64 + (m_ - 8); ld = 64; } }
            float v[8];
#pragma unroll
            for (int i = 0; i < 8; ++i) v[i] = srcp ? srcp[(size_t)(k8 * 8 + i) * ld] : 0.f;
            u32x4 o; o.x = cvt_pk_bf16(v[0], v[1]); o.y = cvt_pk_bf16(v[2], v[3]); o.z = cvt_pk_bf16(v[4], v[5]); o.w = cvt_pk_bf16(v[6], v[7]);
            *(u32x4*)(dst + k8 * 8) = o;
        }
    }
    for (int m = gw; m < MTOK; m += NGW) {
        const f32x4* xr = (const f32x4*)(c.x_in() + (size_t)m * DM) + c.lane; unsigned long long* o8 = (unsigned long long*)(c.xb() + (size_t)m * DM) + c.lane;
#pragma unroll
        for (int j = 0; j < 8; ++j) { const f32x4 v = xr[64 * j]; o8[64 * j] = (unsigned long long)cvt_pk_bf16(v.x, v.y) | ((unsigned long long)cvt_pk_bf16(v.z, v.w) << 32); }
    }
}
__device__ __forceinline__ void ph_inproj(const Ctx& c, int L, const float* xin) {
    {
        pg8::Gemm g{c.xb(), c.wint() + (size_t)L * 3072 * DM, MTOK, 3072, DM}; pg8::StaticOrder S; S.init(MTOK, 3072, (int)gridDim.x, (int)blockIdx.x);
        pg8::EpiBf16<0> E{c.proj(), PP, c.b_in() + L * INC, 0, 0, 1.f};
        pg8::gemm_phase<pg8::EpiBf16<0>, pg8::StaticOrder, true, true>(c.lds, g, S, E);
    }
    for (int u = blockIdx.x; u < MTOK / 64; u += gridDim.x) {
        EpiGateCols ep{c.proj(), c.b_in() + L * INC, u * 64};
        skinny_unit<3>(c.lds, c.xb() + (size_t)u * 64 * DM, c.bg() + (size_t)L * 48 * DM, ep, c.wid, c.lane);
    }
}
__device__ __forceinline__ void ph_cmp1_swa(const Ctx& c, int L) {
    const int ar = c.tid >> 2, bn = c.tid & 127;
    for (int uu = blockIdx.x; uu < 256; uu += gridDim.x) {
        const int ksp = uu & 3, u = uu >> 2;
        const int which = u >> 5, rt = (u >> 1) & 15, ct = u & 1;
        const int r = rt * 128 + ar;
        const bf16* base = nullptr;
        if (r < CMPROWS) { const int g = r & 1, bn_ = r >> 1, n = bn_ % NCMP, b = bn_ / NCMP;
            base = c.proj() + ((size_t)b * SEQ + 16 * n) * PP + C_KV + which * 128 + g * 64; }
        ALcmp al{base, (which ? c.pe_v() : c.pe_k()) + (size_t)L * 2048, ksp * 512};
        BLf32 bl{(which ? c.w1_v() : c.w1_k()) + (size_t)L * 2048 * 256 + (size_t)(ksp * 512) * 256 + ct * 128 + bn, (size_t)256};
        EpiCmp1 ep{c.hb4() + ((size_t)ksp * 2 + which) * 2048 * 256, rt * 128, ct * 128};
        gemm_tile(c.lds, al, bl, ep, 512);
    }
    __syncthreads();
    for (int u = blockIdx.x; u < NB * 2 * 64; u += gridDim.x) win_unit(c, L, u);
    for (int u = blockIdx.x; u < NB * 2 * 64; u += gridDim.x) swa_unit(c, L, u);
}
__device__ __forceinline__ void ph_cmp2(const Ctx& c, int L) {
    const int ar = c.tid >> 2, bn = c.tid & 127;
    for (int u = blockIdx.x; u < 32; u += gridDim.x) {
        const int which = u >> 4, rt = u & 15;
        ALsum4gelu al{c.hb4() + (size_t)which * 2048 * 256 + (size_t)(rt * 128 + ar) * 256, (size_t)2 * 2048 * 256};
        BLf32 bl{bn < 64 ? (which ? c.w2_v() : c.w2_k()) + (size_t)L * 256 * 64 + bn : nullptr, (size_t)64};
        EpiCmp2 ep{c.kvc() + (size_t)which * 2048 * 64, rt * 128};
        gemm_tile(c.lds, al, bl, ep, 256);
    }
}
__device__ __forceinline__ void ph_nsa(const Ctx& c, int L) {
    for (int i = blockIdx.x; i < NB * 2 * 64; i += gridDim.x) {
        const int r = i >> 8, q = i & 255, bg = q >> 5, ci = q & 31;
        cmpslc_unit(c, L, bg * 64 + (r ? 63 - ci : ci));
    }
}
__device__ __forceinline__ void ph_outproj(const Ctx& c, int L, const float* xin) {
    pg8::Gemm g{c.o(), c.wot() + (size_t)L * DM * DM, MTOK, DM, DM}; pg8::StaticOrder S; S.init(MTOK, DM, (int)gridDim.x, (int)blockIdx.x);
    pg8::EpiF32Res E{c.y(), xin, c.xb(), c.b_out() + L * DM, DM, ALPHA};
    pg8::gemm_phase<pg8::EpiF32Res, pg8::StaticOrder, true, true>(c.lds, g, S, E);
}
__device__ __forceinline__ void ph_ln(const Ctx& c, const float* src, const bf16* srcb, float sscale, const bf16* add, float* dst, const float* gam, const float* bet, bf16* dstb) {
    const int lane = c.lane;
    for (int r = blockIdx.x * 8 + c.wid; r < MTOK; r += gridDim.x * 8) {
        f32x4 v[8]; float s = 0.f;
        if (src) { const f32x4* sp = (const f32x4*)(src + (size_t)r * DM) + lane;
#pragma unroll
            for (int j = 0; j < 8; ++j) { v[j] = sp[64 * j] * sscale; }
        } else { typedef unsigned u32x2 __attribute__((ext_vector_type(2))); const u32x2* sp = (const u32x2*)(srcb + (size_t)r * DM) + lane;
#pragma unroll
            for (int j = 0; j < 8; ++j) { const u32x2 pw = sp[64 * j]; v[j].x = bf2f(pw.x & 0xffffu) * sscale; v[j].y = bf2f(pw.x >> 16) * sscale; v[j].z = bf2f(pw.y & 0xffffu) * sscale; v[j].w = bf2f(pw.y >> 16) * sscale; }
        }
        if (add) {
            typedef unsigned u32x2 __attribute__((ext_vector_type(2)));
            const u32x2* a0 = (const u32x2*)(add + (size_t)(2 * r) * DM) + lane; const u32x2* a1 = (const u32x2*)(add + (size_t)(2 * r + 1) * DM) + lane;
#pragma unroll
            for (int j = 0; j < 8; ++j) { const u32x2 p0 = a0[64 * j], p1 = a1[64 * j];
                v[j].x += bf2f(p0.x & 0xffffu) + bf2f(p1.x & 0xffffu); v[j].y += bf2f(p0.x >> 16) + bf2f(p1.x >> 16);
                v[j].z += bf2f(p0.y & 0xffffu) + bf2f(p1.y & 0xffffu); v[j].w += bf2f(p0.y >> 16) + bf2f(p1.y >> 16); }
        }
#pragma unroll
        for (int j = 0; j < 8; ++j) s += (v[j].x + v[j].y) + (v[j].z + v[j].w);
        const float mean = wave_sum(s) * (1.f / DM); float s2 = 0.f;
#pragma unroll
        for (int j = 0; j < 8; ++j) { v[j] = v[j] - mean; s2 += (v[j].x * v[j].x + v[j].y * v[j].y) + (v[j].z * v[j].z + v[j].w * v[j].w); }
        const float rstd = 1.f / sqrtf(wave_sum(s2) * (1.f / DM) + LN_EPS);
        const f32x4* gp = (const f32x4*)gam + lane; const f32x4* bp = (const f32x4*)bet + lane;
#pragma unroll
        for (int j = 0; j < 8; ++j) v[j] = v[j] * rstd * gp[64 * j] + bp[64 * j];
        if (dst) { f32x4* dp = (f32x4*)(dst + (size_t)r * DM) + lane;
#pragma unroll
            for (int j = 0; j < 8; ++j) dp[64 * j] = v[j]; }
        if (dstb) { unsigned long long* o8 = (unsigned long long*)(dstb + (size_t)r * DM) + lane;
#pragma unroll
            for (int j = 0; j < 8; ++j) o8[64 * j] = (unsigned long long)cvt_pk_bf16(v[j].x, v[j].y) | ((unsigned long long)cvt_pk_bf16(v[j].z, v[j].w) << 32); }
    }
}
__device__ __forceinline__ void ph_router(const Ctx& c, int L) {
    LAS float* lgs = (LAS float*)(c.lds + 32768);
    LAS int* hist = (LAS int*)(c.lds + 53248); LAS int* base = hist + 64;
    unsigned* cnt = c.cnt() + L * 64;
    for (int u = blockIdx.x; u < MTOK / 64; u += gridDim.x) {
        if (c.tid < 64) hist[c.tid] = 0;
        EpiLogitLds ep{lgs, c.b_group() + L * 8, c.b_expert() + L * 64};
        skinny_unit<5>(c.lds, c.x1b() + (size_t)u * 64 * DM, c.br() + (size_t)L * 80 * DM, ep, c.wid, c.lane);
        int ea = 0, eb = 0, pa = 0, pb = 0; float w0 = 0.f, w1 = 0.f;
        if (c.tid < 64) {
            const LAS float* lg = lgs + c.tid * NLOG;
            float gl[8];
#pragma unroll
            for (int i = 0; i < 8; ++i) gl[i] = lg[i];
            int gs = 0; float gm = gl[0];
#pragma unroll
            for (int i = 1; i < 8; ++i) if (gl[i] > gm) { gm = gl[i]; gs = i; }
            float gsum = 0.f;
#pragma unroll
            for (int i = 0; i < 8; ++i) gsum += expf(gl[i] - gm);
            const float gw = 1.f / gsum;
            float el[8];
#pragma unroll
            for (int i = 0; i < 8; ++i) el[i] = lg[8 + gs * 8 + i];
            int i0 = 0; float v0 = el[0];
#pragma unroll
            for (int i = 1; i < 8; ++i) if (el[i] > v0) { v0 = el[i]; i0 = i; }
            int i1 = -1; float v1 = -INFINITY;
#pragma unroll
            for (int i = 0; i < 8; ++i) if (i != i0 && el[i] > v1) { v1 = el[i]; i1 = i; }
            const float e1 = expf(v1 - v0);
            w0 = gw / (1.f + e1); w1 = gw * e1 / (1.f + e1);
            ea = gs * 8 + i0; eb = gs * 8 + i1;
            pa = __hip_atomic_fetch_add((int*)(hist + ea), 1, __ATOMIC_RELAXED, __HIP_MEMORY_SCOPE_WORKGROUP); pb = __hip_atomic_fetch_add((int*)(hist + eb), 1, __ATOMIC_RELAXED, __HIP_MEMORY_SCOPE_WORKGROUP);
        }
        __syncthreads();
        if (c.tid < 64) { const int h = hist[c.tid]; base[c.tid] = h ? (int)atomicAdd(&cnt[c.tid], (unsigned)h) : 0; }
        __syncthreads();
        if (c.tid < 64) {
            const int tok = u * 64 + c.tid;
            const size_t ia = (size_t)ea * LCAP + base[ea] + pa, ib = (size_t)eb * LCAP + base[eb] + pb;
            c.lslot()[ia] = tok * 2; c.lw()[ia] = w0;
            c.lslot()[ib] = tok * 2 + 1; c.lw()[ib] = w1;
        }
        __syncthreads();
    }
}
__device__ __forceinline__ void moe_tables(const Ctx& c, int L) {
    LAS int* tab = (LAS int*)(c.lds + L_TAB);
    __syncthreads();
    if (c.tid < 64) tab[c.tid] = (int)c.cnt()[L * 64 + c.tid];
    __syncthreads();
    if (c.tid == 0) { int rb = 0, tb = 0; for (int e = 0; e < 64; ++e) { tab[64 + e] = rb; tab[128 + e] = tb; rb += tab[e]; tb += (tab[e] + 255) >> 8; } tab[192] = tb; }
    __syncthreads();
}
__device__ __forceinline__ int moe_find(const LAS int* tab, int rtg) { const int lane = threadIdx.x & 63; const unsigned long long m = __ballot(tab[128 + lane] <= rtg); return (int)__builtin_popcountll(m) - 1; }
__device__ __forceinline__ int vcu_id() { const int G = gridDim.x, bx = blockIdx.x; return (G % 8 == 0) ? (bx % 8) * (G / 8) + bx / 8 : bx; }
__device__ __forceinline__ void ph_moe1(const Ctx& c, int L) {
    moe_tables(c, L);
    const LAS int* tab = (const LAS int*)(c.lds + L_TAB);
    const int ntile = tab[192], lane = c.lane, tid = c.tid;
    for (int u = vcu_id(); u < ntile * 4; u += gridDim.x) {
        const int ct = u / ntile, rtg = u - ct * ntile; const int e = moe_find(tab, rtg); const int rt = rtg - tab[128 + e], cnt = tab[e], rowbase = tab[64 + e];
        int mvalid = cnt - rt * 256; if (mvalid > 256) mvalid = 256;
        const int* ls = c.lslot() + (size_t)e * LCAP + rt * 256;
        const bf16* ap[4];
#pragma unroll
        for (int i = 0; i < 4; ++i) { const int row = (tid >> 3) + 64 * i; const int slot = ls[row < mvalid ? row : 0]; ap[i] = c.x1b() + (size_t)(slot >> 1) * DM; }
        const int h0 = ct * 128;
        const int wcv = lane >> 4, nnv = (lane >> 2) & 3, within = 4 * (lane & 3);
        const float* Wsel = ((nnv >> 1) ? c.we_up() : c.we_gate()) + ((size_t)L * NE + e) * DM * EH;
        const float* bcol = Wsel + h0 + wcv * 32 + (nnv & 1) * 16 + within;
        mg::EpiGU ep{c.H(), rowbase + rt * 256, mvalid, h0};
        mg::tile(c.lds, ap[0], ap[1], ap[2], ap[3], bcol, (size_t)EH, DM, mvalid, ep);
    }
}
__device__ __forceinline__ void ph_moe2(const Ctx& c, int L) {
    moe_tables(c, L);
    const LAS int* tab = (const LAS int*)(c.lds + L_TAB);
    const int ntile = tab[192], lane = c.lane, tid = c.tid;
    for (int u = vcu_id(); u < ntile * 8; u += gridDim.x) {
        const int ct = u / ntile, rtg = u - ct * ntile; const int e = moe_find(tab, rtg); const int rt = rtg - tab[128 + e], cnt = tab[e], rowbase = tab[64 + e];
        int mvalid = cnt - rt * 256; if (mvalid > 256) mvalid = 256;
        const bf16* ap[4];
#pragma unroll
        for (int i = 0; i < 4; ++i) { const int row = (tid >> 3) + 64 * i; ap[i] = c.H() + (size_t)(rowbase + rt * 256 + (row < mvalid ? row : 0)) * EH; }
        const float* bcol = c.we_down() + ((size_t)L * NE + e) * EH * DM + ct * 256 + 4 * lane;
        mg::EpiDown ep{c.contribb(), c.lslot() + (size_t)e * LCAP + rt * 256, c.lw() + (size_t)e * LCAP + rt * 256, mvalid, ct * 256};
        mg::tile(c.lds, ap[0], ap[1], ap[2], ap[3], bcol, (size_t)DM, EH, mvalid, ep);
    }
}

__global__ void __launch_bounds__(512, 2) fwd(Args a) {
    extern __shared__ __attribute__((aligned(16))) unsigned char smem[];
    unsigned char* ws = a.ws;
    const int tid0 = threadIdx.x;
    volatile LAS unsigned* barw = (volatile LAS unsigned*)((LAS unsigned char*)smem + L_BARW);
    if (tid0 < 4) barw[tid0] = 0u;
    __syncthreads();
    const int lo = a.lo, hi = a.hi;
    XcdBarrier bar; bar.bar = (unsigned*)(ws + WS_CTL) + CW_BAR; bar.x = 0; bar.st = barw;
    if (hi - lo > 1) bar = xcd_barrier_post((unsigned*)(ws + WS_CTL) + CW_BAR, barw);
#ifndef PHMASK
#define PHMASK 0x7ff
#endif
#define IN(k) (((PHMASK >> ((k) % NPH)) & 1) && lo <= (k) && (k) < hi)
#ifndef DUPMASK
#define DUPMASK 0
#endif
#define DUP(k) ((DUPMASK >> ((k) % NPH)) & 1)
#define SEAM(k) do { if ((k) + 1 < hi) xcd_barrier(bar); } while (0)
#define PCTX() Ctx c; { int t_ = threadIdx.x; asm volatile("" : "+v"(t_)); c.tid = t_; c.lane = t_ & 63; c.wid = __builtin_amdgcn_readfirstlane(t_ >> 6); c.lds = (LAS unsigned char*)smem; c.a = &a; }
#define LAYER_BODY(L) { const int pb = (L) * NPH; \
        if (IN(pb + 0)) { PCTX(); ph_inproj(c, L, L == 0 ? c.x_in() : c.x2()); if (DUP(0)) { ph_inproj(c, L, L == 0 ? c.x_in() : c.x2()); } SEAM(pb + 0); } \
        if (IN(pb + 1)) { PCTX(); ph_cmp1_swa(c, L); if (DUP(1)) { ph_cmp1_swa(c, L); } SEAM(pb + 1); } \
        if (IN(pb + 2)) { PCTX(); ph_cmp2(c, L); if (DUP(2)) { ph_cmp2(c, L); } SEAM(pb + 2); } \
        if (IN(pb + 3)) { PCTX(); ph_nsa(c, L); if (DUP(3)) { ph_nsa(c, L); } SEAM(pb + 3); } \
        if (IN(pb + 4)) { PCTX(); ph_outproj(c, L, L == 0 ? c.x_in() : nullptr); if (DUP(4)) { ph_outproj(c, L, L == 0 ? c.x_in() : nullptr); } SEAM(pb + 4); } \
        if (IN(pb + 5)) { PCTX(); ph_ln(c, c.y(), nullptr, 1.f, nullptr, nullptr, c.ln1_g() + L * DM, c.ln1_b() + L * DM, c.x1b()); if (DUP(5)) { ph_ln(c, c.y(), nullptr, 1.f, nullptr, nullptr, c.ln1_g() + L * DM, c.ln1_b() + L * DM, c.x1b()); } SEAM(pb + 5); } \
        if (IN(pb + 6)) { PCTX(); ph_router(c, L); if (DUP(6)) { ph_router(c, L); } SEAM(pb + 6); } \
        if (IN(pb + 8)) { PCTX(); ph_moe1(c, L); if (DUP(8)) { ph_moe1(c, L); } SEAM(pb + 8); } \
        if (IN(pb + 9)) { PCTX(); ph_moe2(c, L); if (DUP(9)) { ph_moe2(c, L); } SEAM(pb + 9); } \
        if (IN(pb + 10)) { PCTX(); ph_ln(c, nullptr, c.x1b(), ALPHA, c.contribb(), L == DEPTH - 1 ? c.out() : nullptr, c.ln2_g() + L * DM, c.ln2_b() + L * DM, L == DEPTH - 1 ? nullptr : c.xb()); if (DUP(10)) { ph_ln(c, nullptr, c.x1b(), ALPHA, c.contribb(), L == DEPTH - 1 ? c.out() : nullptr, c.ln2_g() + L * DM, c.ln2_b() + L * DM, L == DEPTH - 1 ? nullptr : c.xb()); } SEAM(pb + 10); } \
    }
    if (lo <= 0) { PCTX(); ph_prologue(c); if (hi > 0) xcd_barrier(bar); }
    LAYER_BODY(0)
    LAYER_BODY(1)
#undef IN
#undef SEAM
}

extern "C" void kernel_launch(void* const* d_in, const int* in_sizes, int n_in, void* d_out, int out_size, void* d_ws, size_t ws_size, hipStream_t stream) {
    static int grid = 0;
    if (grid == 0) {
        if (n_in != 23 || out_size != MTOK * DM || ws_size < WS_END) { fprintf(stderr, "kernel_launch: unexpected shapes (n_in %d out %d ws %zu)\n", n_in, out_size, ws_size); grid = -1; return; }
        int dev = 0, cus = 0;
        if (hipGetDevice(&dev) != hipSuccess || hipDeviceGetAttribute(&cus, hipDeviceAttributeMultiprocessorCount, dev) != hipSuccess) { grid = -1; return; }
        if (hipFuncSetAttribute((const void*)fwd, hipFuncAttributeMaxDynamicSharedMemorySize, LDS_BYTES) != hipSuccess) { fprintf(stderr, "kernel_launch: hipFuncSetAttribute failed\n"); grid = -1; return; }
        int per_cu = 0;
        (void)hipOccupancyMaxActiveBlocksPerMultiprocessor(&per_cu, (const void*)fwd, 512, LDS_BYTES);
        (void)hipGetLastError();
        grid = cus;
    }
    if (grid < 0) return;
    (void)hipMemsetAsync((char*)d_ws + WS_CTL, 0, CTL_BYTES, stream);
    Args a{};
    for (int i = 0; i < 23; ++i) a.in[i] = (const float*)d_in[i];
    a.out = (float*)d_out; a.ws = (unsigned char*)d_ws;
#if ONE_LAUNCH
    a.lo = 0; a.hi = DEPTH * NPH;
    hipLaunchKernelGGL(fwd, dim3(grid), dim3(512), LDS_BYTES, stream, a);
#else
    for (int k = 0; k < DEPTH * NPH; ++k) { a.lo = k; a.hi = k + 1; hipLaunchKernelGGL(fwd, dim3(grid), dim3(512), LDS_BYTES, stream, a); }
#endif
}
```
